# Optimizing an MI355X kernel written in HIP

```python
import math
import jax, jax.numpy as jnp
from jax import lax
import numpy as np

D_MODEL = 1024
BATCH = 8
SEQ = 4096
DEPTH = 1

CHUNK = 64
MIX_WIDTH = D_MODEL
ATTN_WIDTH = MIX_WIDTH // 2
SSM_WIDTH = MIX_WIDTH - ATTN_WIDTH
HEAD_DIM = 64
N_HEADS = ATTN_WIDTH // HEAD_DIM
Q_BLOCK = 128
SSM_GROUP = 16
N_SSM_GROUPS = SSM_WIDTH // SSM_GROUP
SSM_STATE = 64
DT_MIN = 1e-3
DT_MAX = 1e-1
IN_WIDTH = 3 * ATTN_WIDTH + N_HEADS + SSM_WIDTH
N_EXPERTS = 32
TOP_K = 4
D_FF = D_MODEL
SWIGLU_LIMIT = 7.0
SWIGLU_ALPHA = 1.702
MOE_BLOCK = 128
PLE_DIM = 256
NORM_EPS = 1e-5

kernel_name = "hymba_s5_fox_moe_ple_encoder"


def rmsnorm(x, g):
    xf = x.astype(jnp.float32)
    y = xf * lax.rsqrt(jnp.mean(xf * xf, axis=-1, keepdims=True) + NORM_EPS)
    return (y * g.astype(jnp.float32)).astype(x.dtype)


def forgetting_attention(q, k, v, log_f):
    b, s, h, dh = q.shape
    n_blk = s // Q_BLOCK
    c_t = jnp.cumsum(log_f, axis=1).transpose(0, 2, 1)
    c_blocks = c_t.reshape(b, h, n_blk, Q_BLOCK).transpose(2, 0, 1, 3)
    q_blocks = q.reshape(b, n_blk, Q_BLOCK, h, dh).transpose(1, 0, 2, 3, 4)
    key_pos = jnp.arange(s)
    scale = dh ** -0.5

    def one_block(args):
        i, q_i, c_i = args
        q_pos = i * Q_BLOCK + jnp.arange(Q_BLOCK)
        logits = jnp.einsum('bqhd,bkhd->bhqk', q_i, k,
                            preferred_element_type=jnp.float32) * scale
        logits = logits + c_i[..., :, None] - c_t[..., None, :]
        logits = jnp.where(key_pos[None, :] <= q_pos[:, None], logits, -jnp.inf)
        w = jax.nn.softmax(logits, axis=-1)
        return jnp.einsum('bhqk,bkhd->bqhd', w.astype(v.dtype), v)

    out = lax.map(one_block, (jnp.arange(n_blk), q_blocks, c_blocks))
    return out.transpose(1, 0, 2, 3, 4).reshape(b, s, h, dh)


def s5_mixer(u, lam_re, lam_im, log_dt, b_re, b_im, c_re, c_im, d_skip, w_glu, b_glu):
    bsz, s, _ = u.shape
    f32 = jnp.float32
    uf = u.astype(f32).reshape(bsz, s, N_SSM_GROUPS, SSM_GROUP)
    dt = jnp.exp(log_dt.astype(f32))[:, None]
    lr = lam_re.astype(f32)
    li = lam_im.astype(f32)
    mag = jnp.exp(lr * dt)
    ab_re = mag * jnp.cos(li * dt)
    ab_im = mag * jnp.sin(li * dt)
    den = lr * lr + li * li
    nr = ab_re - 1.0
    z_re = (nr * lr + ab_im * li) / den
    z_im = (ab_im * lr - nr * li) / den
    br = b_re.astype(f32)
    bi = b_im.astype(f32)
    bb_re = z_re[..., None] * br - z_im[..., None] * bi
    bb_im = z_re[..., None] * bi + z_im[..., None] * br
    bu_re = jnp.einsum('bsgc,gpc->bsgp', uf, bb_re)
    bu_im = jnp.einsum('bsgc,gpc->bsgp', uf, bb_im)
    a_re = jnp.broadcast_to(ab_re, (1, s) + ab_re.shape)
    a_im = jnp.broadcast_to(ab_im, (1, s) + ab_im.shape)

    def combine(e1, e2):
        a1r, a1i, b1r, b1i = e1
        a2r, a2i, b2r, b2i = e2
        return (a2r * a1r - a2i * a1i,
                a2r * a1i + a2i * a1r,
                a2r * b1r - a2i * b1i + b2r,
                a2r * b1i + a2i * b1r + b2i)

    _, _, x_re, x_im = lax.associative_scan(combine, (a_re, a_im, bu_re, bu_im), axis=1)
    y = (jnp.einsum('bsgp,gcp->bsgc', x_re, c_re.astype(f32))
         - jnp.einsum('bsgp,gcp->bsgc', x_im, c_im.astype(f32)))
    y = y.reshape(bsz, s, SSM_WIDTH) + d_skip.astype(f32) * u.astype(f32)
    g = jax.nn.gelu(y)
    out = g * jax.nn.sigmoid(g @ w_glu.astype(f32) + b_glu.astype(f32))
    return out.astype(u.dtype)


def clamped_swiglu(gu):
    gate = jnp.minimum(gu[:, :D_FF], SWIGLU_LIMIT)
    up = jnp.clip(gu[:, D_FF:], -SWIGLU_LIMIT, SWIGLU_LIMIT)
    return gate * jax.nn.sigmoid(SWIGLU_ALPHA * gate) * (up + 1.0)


def moe_ffn(h, w_router, b_router, w_gu, b_gu, w_dn, b_dn):
    t, d = h.shape
    logits = (h @ w_router + b_router).astype(jnp.float32)
    top_val, top_idx = lax.top_k(logits, TOP_K)
    gates = jax.nn.softmax(top_val, axis=-1)
    n_assign = t * TOP_K
    flat_e = top_idx.reshape(-1)
    flat_tok = jnp.broadcast_to(jnp.arange(t, dtype=jnp.int32)[:, None], (t, TOP_K)).reshape(-1)
    flat_g = gates.reshape(-1)
    order = jnp.argsort(flat_e)
    se = flat_e[order]
    stok = flat_tok[order]
    sg = flat_g[order]
    counts = jnp.bincount(flat_e, length=N_EXPERTS)
    starts = jnp.cumsum(counts) - counts
    padded = (counts + MOE_BLOCK - 1) // MOE_BLOCK * MOE_BLOCK
    pad_end = jnp.cumsum(padded)
    pad_start = pad_end - padded
    dest = pad_start[se] + jnp.arange(n_assign) - starts[se]
    cap = n_assign + N_EXPERTS * MOE_BLOCK
    n_blocks = cap // MOE_BLOCK
    row_tok = jnp.full((cap,), t, dtype=jnp.int32).at[dest].set(stok)
    row_gate = jnp.zeros((cap,), jnp.float32).at[dest].set(sg)
    blk_expert = jnp.minimum(
        jnp.searchsorted(pad_end, jnp.arange(n_blocks) * MOE_BLOCK, side='right'),
        N_EXPERTS - 1)
    h_pad = jnp.concatenate([h, jnp.zeros((1, d), h.dtype)], axis=0)

    def expert_block(args):
        e, toks = args
        xb = h_pad[toks]
        act = clamped_swiglu(xb @ w_gu[e] + b_gu[e])
        return act @ w_dn[e] + b_dn[e]

    y = lax.map(expert_block, (blk_expert, row_tok.reshape(n_blocks, MOE_BLOCK)))
    y = y.reshape(cap, d) * row_gate[:, None].astype(y.dtype)
    return jnp.zeros((t + 1, d), y.dtype).at[row_tok].add(y)[:t]


def setup_inputs(seed: int = 0) -> dict:
    key = jax.random.key(seed)
    ks = jax.random.split(key, 32)
    f32 = jnp.float32
    nrm = lambda k, shape, scale: jax.random.normal(k, shape, f32) * scale
    G, P, C = N_SSM_GROUPS, SSM_STATE, SSM_GROUP
    x = nrm(ks[0], (BATCH, SEQ, D_MODEL), 1.0)
    p = nrm(ks[1], (DEPTH, BATCH, SEQ, PLE_DIM), 1.0)
    norm_mix_g = 1.0 + nrm(ks[2], (DEPTH, D_MODEL), 0.02)
    w_in = nrm(ks[3], (DEPTH, D_MODEL, IN_WIDTH), D_MODEL ** -0.5)
    b_f = jnp.linspace(1.0, 6.0, N_HEADS, dtype=f32)[None, :] + nrm(ks[4], (DEPTH, N_HEADS), 0.1)
    lam_re = -0.5 + nrm(ks[5], (DEPTH, G, P), 0.01)
    lam_im = jnp.broadcast_to(math.pi * jnp.arange(P, dtype=f32), (DEPTH, G, P)) + nrm(ks[6], (DEPTH, G, P), 0.01)
    log_dt = jax.random.uniform(ks[7], (DEPTH, G), f32, math.log(DT_MIN), math.log(DT_MAX))
    b_re = nrm(ks[8], (DEPTH, G, P, C), (2 * C) ** -0.5)
    b_im = nrm(ks[9], (DEPTH, G, P, C), (2 * C) ** -0.5)
    c_re = nrm(ks[10], (DEPTH, G, C, P), (2 * P) ** -0.5)
    c_im = nrm(ks[11], (DEPTH, G, C, P), (2 * P) ** -0.5)
    d_skip = nrm(ks[12], (DEPTH, SSM_WIDTH), 1.0)
    w_glu = nrm(ks[13], (DEPTH, SSM_WIDTH, SSM_WIDTH), SSM_WIDTH ** -0.5)
    b_glu = nrm(ks[14], (DEPTH, SSM_WIDTH), 0.01)
    attn_out_g = 1.0 + nrm(ks[15], (DEPTH, ATTN_WIDTH), 0.02)
    ssm_out_g = 1.0 + nrm(ks[16], (DEPTH, SSM_WIDTH), 0.02)
    w_out = nrm(ks[17], (DEPTH, MIX_WIDTH, D_MODEL), MIX_WIDTH ** -0.5)
    norm_ffn_g = 1.0 + nrm(ks[18], (DEPTH, D_MODEL), 0.02)
    w_router = nrm(ks[19], (DEPTH, D_MODEL, N_EXPERTS), D_MODEL ** -0.5)
    b_router = nrm(ks[20], (DEPTH, N_EXPERTS), 0.01)
    w_gu = nrm(ks[21], (DEPTH, N_EXPERTS, D_MODEL, 2 * D_FF), D_MODEL ** -0.5)
    b_gu = nrm(ks[22], (DEPTH, N_EXPERTS, 2 * D_FF), 0.01)
    w_dn = nrm(ks[23], (DEPTH, N_EXPERTS, D_FF, D_MODEL), D_FF ** -0.5)
    b_dn = nrm(ks[24], (DEPTH, N_EXPERTS, D_MODEL), 0.01)
    norm_ple_g = 1.0 + nrm(ks[25], (DEPTH, D_MODEL), 0.02)
    w_ple_gate = nrm(ks[26], (DEPTH, D_MODEL, D_MODEL), D_MODEL ** -0.5)
    w_ple_proj = nrm(ks[27], (DEPTH, PLE_DIM, D_MODEL), PLE_DIM ** -0.5)
    norm_final_g = 1.0 + nrm(ks[28], (D_MODEL,), 0.02)
    return {"x": x, "p": p, "norm_mix_g": norm_mix_g, "w_in": w_in, "b_f": b_f,
            "lam_re": lam_re, "lam_im": lam_im, "log_dt": log_dt,
            "b_re": b_re, "b_im": b_im, "c_re": c_re, "c_im": c_im,
            "d_skip": d_skip, "w_glu": w_glu, "b_glu": b_glu,
            "attn_out_g": attn_out_g, "ssm_out_g": ssm_out_g, "w_out": w_out,
            "norm_ffn_g": norm_ffn_g, "w_router": w_router, "b_router": b_router,
            "w_gu": w_gu, "b_gu": b_gu, "w_dn": w_dn, "b_dn": b_dn,
            "norm_ple_g": norm_ple_g, "w_ple_gate": w_ple_gate, "w_ple_proj": w_ple_proj,
            "norm_final_g": norm_final_g}


def reference(x, p, norm_mix_g, w_in, b_f, lam_re, lam_im, log_dt, b_re, b_im, c_re, c_im,
              d_skip, w_glu, b_glu, attn_out_g, ssm_out_g, w_out, norm_ffn_g,
              w_router, b_router, w_gu, b_gu, w_dn, b_dn,
              norm_ple_g, w_ple_gate, w_ple_proj, norm_final_g):
    bsz, s, d = x.shape
    split_at = [ATTN_WIDTH, 2 * ATTN_WIDTH, 3 * ATTN_WIDTH, 3 * ATTN_WIDTH + N_HEADS]
    for i in range(DEPTH):
        h = rmsnorm(x, norm_mix_g[i])
        proj = h @ w_in[i]
        q, k, v, f_logit, u = jnp.split(proj, split_at, axis=-1)
        q = q.reshape(bsz, s, N_HEADS, HEAD_DIM)
        k = k.reshape(bsz, s, N_HEADS, HEAD_DIM)
        v = v.reshape(bsz, s, N_HEADS, HEAD_DIM)
        log_f = jax.nn.log_sigmoid(f_logit.astype(jnp.float32) + b_f[i].astype(jnp.float32))
        attn = forgetting_attention(q, k, v, log_f).reshape(bsz, s, ATTN_WIDTH)
        ssm = s5_mixer(u, lam_re[i], lam_im[i], log_dt[i], b_re[i], b_im[i], c_re[i], c_im[i],
                       d_skip[i], w_glu[i], b_glu[i])
        mixed = jnp.concatenate([rmsnorm(attn, attn_out_g[i]), rmsnorm(ssm, ssm_out_g[i])], axis=-1)
        x = x + mixed @ w_out[i]
        h = rmsnorm(x, norm_ffn_g[i]).reshape(bsz * s, d)
        x = x + moe_ffn(h, w_router[i], b_router[i], w_gu[i], b_gu[i], w_dn[i], b_dn[i]).reshape(bsz, s, d)
        gate = jax.nn.sigmoid(rmsnorm(x, norm_ple_g[i]) @ w_ple_gate[i])
        x = x + gate * (p[i] @ w_ple_proj[i])
    return rmsnorm(x, norm_final_g)
```

```cpp
#include <hip/hip_runtime.h>
#include <hip/hip_cooperative_groups.h>
#include <cstdio>
#include <cstdint>
namespace cg = cooperative_groups;

constexpr int NB = 8, S = 4096, T = NB * S, D = 1024, NH = 8, HD = 64, AW = 512, SW = 512, INW = 2056;
constexpr int NG = 32, NP = 64, NC = 16, NE = 32, TOPK = 4, DFF = 1024, PLE = 256;
constexpr int COL_K = 512, COL_V = 1024, COL_F = 1536, COL_U = 1544;
constexpr float EPS = 1e-5f;
constexpr int NTHR = 512, NWAVE = 8;
constexpr int MB = 128;
constexpr int CAP = T * TOPK + NE * MB;
constexpr int MAXTILES = CAP / MB;

typedef unsigned short bf16_t;
__device__ __forceinline__ bf16_t f2bf(float f) { unsigned u = __builtin_bit_cast(unsigned, f); return (bf16_t)((u + 0x7fffu + ((u >> 16) & 1u)) >> 16); }
__device__ __forceinline__ float bf2f(bf16_t b) { return __builtin_bit_cast(float, (unsigned)b << 16); }
__device__ __forceinline__ float ldf(const float* p, size_t i) { return p[i]; }
__device__ __forceinline__ float ldf(const bf16_t* p, size_t i) { return bf2f(p[i]); }

constexpr size_t MiB = 1u << 20;
constexpr size_t WS_CTL = 0;
constexpr size_t WS_XN = 1 * MiB;
constexpr size_t WS_PROJ = 129 * MiB;
constexpr size_t WS_C = 386 * MiB;
constexpr size_t WS_MIX = 387 * MiB;
constexpr size_t WS_G = 515 * MiB;
constexpr size_t WS_X1 = 579 * MiB;
constexpr size_t WS_TOPI = 707 * MiB;
constexpr size_t WS_TOPG = 707 * MiB + 512 * 1024;
constexpr size_t WS_ROWTOK = 708 * MiB;
constexpr size_t WS_ROWGATE = 709 * MiB;
constexpr size_t WS_Y = 710 * MiB;
constexpr size_t WS_END = 966 * MiB;
constexpr int CT_COUNT = 0, CT_CURSOR = 64, CT_PADSTART = 128, CT_NTILES = 192, CT_TILEEXP = 256;

struct Params {
    const float* in[29];
    float* out;
    unsigned char* ws;
};

__device__ __forceinline__ float wave_sum(float v) {
#pragma unroll
    for (int o = 1; o < 64; o <<= 1) v += __shfl_xor(v, o);
    return v;
}
__device__ __forceinline__ float wave_max(float v) {
#pragma unroll
    for (int o = 1; o < 64; o <<= 1) v = fmaxf(v, __shfl_xor(v, o));
    return v;
}

__device__ void rms_rows(const float* in, int ldi, const float* g, float* out, int ldo, int ncols, int nrows, int gw, int ngw, int lane) {
    for (int r = gw; r < nrows; r += ngw) {
        const float* row = in + (size_t)r * ldi; float ss = 0.f;
        for (int c = lane; c < ncols; c += 64) { const float v = row[c]; ss += v * v; }
        ss = wave_sum(ss);
        const float rs = rsqrtf(ss / (float)ncols + EPS);
        float* orow = out + (size_t)r * ldo;
        for (int c = lane; c < ncols; c += 64) orow[c] = row[c] * rs * g[c];
    }
}

template <class AT, bool DUAL, class RowFn, class Epi>
__device__ void gemm_tile(const AT* A, int lda, RowFn arow, const float* B, int ldb, int K, int m0, int n0, int n1, int Nmax, float* sm, Epi epi) {
    float* As = sm;
    float* Bs = sm + 16 * 132;
    float* Bs2 = Bs + 16 * 128;
    const int tid = threadIdx.x, ty = tid >> 4, tx = tid & 15;
    float acc[4][8], acc2[4][8];
#pragma unroll
    for (int i = 0; i < 4; ++i)
#pragma unroll
        for (int j = 0; j < 8; ++j) { acc[i][j] = 0.f; acc2[i][j] = 0.f; }
    const int ar = tid >> 2, ak = (tid & 3) * 4;
    const int srow = arow(m0 + ar);
    const int bk = tid >> 5, bn = (tid & 31) * 4;
    for (int k0 = 0; k0 < K; k0 += 16) {
        float a4[4];
#pragma unroll
        for (int j = 0; j < 4; ++j) a4[j] = (srow >= 0) ? ldf(A, (size_t)srow * lda + k0 + ak + j) : 0.f;
        float b4[4], c4[4];
#pragma unroll
        for (int j = 0; j < 4; ++j) { const int col = n0 + bn + j; b4[j] = (col < Nmax) ? B[(size_t)(k0 + bk) * ldb + col] : 0.f; }
        if (DUAL) {
#pragma unroll
            for (int j = 0; j < 4; ++j) c4[j] = B[(size_t)(k0 + bk) * ldb + n1 + bn + j];
        }
        __syncthreads();
#pragma unroll
        for (int j = 0; j < 4; ++j) As[(ak + j) * 132 + ar] = a4[j];
#pragma unroll
        for (int j = 0; j < 4; ++j) Bs[bk * 128 + bn + j] = b4[j];
        if (DUAL) {
#pragma unroll
            for (int j = 0; j < 4; ++j) Bs2[bk * 128 + bn + j] = c4[j];
        }
        __syncthreads();
#pragma unroll 2
        for (int kk = 0; kk < 16; ++kk) {
            float a[4], b[8];
#pragma unroll
            for (int i = 0; i < 4; ++i) a[i] = As[kk * 132 + ty * 4 + i];
#pragma unroll
            for (int j = 0; j < 8; ++j) b[j] = Bs[kk * 128 + tx * 8 + j];
#pragma unroll
            for (int i = 0; i < 4; ++i)
#pragma unroll
                for (int j = 0; j < 8; ++j) acc[i][j] += a[i] * b[j];
            if (DUAL) {
#pragma unroll
                for (int j = 0; j < 8; ++j) b[j] = Bs2[kk * 128 + tx * 8 + j];
#pragma unroll
                for (int i = 0; i < 4; ++i)
#pragma unroll
                    for (int j = 0; j < 8; ++j) acc2[i][j] += a[i] * b[j];
            }
        }
    }
    __syncthreads();
#pragma unroll
    for (int i = 0; i < 4; ++i)
#pragma unroll
        for (int j = 0; j < 8; ++j) epi(m0 + ty * 4 + i, tx * 8 + j, acc[i][j], acc2[i][j]);
}

struct RowId { __device__ int operator()(int r) const { return r; } };
struct RowTok { const int* rowtok; __device__ int operator()(int r) const { const int id = rowtok[r]; return id < 0 ? -1 : (id >> 2); } };
struct RowSlot { const int* rowtok; __device__ int operator()(int r) const { return rowtok[r] < 0 ? -1 : r; } };

__device__ __forceinline__ float sigmoidf_(float x) { return 1.f / (1.f + __expf(-x)); }

__global__ void __launch_bounds__(NTHR) fwd_naive(Params P) {
    cg::grid_group grid = cg::this_grid();
    __shared__ float sm[16 * 132 + 2 * 16 * 128 + 8 * 1024];
    __shared__ int ism[64];
    const int tid = threadIdx.x, lane = tid & 63, wave = tid >> 6;
    const int nblk = gridDim.x, blk = blockIdx.x;
    const int gw = blk * NWAVE + wave, ngw = nblk * NWAVE;
    unsigned char* ws = P.ws;
    int* ctl = (int*)(ws + WS_CTL);
    float* xn = (float*)(ws + WS_XN);
    float* proj = (float*)(ws + WS_PROJ);
    float* cbuf = (float*)(ws + WS_C);
    float* mix = (float*)(ws + WS_MIX);
    float* gbuf = (float*)(ws + WS_G);
    float* x1 = (float*)(ws + WS_X1);
    int* topi = (int*)(ws + WS_TOPI);
    float* topg = (float*)(ws + WS_TOPG);
    int* rowtok = (int*)(ws + WS_ROWTOK);
    float* rowgate = (float*)(ws + WS_ROWGATE);
    bf16_t* act = (bf16_t*)(ws + WS_XN);
    bf16_t* Y = (bf16_t*)(ws + WS_Y);
    float* Gs = (float*)(ws + WS_XN);
    const float* x = P.in[0]; const float* pin = P.in[1]; const float* norm_mix_g = P.in[2]; const float* w_in = P.in[3]; const float* b_f = P.in[4];
    const float* lam_re = P.in[5]; const float* lam_im = P.in[6]; const float* log_dt = P.in[7]; const float* b_re = P.in[8]; const float* b_im = P.in[9];
    const float* c_re = P.in[10]; const float* c_im = P.in[11]; const float* d_skip = P.in[12]; const float* w_glu = P.in[13]; const float* b_glu = P.in[14];
    const float* attn_out_g = P.in[15]; const float* ssm_out_g = P.in[16]; const float* w_out = P.in[17]; const float* norm_ffn_g = P.in[18];
    const float* w_router = P.in[19]; const float* b_router = P.in[20]; const float* w_gu = P.in[21]; const float* b_gu = P.in[22];
    const float* w_dn = P.in[23]; const float* b_dn = P.in[24]; const float* norm_ple_g = P.in[25]; const float* w_ple_gate = P.in[26];
    const float* w_ple_proj = P.in[27]; const float* norm_final_g = P.in[28];

    if (blk == 0 && tid < 128) ctl[tid] = 0;
    rms_rows(x, D, norm_mix_g, xn, D, D, T, gw, ngw, lane);
    grid.sync();

    {
        const int nN = (INW + 127) / 128, nM = T / 128;
        for (int vb = blk; vb < nM * nN; vb += nblk) {
            const int mt = vb / nN, nt = vb % nN;
            auto epi = [&](int r, int c, float a, float) { const int col = nt * 128 + c; if (col < INW) proj[(size_t)r * INW + col] = a; };
            gemm_tile<float, false>(xn, D, RowId{}, w_in, INW, D, mt * 128, nt * 128, 0, INW, sm, epi);
        }
    }
    grid.sync();

    for (int j = gw; j < NB * NH; j += ngw) {
        const int b = j / NH, h = j % NH; const float bf = b_f[h];
        float tot = 0.f;
        for (int i = 0; i < 64; ++i) { const int t = lane * 64 + i; const float z = proj[(size_t)(b * S + t) * INW + COL_F + h] + bf; tot += fminf(z, 0.f) - log1pf(__expf(-fabsf(z))); }
        float incl = tot;
#pragma unroll
        for (int o = 1; o < 64; o <<= 1) { const float n = __shfl_up(incl, o); if (lane >= o) incl += n; }
        float run = incl - tot;
        for (int i = 0; i < 64; ++i) { const int t = lane * 64 + i; const float z = proj[(size_t)(b * S + t) * INW + COL_F + h] + bf; run += fminf(z, 0.f) - log1pf(__expf(-fabsf(z))); cbuf[(size_t)j * S + t] = run; }
    }
    grid.sync();

    for (int j = wave * nblk + blk; j < NB * NG; j += ngw) {
        const int b = j / NG, g = j % NG, p = lane;
        const float dt = __expf(log_dt[g]); const float lr = lam_re[g * NP + p], li = lam_im[g * NP + p];
        const float mag = __expf(lr * dt); const float abr = mag * cosf(li * dt), abi = mag * sinf(li * dt);
        const float den = lr * lr + li * li, nr = abr - 1.f; const float zr = (nr * lr + abi * li) / den, zi = (abi * lr - nr * li) / den;
        float bbr[NC], bbi[NC], cr[NC], ci[NC];
#pragma unroll
        for (int c = 0; c < NC; ++c) { const float br = b_re[(size_t)(g * NP + p) * NC + c], bi = b_im[(size_t)(g * NP + p) * NC + c]; bbr[c] = zr * br - zi * bi; bbi[c] = zr * bi + zi * br;
            cr[c] = c_re[(size_t)(g * NC + c) * NP + p]; ci[c] = c_im[(size_t)(g * NC + c) * NP + p]; }
        const float dsk = (lane < NC) ? d_skip[g * NC + lane] : 0.f;
        float xr = 0.f, xi = 0.f;
        for (int t = 0; t < S; ++t) {
            const float* up = proj + (size_t)(b * S + t) * INW + COL_U + g * NC;
            const float ul = (lane < NC) ? up[lane] : 0.f;
            float bur = 0.f, bui = 0.f;
#pragma unroll
            for (int c = 0; c < NC; ++c) { const float uc = __shfl(ul, c); bur += bbr[c] * uc; bui += bbi[c] * uc; }
            const float nxr = abr * xr - abi * xi + bur, nxi = abr * xi + abi * xr + bui; xr = nxr; xi = nxi;
            float yv = 0.f;
#pragma unroll
            for (int c = 0; c < NC; ++c) { const float s = wave_sum(cr[c] * xr - ci[c] * xi); if (lane == c) yv = s; }
            if (lane < NC) { const float y = yv + dsk * ul; const float gl = 0.5f * y * (1.f + tanhf(0.7978845608028654f * (y + 0.044715f * y * y * y))); gbuf[(size_t)(b * S + t) * SW + g * NC + lane] = gl; }
        }
    }
    {
        float* wbuf = sm + 16 * 132 + 2 * 16 * 128 + wave * 1024;
        for (int row = gw; row < NB * NH * S; row += ngw) {
            const int bh = row / S, t = row % S, b = bh / NH, h = bh % NH;
            const float* qp = proj + (size_t)(b * S + t) * INW + h * HD;
            wbuf[lane] = qp[lane] * 0.125f;
            const float ct = cbuf[(size_t)bh * S + t];
            float m = -INFINITY, l = 0.f, o = 0.f;
            for (int s0 = 0; s0 <= t; s0 += 64) {
                const int s = s0 + lane;
                const float* kp = proj + (size_t)(b * S + s) * INW + COL_K + h * HD;
                float dot = 0.f;
#pragma unroll 8
                for (int d = 0; d < HD; d += 4) { const float4 kv = *(const float4*)(kp + d); dot += wbuf[d] * kv.x + wbuf[d + 1] * kv.y + wbuf[d + 2] * kv.z + wbuf[d + 3] * kv.w; }
                float lg = (s <= t) ? dot + ct - cbuf[(size_t)bh * S + s] : -INFINITY;
                const float gm = wave_max(lg); const float mn = fmaxf(m, gm);
                const float alpha = __expf(m - mn); const float pe = __expf(lg - mn);
                l = l * alpha + wave_sum(pe); o *= alpha; m = mn;
                const float* vp = proj + (size_t)(b * S + s0) * INW + COL_V + h * HD + lane;
                const int nk = (t - s0 + 1) < 64 ? (t - s0 + 1) : 64;
                for (int j = 0; j < nk; ++j) o += __shfl(pe, j) * vp[(size_t)j * INW];
            }
            mix[(size_t)(b * S + t) * D + h * HD + lane] = o / l;
        }
    }
    grid.sync();

    {
        const int nN = SW / 128, nM = T / 128;
        for (int vb = blk; vb < nM * nN; vb += nblk) {
            const int mt = vb / nN, nt = vb % nN;
            auto epi = [&](int r, int c, float a, float) { const int col = nt * 128 + c; const float gv = gbuf[(size_t)r * SW + col]; mix[(size_t)r * D + AW + col] = gv * sigmoidf_(a + b_glu[col]); };
            gemm_tile<float, false>(gbuf, SW, RowId{}, w_glu, SW, SW, mt * 128, nt * 128, 0, SW, sm, epi);
        }
    }
    grid.sync();

    rms_rows(mix, D, attn_out_g, mix, D, AW, T, gw, ngw, lane);
    rms_rows(mix + AW, D, ssm_out_g, mix + AW, D, SW, T, gw, ngw, lane);
    grid.sync();

    {
        const int nN = D / 128, nM = T / 128;
        for (int vb = blk; vb < nM * nN; vb += nblk) {
            const int mt = vb / nN, nt = vb % nN;
            auto epi = [&](int r, int c, float a, float) { const size_t i = (size_t)r * D + nt * 128 + c; x1[i] = x[i] + a; };
            gemm_tile<float, false>(mix, D, RowId{}, w_out, D, D, mt * 128, nt * 128, 0, D, sm, epi);
        }
    }
    grid.sync();

    for (int i = blk * NTHR + tid; i < CAP; i += nblk * NTHR) { rowtok[i] = -1; rowgate[i] = 0.f; }
    {
        float* wbuf = sm + 16 * 132 + 2 * 16 * 128 + wave * 1024;
        for (int r = gw; r < T; r += ngw) {
            const float* row = x1 + (size_t)r * D; float ss = 0.f;
            for (int c = lane; c < D; c += 64) { const float v = row[c]; ss += v * v; }
            ss = wave_sum(ss); const float rs = rsqrtf(ss / (float)D + EPS);
            for (int c = lane; c < D; c += 64) { const float hv = row[c] * rs * norm_ffn_g[c]; wbuf[c] = hv; mix[(size_t)r * D + c] = hv; }
            const int e = lane & 31, kh = lane >> 5; float part = 0.f;
            for (int k = kh * 512; k < kh * 512 + 512; ++k) part += wbuf[k] * w_router[(size_t)k * NE + e];
            part += __shfl_xor(part, 32);
            float lg = (lane < 32) ? part + b_router[e] : -INFINITY;
            float tv[TOPK]; int ti[TOPK];
#pragma unroll
            for (int k = 0; k < TOPK; ++k) { const float mx = wave_max(lg); const unsigned long long bm = __ballot(lg == mx); const int idx = __ffsll((long long)bm) - 1; tv[k] = mx; ti[k] = idx; if (lane == idx) lg = -INFINITY; }
            float es[TOPK], den = 0.f;
#pragma unroll
            for (int k = 0; k < TOPK; ++k) { es[k] = __expf(tv[k] - tv[0]); den += es[k]; }
            if (lane < TOPK) {
                float gsel = es[0]; int isel = ti[0];
#pragma unroll
                for (int k = 1; k < TOPK; ++k) if (lane == k) { gsel = es[k]; isel = ti[k]; }
                topi[(size_t)r * TOPK + lane] = isel; topg[(size_t)r * TOPK + lane] = gsel / den;
                atomicAdd(&ctl[CT_COUNT + isel], 1);
            }
        }
    }
    grid.sync();

    if (tid == 0) {
        int run = 0;
        for (int e = 0; e < NE; ++e) { ism[e] = run; const int cnt = ctl[CT_COUNT + e]; run += (cnt + MB - 1) / MB * MB; }
        ism[NE] = run;
        if (blk == 0) {
            for (int e = 0; e <= NE; ++e) ctl[CT_PADSTART + e] = ism[e];
            ctl[CT_NTILES] = run / MB;
            for (int e = 0; e < NE; ++e) for (int tt = ism[e] / MB; tt < ism[e + 1] / MB; ++tt) ctl[CT_TILEEXP + tt] = e;
        }
    }
    __syncthreads();
    for (int i = blk * NTHR + tid; i < T * TOPK; i += nblk * NTHR) {
        const int e = topi[i]; const int pos = atomicAdd(&ctl[CT_CURSOR + e], 1); const int slot = ism[e] + pos;
        rowtok[slot] = i; rowgate[slot] = topg[i];
    }
    grid.sync();

    {
        const int ntiles = ctl[CT_NTILES], nN = DFF / 128;
        for (int vb = blk; vb < ntiles * nN; vb += nblk) {
            const int mt = vb / nN, nt = vb % nN; const int e = ctl[CT_TILEEXP + mt];
            const float* Bw = w_gu + (size_t)e * D * (2 * DFF); const float* bias = b_gu + (size_t)e * 2 * DFF;
            auto epi = [&](int r, int c, float a, float a2) { const int col = nt * 128 + c;
                const float gate = fminf(a + bias[col], 7.f); const float up = fminf(fmaxf(a2 + bias[DFF + col], -7.f), 7.f);
                act[(size_t)r * DFF + col] = f2bf(gate * sigmoidf_(1.702f * gate) * (up + 1.f)); };
            gemm_tile<float, true>(mix, D, RowTok{rowtok}, Bw, 2 * DFF, D, mt * 128, nt * 128, DFF + nt * 128, 2 * DFF, sm, epi);
        }
    }
    grid.sync();

    {
        const int ntiles = ctl[CT_NTILES], nN = D / 128;
        for (int vb = blk; vb < ntiles * nN; vb += nblk) {
            const int mt = vb / nN, nt = vb % nN; const int e = ctl[CT_TILEEXP + mt];
            const float* Bw = w_dn + (size_t)e * DFF * D; const float* bias = b_dn + (size_t)e * D;
            auto epi = [&](int r, int c, float a, float) { const int id = rowtok[r]; if (id >= 0) { const int col = nt * 128 + c; Y[(size_t)id * D + col] = f2bf((a + bias[col]) * rowgate[r]); } };
            gemm_tile<bf16_t, false>(act, DFF, RowSlot{rowtok}, Bw, D, DFF, mt * 128, nt * 128, 0, D, sm, epi);
        }
    }
    grid.sync();

    for (int r = gw; r < T; r += ngw) {
        float* row = x1 + (size_t)r * D; float ss = 0.f;
        for (int c = lane; c < D; c += 64) { float v = row[c];
#pragma unroll
            for (int k = 0; k < TOPK; ++k) v += bf2f(Y[((size_t)r * TOPK + k) * D + c]);
            row[c] = v; ss += v * v; }
        ss = wave_sum(ss); const float rs = rsqrtf(ss / (float)D + EPS);
        for (int c = lane; c < D; c += 64) mix[(size_t)r * D + c] = row[c] * rs * norm_ple_g[c];
    }
    grid.sync();

    {
        const int nN = D / 128, nM = T / 128;
        for (int vb = blk; vb < nM * nN; vb += nblk) {
            const int mt = vb / nN, nt = vb % nN;
            auto epi = [&](int r, int c, float a, float) { Gs[(size_t)r * D + nt * 128 + c] = sigmoidf_(a); };
            gemm_tile<float, false>(mix, D, RowId{}, w_ple_gate, D, D, mt * 128, nt * 128, 0, D, sm, epi);
        }
    }
    grid.sync();

    {
        const int nN = D / 128, nM = T / 128;
        for (int vb = blk; vb < nM * nN; vb += nblk) {
            const int mt = vb / nN, nt = vb % nN;
            auto epi = [&](int r, int c, float a, float) { const size_t i = (size_t)r * D + nt * 128 + c; x1[i] = x1[i] + Gs[i] * a; };
            gemm_tile<float, false>(pin, PLE, RowId{}, w_ple_proj, D, PLE, mt * 128, nt * 128, 0, D, sm, epi);
        }
    }
    grid.sync();

    rms_rows(x1, D, norm_final_g, P.out, D, D, T, gw, ngw, lane);
}

extern "C" void kernel_launch(void* const* d_in, const int* in_sizes, int n_in, void* d_out, int out_size, void* d_ws, size_t ws_size, hipStream_t stream) {
    static int grid = 0;
    if (grid == 0) {
        int dev = 0, cus = 0, per_cu = 0;
        hipGetDevice(&dev);
        hipDeviceGetAttribute(&cus, hipDeviceAttributeMultiprocessorCount, dev);
        hipOccupancyMaxActiveBlocksPerMultiprocessor(&per_cu, (const void*)fwd_naive, NTHR, 0);
        if (per_cu < 1) per_cu = 1;
        if (per_cu > 2) per_cu = 2;
        grid = cus * per_cu;
        if (n_in != 29 || ws_size < WS_END) { fprintf(stderr, "kernel_launch: unexpected n_in %d or ws_size %zu\n", n_in, ws_size); }
    }
    Params p{};
    for (int i = 0; i < 29; ++i) p.in[i] = (const float*)d_in[i];
    p.out = (float*)d_out; p.ws = (unsigned char*)d_ws;
    void* args[] = {&p};
    hipError_t e = hipLaunchCooperativeKernel((const void*)fwd_naive, dim3(grid), dim3(NTHR), args, 0, stream);
    if (e != hipSuccess) fprintf(stderr, "cooperative launch failed: %s (grid %d)\n", hipGetErrorString(e), grid);
}
```

```cpp
#include <hip/hip_runtime.h>
#include <hip/hip_cooperative_groups.h>
#include <cstdio>
#include <cstdint>
namespace cg = cooperative_groups;

constexpr int NB = 8, S = 4096, T = NB * S, D = 1024, NH = 8, HD = 64, AW = 512, SW = 512, INW = 2056;
constexpr int NG = 32, NP = 64, NC = 16, NE = 32, TOPK = 4, DFF = 1024, PLE = 256;
constexpr int COL_K = 512, COL_V = 1024, COL_F = 1536, COL_U = 1544;
constexpr float EPS = 1e-5f;
constexpr int NTHR = 512, NWAVE = 8;
constexpr int MB = 256;
constexpr int CAP = T * TOPK + NE * MB;
constexpr int MAXTILES = CAP / MB;
constexpr int LDS_BYTES = 147456;

typedef unsigned short bf16_t;
__device__ __forceinline__ bf16_t f2bf(float f) { unsigned u = __builtin_bit_cast(unsigned, f); return (bf16_t)((u + 0x7fffu + ((u >> 16) & 1u)) >> 16); }
__device__ __forceinline__ float bf2f(bf16_t b) { return __builtin_bit_cast(float, (unsigned)b << 16); }
__device__ __forceinline__ unsigned pk2(float lo, float hi) { return (unsigned)f2bf(lo) | ((unsigned)f2bf(hi) << 16); }
__device__ __forceinline__ float ldf(const float* p, size_t i) { return p[i]; }
__device__ __forceinline__ float ldf(const bf16_t* p, size_t i) { return bf2f(p[i]); }

constexpr size_t MiB = 1u << 20;
constexpr size_t WS_CTL = 0;
constexpr size_t WS_WIN = 1 * MiB;
constexpr size_t WS_WGLU = 5 * MiB;
constexpr size_t WS_WOUT = 6 * MiB;
constexpr size_t WS_WPG = 8 * MiB;
constexpr size_t WS_WPP = 10 * MiB;
constexpr size_t WS_WDN = 17 * MiB;
constexpr size_t WS_X1 = 81 * MiB;
constexpr size_t WS_TOPI = 209 * MiB;
constexpr size_t WS_TOPG = 209 * MiB + 512 * 1024;
constexpr size_t WS_ROWTOK = 210 * MiB;
constexpr size_t WS_ROWGATE = 211 * MiB;
constexpr size_t WS_ROWSRC = 212 * MiB;
constexpr size_t WS_ROWSCL = 213 * MiB;
constexpr size_t WS_R1 = 214 * MiB;
constexpr size_t WS_PSA = 215 * MiB;
constexpr size_t WS_PB = 216 * MiB;
constexpr size_t WS_LOGF = 232 * MiB;
constexpr size_t WS_C = 233 * MiB;
constexpr size_t WS_PSS = 234 * MiB;
constexpr size_t WS_A = 235 * MiB;
constexpr size_t WS_XN = WS_A;
constexpr size_t WS_Q = WS_A + 64 * MiB;
constexpr size_t WS_MIXB = WS_A + 192 * MiB;
constexpr size_t WS_GB = WS_A + 256 * MiB;
constexpr size_t WS_ACT = WS_A;
constexpr size_t WS_XN2 = WS_A;
constexpr size_t WS_GS = WS_A + 64 * MiB;
constexpr size_t WS_B = WS_A + 288 * MiB;
constexpr size_t WS_WGU = WS_B;
constexpr size_t WS_X1B = WS_B + 128 * MiB;
constexpr size_t WS_Y = WS_B;
constexpr size_t WS_MIXF = WS_B + 256 * MiB;
constexpr size_t WS_GF = WS_MIXF + 128 * MiB;
constexpr size_t WS_END = WS_GF + 64 * MiB;
static_assert((size_t)CAP * 4 <= MiB && (size_t)CAP * DFF * 2 <= 272 * MiB, "list arrays fit 1 MiB each; ACT fits");
constexpr int CT_COUNT = 0, CT_CURSOR = 64, CT_PADSTART = 128, CT_NTILES = 192, CT_TILEEXP = 256;
constexpr float LOG2E = 1.4426950408889634f, C2 = 0.125f * LOG2E;

namespace pg8 {
#define PG8_LAS __attribute__((address_space(3)))
typedef short bf16x8 __attribute__((ext_vector_type(8)));
typedef float f32x4 __attribute__((ext_vector_type(4)));
typedef unsigned u32x4 __attribute__((ext_vector_type(4)));
constexpr int BM = 256, BK = 64, HALF = 128, HTB = HALF * BK * 2, STAGE_BYTES = 8 * HTB, NXCD = 8, WGM = 8;
__device__ __forceinline__ int lds_byte(int r, int c) { const int st = (r >> 4) * 2 + (c >> 5), rr = r & 15, cc = c & 31, ob = rr * 64 + cc * 2; return st * 1024 + (ob ^ (((ob >> 9) & 1) << 5)); }
__device__ __forceinline__ void stage_rc(int b, int& R, int& C) { const int st = b / 1024, sb = b % 1024, swz = sb ^ (((sb >> 9) & 1) << 5); R = (st >> 1) * 16 + swz / 64; C = (st & 1) * 32 + (swz % 64) / 2; }
__device__ __forceinline__ int perm32(int rho) { const int n = rho >> 4, i = rho & 15; return 8 * (i >> 2) + 4 * n + (i & 3); }
struct Unit { int pm, pn, e; };
struct Order {
    int nM, nN, nwg, G, c; const int* texp;
    __device__ void init(int nM_, int nN_, int G_, int c_, const int* texp_) { nM = nM_; nN = nN_; nwg = nM * nN; G = G_; c = c_; texp = texp_; }
    __device__ bool next(int i, Unit& u) const {
        const long L = (long)i * G + c; if (L >= nwg) return false;
        int wgid = (int)L; { const int q = nwg / NXCD, r = nwg % NXCD, xcd = wgid % NXCD, off = wgid / NXCD; wgid = (xcd < r ? xcd * (q + 1) : r * (q + 1) + (xcd - r) * q) + off; }
        const int nig = WGM * nN, gid = wgid / nig, fm = gid * WGM, gsz = (nM - fm) < WGM ? (nM - fm) : WGM;
        u.pm = fm + ((wgid % nig) % gsz); u.pn = (wgid % nig) / gsz; u.e = texp ? __builtin_amdgcn_readfirstlane(texp[u.pm]) : 0; return true;
    }
};
struct DenseRows { __device__ __forceinline__ unsigned row(const Unit& u, int r) const { return (unsigned)(u.pm * BM + r); } };
struct GatherRows { const int* src; __device__ __forceinline__ unsigned row(const Unit& u, int r) const { return (unsigned)src[u.pm * BM + r]; } };
__device__ __forceinline__ unsigned cvt_pk_bf16(float lo, float hi) { unsigned r; asm volatile("v_cvt_pk_bf16_f32 %0, %1, %2" : "=v"(r) : "v"(lo), "v"(hi)); return r; }

template <class Epi, class ARow>
__device__ __forceinline__ void gemm_phase(PG8_LAS unsigned char* lds, const char* Abase, const char* Bbase, size_t b_estride, int K, const Order& S, const ARow& AR, const Epi& E) {
    int tid = threadIdx.x; asm volatile("" : "+v"(tid));
    const int wid = __builtin_amdgcn_readfirstlane(tid >> 6), lane = tid & 63, wr = wid >> 2, wc = wid & 3, fr = lane & 15, fq = lane >> 4;
    const int nt = K / BK;
    int Rr[2], Cc[2]; unsigned voffB[2];
#pragma unroll
    for (int i = 0; i < 2; ++i) { int R, C; stage_rc(tid * 16 + i * 8192, R, C); const int Rb = Epi::PERM ? ((R & ~31) + perm32(R & 31)) : R; Rr[i] = R; Cc[i] = C; voffB[i] = (unsigned)(Rb * K + C) * 2u; }
    const size_t kstep = (size_t)(BK * 2), hstep = (size_t)HALF * K * 2, tstep = 2 * hstep;
    const unsigned ldsw = (unsigned)wid * 1024u;
    const int aoff = lds_byte(wr * 64 + fr, fq * 8), boff = lds_byte(wc * 32 + fr, fq * 8);
#define PG8_SA(b, h) (((b) * 2 + (h)) * HTB)
#define PG8_SB(b, h) ((4 + (b) * 2 + (h)) * HTB)
#define PG8_STAGE(bufoff, gbase, voff) do { _Pragma("unroll") for (int _i = 0; _i < 2; ++_i) \
        __builtin_amdgcn_global_load_lds((const unsigned*)((const char*)(gbase) + (voff)[_i]), (PG8_LAS unsigned*)(lds + (bufoff) + ldsw + _i * 8192), 16, 0, 0); } while (0)
#define PG8_LDA(dst, b, h) do { _Pragma("unroll") for (int m = 0; m < 4; ++m) _Pragma("unroll") for (int k = 0; k < 2; ++k) dst[m][k] = *(const PG8_LAS bf16x8*)(lds + PG8_SA(b, h) + aoff + m * 2048 + k * 1024); } while (0)
#define PG8_LDB(dst, b, h) do { _Pragma("unroll") for (int n = 0; n < 2; ++n) _Pragma("unroll") for (int k = 0; k < 2; ++k) dst[n][k] = *(const PG8_LAS bf16x8*)(lds + PG8_SB(b, h) + boff + n * 2048 + k * 1024); } while (0)
#define PG8_MMA(ai, bj, At, Bt) do { __builtin_amdgcn_s_setprio(1); _Pragma("unroll") for (int m = 0; m < 4; ++m) _Pragma("unroll") for (int n = 0; n < 2; ++n) _Pragma("unroll") for (int k = 0; k < 2; ++k) \
        acc[ai][bj][m][n] = __builtin_amdgcn_mfma_f32_16x16x32_bf16(Bt[n][k], At[m][k], acc[ai][bj][m][n], 0, 0, 0); __builtin_amdgcn_s_setprio(0); } while (0)
#define PG8_WAIT_V(n) asm volatile("s_waitcnt vmcnt(" #n ")" ::: "memory")
#define PG8_WAIT_L(n) asm volatile("s_waitcnt lgkmcnt(" #n ")" ::: "memory")
#define PG8_BAR __builtin_amdgcn_s_barrier()
#define PG8_SCHED __builtin_amdgcn_sched_barrier(0)
#define PG8_VOFF(dst, u) do { _Pragma("unroll") for (int _h = 0; _h < 2; ++_h) _Pragma("unroll") for (int _i = 0; _i < 2; ++_i) dst[_h][_i] = (AR.row(u, _h * HALF + Rr[_i]) * (unsigned)K + (unsigned)Cc[_i]) * 2u; } while (0)
    Unit cur, nxt; int ui = 0;
    if (!S.next(0, cur)) return;
    f32x4 acc[2][2][4][2];
#pragma unroll
    for (int a = 0; a < 2; ++a)
#pragma unroll
        for (int b = 0; b < 2; ++b)
#pragma unroll
            for (int m = 0; m < 4; ++m)
#pragma unroll
                for (int n = 0; n < 2; ++n) acc[a][b][m][n] = (f32x4){0.f, 0.f, 0.f, 0.f};
    bf16x8 At[4][2], B0[2][2], B1[2][2];
    unsigned cvA[2][2], nvA[2][2];
    PG8_VOFF(cvA, cur);
    const char* cB = Bbase + (size_t)cur.e * b_estride + (size_t)cur.pn * tstep;
    PG8_STAGE(PG8_SB(0, 0), cB, voffB); PG8_STAGE(PG8_SB(0, 1), cB + hstep, voffB); PG8_STAGE(PG8_SA(0, 0), Abase, cvA[0]); PG8_STAGE(PG8_SA(0, 1), Abase, cvA[1]);
    if (wr == 1) PG8_BAR;
    PG8_WAIT_V(2); PG8_BAR;
    PG8_STAGE(PG8_SB(1, 0), cB + kstep, voffB); PG8_STAGE(PG8_SA(1, 0), Abase + kstep, cvA[0]); PG8_STAGE(PG8_SB(1, 1), cB + hstep + kstep, voffB);
    PG8_WAIT_V(6); PG8_BAR;
    for (;;) {
        const bool has_next = S.next(ui + 1, nxt);
        if (has_next) { PG8_VOFF(nvA, nxt); } else {
#pragma unroll
            for (int h = 0; h < 2; ++h)
#pragma unroll
                for (int i = 0; i < 2; ++i) nvA[h][i] = cvA[h][i]; }
        const char* nB = has_next ? Bbase + (size_t)nxt.e * b_estride + (size_t)nxt.pn * tstep : cB;
        for (int t = 0; t < nt; t += 2) {
            const bool last = (t == nt - 2);
            const char* a1 = Abase + (size_t)(t + 1) * kstep;
            const char* a2 = last ? Abase : Abase + (size_t)(t + 2) * kstep; const char* b2 = last ? nB : cB + (size_t)(t + 2) * kstep;
            const char* a3 = a2 + kstep; const char* b3 = b2 + kstep;
            unsigned v2[2][2];
#pragma unroll
            for (int h = 0; h < 2; ++h)
#pragma unroll
                for (int i = 0; i < 2; ++i) v2[h][i] = last ? nvA[h][i] : cvA[h][i];
            PG8_LDB(B0, 0, 0); PG8_LDB(B1, 0, 1); PG8_SCHED; PG8_LDA(At, 0, 0); PG8_STAGE(PG8_SA(1, 1), a1, cvA[1]);
            PG8_WAIT_V(8); PG8_WAIT_L(0); PG8_BAR; PG8_MMA(0, 0, At, B0); PG8_MMA(0, 1, At, B1); PG8_BAR; PG8_SCHED;
            PG8_LDA(At, 0, 1); PG8_STAGE(PG8_SB(0, 0), b2, voffB); PG8_STAGE(PG8_SB(0, 1), b2 + hstep, voffB); PG8_STAGE(PG8_SA(0, 0), a2, v2[0]);
            PG8_WAIT_V(8); PG8_WAIT_L(0); PG8_BAR; PG8_MMA(1, 0, At, B0); PG8_MMA(1, 1, At, B1); PG8_BAR; PG8_SCHED;
            PG8_LDB(B0, 1, 0); PG8_LDB(B1, 1, 1); PG8_SCHED; PG8_LDA(At, 1, 0); PG8_STAGE(PG8_SA(0, 1), a2, v2[1]);
            PG8_WAIT_V(8); PG8_WAIT_L(0); PG8_BAR; PG8_MMA(0, 0, At, B0); PG8_MMA(0, 1, At, B1); PG8_BAR; PG8_SCHED;
            PG8_LDA(At, 1, 1); PG8_STAGE(PG8_SB(1, 0), b3, voffB); PG8_STAGE(PG8_SB(1, 1), b3 + hstep, voffB); PG8_STAGE(PG8_SA(1, 0), a3, v2[0]);
            PG8_WAIT_V(8); PG8_WAIT_L(0); PG8_BAR; PG8_MMA(1, 0, At, B0); PG8_MMA(1, 1, At, B1); PG8_BAR; PG8_SCHED;
        }
        if (wr == 0) PG8_BAR;
        E(acc, cur, wr, wc, fr, fq);
        if (!has_next) break;
#pragma unroll
        for (int a = 0; a < 2; ++a)
#pragma unroll
            for (int b = 0; b < 2; ++b)
#pragma unroll
                for (int m = 0; m < 4; ++m)
#pragma unroll
                    for (int n = 0; n < 2; ++n) acc[a][b][m][n] = (f32x4){0.f, 0.f, 0.f, 0.f};
        cur = nxt; cB = nB; ++ui;
#pragma unroll
        for (int h = 0; h < 2; ++h)
#pragma unroll
            for (int i = 0; i < 2; ++i) cvA[h][i] = nvA[h][i];
        if (wr == 1) PG8_BAR;
    }
    PG8_WAIT_V(0);
    PG8_BAR;
#undef PG8_SA
#undef PG8_SB
#undef PG8_STAGE
#undef PG8_LDA
#undef PG8_LDB
#undef PG8_MMA
#undef PG8_WAIT_V
#undef PG8_WAIT_L
#undef PG8_BAR
#undef PG8_SCHED
#undef PG8_VOFF
}

__device__ __forceinline__ float sigm(float x) { return __builtin_amdgcn_rcpf(1.f + __builtin_amdgcn_exp2f(-1.4426950408889634f * x)); }
struct EpiSwiglu {
    static constexpr bool PERM = true;
    bf16_t* act; const float* b_gu; const float* rowscale;
    __device__ __forceinline__ void operator()(const f32x4 (&acc)[2][2][4][2], const Unit& u, int wr, int wc, int fr, int fq) const {
        const int row0 = u.pm * BM + wr * 64 + fr, col0 = u.pn * HALF + wc * 32 + 8 * fq;
        const float* bias = b_gu + (size_t)u.e * (2 * DFF) + col0;
        f32x4 bg[2], bu[2];
#pragma unroll
        for (int n = 0; n < 2; ++n) { bg[n] = *(const f32x4*)(bias + 4 * n); bu[n] = *(const f32x4*)(bias + DFF + 4 * n); }
#pragma unroll
        for (int ai = 0; ai < 2; ++ai)
#pragma unroll
            for (int m = 0; m < 4; ++m) { const int row = row0 + ai * HALF + m * 16; const float rs = rowscale[row];
                float o[8];
#pragma unroll
                for (int n = 0; n < 2; ++n)
#pragma unroll
                    for (int j = 0; j < 4; ++j) { const float g = fminf(acc[ai][0][m][n][j] * rs + bg[n][j], 7.f); const float up = fminf(fmaxf(acc[ai][1][m][n][j] * rs + bu[n][j], -7.f), 7.f);
                        o[4 * n + j] = g * sigm(1.702f * g) * (up + 1.f); }
                u32x4 w; w.x = cvt_pk_bf16(o[0], o[1]); w.y = cvt_pk_bf16(o[2], o[3]); w.z = cvt_pk_bf16(o[4], o[5]); w.w = cvt_pk_bf16(o[6], o[7]);
                *(u32x4*)(act + (size_t)row * DFF + col0) = w; }
    }
};
struct EpiScatter {
    static constexpr bool PERM = true;
    bf16_t* Y; const float* b_dn; const int* rowtok; const float* rowgate;
    __device__ __forceinline__ void operator()(const f32x4 (&acc)[2][2][4][2], const Unit& u, int wr, int wc, int fr, int fq) const {
        const int row0 = u.pm * BM + wr * 64 + fr, col0 = u.pn * BM + wc * 32 + 8 * fq;
        const float* bias = b_dn + (size_t)u.e * D + col0;
        f32x4 bv[2][2];
#pragma unroll
        for (int bj = 0; bj < 2; ++bj)
#pragma unroll
            for (int n = 0; n < 2; ++n) bv[bj][n] = *(const f32x4*)(bias + bj * HALF + 4 * n);
#pragma unroll
        for (int ai = 0; ai < 2; ++ai)
#pragma unroll
            for (int m = 0; m < 4; ++m) { const int row = row0 + ai * HALF + m * 16; const int id = rowtok[row]; const float gt = rowgate[row];
                if (id >= 0) { bf16_t* yp = Y + (size_t)id * D + col0;
#pragma unroll
                    for (int bj = 0; bj < 2; ++bj) { const f32x4 v0 = (acc[ai][bj][m][0] + bv[bj][0]) * gt, v1 = (acc[ai][bj][m][1] + bv[bj][1]) * gt;
                        u32x4 w; w.x = cvt_pk_bf16(v0[0], v0[1]); w.y = cvt_pk_bf16(v0[2], v0[3]); w.z = cvt_pk_bf16(v1[0], v1[1]); w.w = cvt_pk_bf16(v1[2], v1[3]);
                        *(u32x4*)(yp + bj * HALF) = w; } } }
    }
};
struct EpiQKVU {
    static constexpr bool PERM = true;
    bf16_t* O; size_t stride;
    __device__ __forceinline__ void operator()(const f32x4 (&acc)[2][2][4][2], const Unit& u, int wr, int wc, int fr, int fq) const {
        const int row0 = u.pm * BM + wr * 64 + fr, t = u.pn >> 1; const float sc = (t == 0) ? C2 : 1.f;
        bf16_t* base = O + (size_t)t * stride + (u.pn & 1) * BM + wc * 32 + 8 * fq;
#pragma unroll
        for (int ai = 0; ai < 2; ++ai)
#pragma unroll
            for (int m = 0; m < 4; ++m) { bf16_t* rowp = base + (size_t)(row0 + ai * HALF + m * 16) * 512;
#pragma unroll
                for (int bj = 0; bj < 2; ++bj) { const f32x4 v0 = acc[ai][bj][m][0] * sc, v1 = acc[ai][bj][m][1] * sc;
                    u32x4 w; w.x = cvt_pk_bf16(v0[0], v0[1]); w.y = cvt_pk_bf16(v0[2], v0[3]); w.z = cvt_pk_bf16(v1[0], v1[1]); w.w = cvt_pk_bf16(v1[2], v1[3]);
                    *(u32x4*)(rowp + bj * HALF) = w; } }
    }
};
}

__device__ __forceinline__ void transpose_item(const float* W, int ldw, int k0, int c0, const float* kscale, bf16_t* WT, int K, int r0, __attribute__((address_space(3))) float* scr, int lane) {
#pragma unroll 8
    for (int i = 0; i < 32; ++i) { const int kk = 2 * i + (lane >> 5); float v = W[(size_t)(k0 + kk) * ldw + c0 + (lane & 31)]; if (kscale) v *= kscale[k0 + kk]; scr[kk * 33 + (lane & 31)] = v; }
    __builtin_amdgcn_s_waitcnt(0xC07F); asm volatile("" ::: "memory");
    const int c = lane & 7;
#pragma unroll
    for (int j = 0; j < 4; ++j) { const int n = (lane >> 3) + 8 * j; const __attribute__((address_space(3))) float* s = scr + (8 * c) * 33 + n;
        uint4 o; o.x = pk2(s[0 * 33], s[1 * 33]); o.y = pk2(s[2 * 33], s[3 * 33]); o.z = pk2(s[4 * 33], s[5 * 33]); o.w = pk2(s[6 * 33], s[7 * 33]);
        *(uint4*)(WT + (size_t)(r0 + n) * K + k0 + 8 * c) = o; }
    __builtin_amdgcn_s_waitcnt(0xC07F); asm volatile("" ::: "memory");
}


namespace attn_body {
using bf16x8=__attribute__((ext_vector_type(8)))short;
using s16x4=__attribute__((ext_vector_type(4)))short;
using f32x16=__attribute__((ext_vector_type(16)))float;
using f32x4=__attribute__((ext_vector_type(4)))float;
using u32x4=__attribute__((ext_vector_type(4)))unsigned;
constexpr int SEQ=S,DH=64,DM=NH*DH,OPITCH=D;
constexpr int NW=8,QBLK=32,QB=QBLK*NW,KVBLK=64,NQB=SEQ/QB;
__device__ __forceinline__ int crow(int r,int hi){return (r&3)+8*(r>>2)+4*hi;}
#define SBAR() __builtin_amdgcn_sched_barrier(0)
__device__ __forceinline__ void cmask(f32x16&p0,f32x16&p1,int jb,int qrel,int hi){
  const float NEG=-INFINITY; int kb=64*jb+4*hi;
  #pragma unroll
  for(int r=0;r<16;++r){int kv=kb+(r&3)+8*(r>>2); if(kv>qrel)p0[r]=NEG; if(kv+32>qrel)p1[r]=NEG;}
}
constexpr int NSLOT=3, SLOTB=8192;
constexpr int LDS_K=0, LDS_V=NSLOT*SLOTB, LDS_WS=2*NSLOT*SLOTB, LDS_OST=LDS_WS+NW*64*4, LDS_C=LDS_OST+NW*4096, ATT_LDS_BYTES=LDS_C+(SEQ+64)*4;
__device__ __forceinline__ void glds16(const void*gsrc,unsigned lds_dst){unsigned keep;
  asm volatile("s_mov_b32 %0, m0\n\ts_mov_b32 m0, %2\n\ts_nop 0\n\tglobal_load_lds_dwordx4 %1, off\n\ts_mov_b32 m0, %0":"=&s"(keep):"v"(gsrc),"s"(lds_dst):"memory");}
__device__ __forceinline__ float max3f(float a,float b,float c){float r;asm("v_max3_f32 %0, %1, %2, %3":"=v"(r):"v"(a),"v"(b),"v"(c));return r;}
__device__ __forceinline__ float max2f(float a,float b){float r;asm("v_max_f32_e32 %0, %1, %2":"=v"(r):"v"(a),"v"(b));return r;}
__device__ __forceinline__ float fadd_s(float a,float b){float r;asm("v_add_f32_e32 %0, %1, %2":"=v"(r):"v"(a),"v"(b));return r;}
__device__ __forceinline__ float fsub_s(float a,float b){float r;asm("v_sub_f32_e32 %0, %1, %2":"=v"(r):"v"(a),"v"(b));return r;}
typedef float f32x2_t __attribute__((ext_vector_type(2))); typedef __bf16 bf16x2_t __attribute__((ext_vector_type(2)));
__device__ __forceinline__ unsigned cvtpk_s(float lo,float hi){f32x2_t v={lo,hi};bf16x2_t b=__builtin_convertvector(v,bf16x2_t);return __builtin_bit_cast(unsigned,b);}
#define WAIT_BAR(N) asm volatile("s_waitcnt vmcnt(" #N ") lgkmcnt(0)\n\ts_barrier":::"memory")
typedef __attribute__((address_space(3))) const char* lds_cptr;
typedef __attribute__((address_space(3))) const float* lds_fptr;
typedef short v4i16_t __attribute__((ext_vector_type(4)));
__device__ __forceinline__ void qkt(f32x16&p0,f32x16&p1,const char*Kslot,const bf16x8*qr,int r32,int hi){
  const char*kb=Kslot+hi*1024+r32*16;
  #pragma unroll
  for(int d0=0;d0<4;++d0){
    const bf16x8 b0=*reinterpret_cast<const bf16x8*>(kb+d0*2048);
    const bf16x8 b1=*reinterpret_cast<const bf16x8*>(kb+d0*2048+512);
    p0=__builtin_amdgcn_mfma_f32_32x32x16_bf16(b0,qr[d0],p0,0,0,0);p1=__builtin_amdgcn_mfma_f32_32x32x16_bf16(b1,qr[d0],p1,0,0,0);}
}
__device__ __forceinline__ void kload8(bf16x8*kf,lds_cptr kp){
  kf[0]=*(const __attribute__((address_space(3))) bf16x8*)(kp);      kf[1]=*(const __attribute__((address_space(3))) bf16x8*)(kp+512);
  kf[2]=*(const __attribute__((address_space(3))) bf16x8*)(kp+2048); kf[3]=*(const __attribute__((address_space(3))) bf16x8*)(kp+2560);
  kf[4]=*(const __attribute__((address_space(3))) bf16x8*)(kp+4096); kf[5]=*(const __attribute__((address_space(3))) bf16x8*)(kp+4608);
  kf[6]=*(const __attribute__((address_space(3))) bf16x8*)(kp+6144); kf[7]=*(const __attribute__((address_space(3))) bf16x8*)(kp+6656);
}
__device__ __forceinline__ void kload2(bf16x8*kf,lds_cptr kp,int j){ kf[2*j]=*(const __attribute__((address_space(3))) bf16x8*)(kp+j*2048); kf[2*j+1]=*(const __attribute__((address_space(3))) bf16x8*)(kp+j*2048+512); }
__device__ __forceinline__ s16x4 vtr(lds_cptr p){ return __builtin_bit_cast(s16x4,__builtin_amdgcn_ds_read_tr16_b64_v4i16((__attribute__((address_space(3))) v4i16_t*)p)); }
__device__ __forceinline__ float rowmax(const f32x16&p0,const f32x16&p1){
  float a=max3f(p0[0],p0[1],p1[0]),b=max3f(p0[2],p0[3],p1[1]);a=max3f(a,p1[2],p1[3]);
  #pragma unroll
  for(int r=4;r<16;r+=4){a=max3f(a,p0[r],p0[r+1]);b=max3f(b,p0[r+2],p0[r+3]);a=max3f(a,p1[r],p1[r+1]);b=max3f(b,p1[r+2],p1[r+3]);}
  const float m=max2f(a,b);
  auto rr=__builtin_amdgcn_permlane32_swap(__float_as_uint(m),__float_as_uint(m),false,false);
  return max2f(__uint_as_float(rr[0]),__uint_as_float(rr[1]));
}
__device__ __forceinline__ void pv(f32x16*o,int vb,bf16x8 pa0,bf16x8 pa1,bf16x8 pa2,bf16x8 pa3){
  #pragma unroll
  for(int d0=0;d0<2;++d0){s16x4 lo[4],hi[4];
    #pragma unroll
    for(int ks=0;ks<4;++ks){
      asm volatile("ds_read_b64_tr_b16 %0,%1 offset:%c2":"=&v"(lo[ks]):"v"(vb),"i"(d0*4096+ks*1024):"memory");
      asm volatile("ds_read_b64_tr_b16 %0,%1 offset:%c2":"=&v"(hi[ks]):"v"(vb),"i"(d0*4096+ks*1024+512):"memory");}
    asm volatile("s_waitcnt lgkmcnt(0)":::"memory");SBAR();
    #define PK(k) (bf16x8){lo[k][0],lo[k][1],lo[k][2],lo[k][3],hi[k][0],hi[k][1],hi[k][2],hi[k][3]}
    o[d0]=__builtin_amdgcn_mfma_f32_32x32x16_bf16(pa0,PK(0),o[d0],0,0,0);
    o[d0]=__builtin_amdgcn_mfma_f32_32x32x16_bf16(pa1,PK(1),o[d0],0,0,0);
    o[d0]=__builtin_amdgcn_mfma_f32_32x32x16_bf16(pa2,PK(2),o[d0],0,0,0);
    o[d0]=__builtin_amdgcn_mfma_f32_32x32x16_bf16(pa3,PK(3),o[d0],0,0,0);
    #undef PK
  }
}
__device__ __forceinline__ void prep_c(int b,int h,const float*logf,char*shm){
  const int tid=threadIdx.x,lane=tid&63,wid=tid>>6;
  float*cl=(float*)(shm+LDS_C); float*wtot=(float*)(shm+LDS_WS);
  float v[8]; float tot=0.f;
  #pragma unroll
  for(int i=0;i<8;++i){ v[i]=logf[((size_t)b*SEQ+tid*8+i)*8+h]; tot+=v[i]; }
  float incl=tot;
  #pragma unroll
  for(int o=1;o<64;o<<=1){ const float n=__shfl_up(incl,o); if(lane>=o)incl+=n; }
  if(lane==63)wtot[wid]=incl;
  __syncthreads();
  float pre=incl-tot;
  #pragma unroll
  for(int w=0;w<8;++w) if(w<wid)pre+=wtot[w];
  #pragma unroll
  for(int i=0;i<8;++i){ pre+=v[i]; cl[tid*8+i]=pre*LOG2E; }
  if(tid<64)cl[SEQ+tid]=0.f;
  __syncthreads();
}
template<int THRL> __device__ __forceinline__ void attn_unit(int b,int h,int qb,const bf16_t*Q,const bf16_t*__restrict__ K,const bf16_t*__restrict__ V,bf16_t*O,float*psa,char*shm){
  int tid=threadIdx.x; asm volatile("":"+v"(tid)); const int lane=tid&63,r32=lane&31,hi=lane>>5; const int wid=__builtin_amdgcn_readfirstlane(tid>>6);
  const long rowbase=(long)b*SEQ; const int q0=qb*QB;
  const bf16_t*Qw=Q+(rowbase+q0+wid*QBLK)*DM+h*DH;
  const bf16_t*Kh=K+rowbase*DM+h*DH,*Vh=V+rowbase*DM+h*DH;
  const unsigned lds0=(unsigned)(uintptr_t)shm;
  float*wsf=(float*)(shm+LDS_WS)+wid*64;
  const bf16_t*ksrc=Kh+(long)lane*DM+wid*8;
  const bf16_t*vsrc=Vh+(long)(16*(wid&3)+(lane>>2))*DM+(wid>>2)*32+(lane&3)*8;
  const unsigned kdst=lds0+LDS_K+wid*1024, vdst=lds0+LDS_V+wid*1024;
  #define DMA_K(t,slot) glds16(ksrc+(long)(t)*KVBLK*DM,(unsigned)__builtin_amdgcn_readfirstlane(kdst+(slot)))
  #define DMA_V(t,slot) glds16(vsrc+(long)(t)*KVBLK*DM,(unsigned)__builtin_amdgcn_readfirstlane(vdst+(slot)))
  const int vb0=(int)(lds0+LDS_V)+((lane>>4)&1)*32+(lane&3)*8+(4*hi+((lane&15)>>2))*64;
  const char*Kbase=shm+LDS_K; bf16x8 kf[8];
  const lds_cptr shm3=(lds_cptr)shm; const lds_cptr kp0=shm3+LDS_K+hi*1024+r32*16; const lds_cptr vp0=shm3+LDS_V+((lane>>4)&1)*32+(lane&3)*8+(4*hi+((lane&15)>>2))*64;
  const lds_fptr clh=(lds_fptr)(shm3+LDS_C)+4*hi;
  const int NT=(q0+QB)/KVBLK;
  DMA_K(0,0);DMA_V(0,0);DMA_K(1,SLOTB);
  bf16x8 qr[4];
  #pragma unroll
  for(int d0=0;d0<4;++d0)qr[d0]=*reinterpret_cast<const bf16x8*>(&Qw[(long)r32*DM+d0*16+hi*8]);
  float mhat=0.f,l_reg=0.f;f32x16 o[2];o[0]=f32x16{};o[1]=f32x16{};
  const int qrel=wid*QBLK+r32;
  const float cq2=((lds_fptr)(shm3+LDS_C))[q0+qrel];
  #define CMASK(P0,P1,t) do{int jb_=(t)-(NT-4); if(jb_>=0)cmask(P0,P1,jb_,qrel,hi);}while(0)
  #define CINIT(P0,P1,tt,basev_) do{ _Pragma("unroll") for(int g_=0;g_<4;++g_){ const f32x4 a_=*(const __attribute__((address_space(3))) f32x4*)(clh+64*(tt)+8*g_); const f32x4 b_=*(const __attribute__((address_space(3))) f32x4*)(clh+64*(tt)+32+8*g_); \
      _Pragma("unroll") for(int j_=0;j_<4;++j_){ P0[4*g_+j_]=(basev_)-a_[j_]; P1[4*g_+j_]=(basev_)-b_[j_]; } } }while(0)
  bool resc=false;
  #define START(P0,P1) do{ const float rm=rowmax(P0,P1); resc=false; \
    { const float dl=rm; mhat=fadd_s(mhat,dl); \
      _Pragma("unroll") for(int r=0;r<16;++r){P0[r]=fsub_s(P0[r],dl);P1[r]=fsub_s(P1[r],dl);} } \
    _Pragma("unroll") for(int r=0;r<16;++r)P0[r]=__builtin_amdgcn_exp2f(P0[r]); }while(0)
  #define RESC() do{ if(resc){ asm volatile("s_waitcnt lgkmcnt(0)":::"memory"); \
      _Pragma("unroll") for(int d_=0;d_<2;++d_) _Pragma("unroll") for(int r=0;r<16;++r)o[d_][r]*=wsf[crow(r,hi)]; } }while(0)
  f32x16 pA0,pA1,pB0,pB1;
  int sl_prev=0,sl_cur=0,sl_next=SLOTB;
  #define ROT() do{sl_prev=sl_cur;sl_cur=sl_next;sl_next=(sl_next==(NSLOT-1)*SLOTB)?0:sl_next+SLOTB;}while(0)
  DMA_K(2,2*SLOTB);
  CINIT(pA0,pA1,0,cq2);
  WAIT_BAR(3);
  qkt(pA0,pA1,Kbase,qr,r32,hi);asm volatile("s_nop 15\n\ts_nop 7":"+v"(pA0),"+v"(pA1));CMASK(pA0,pA1,0);
  START(pA0,pA1);
  _Pragma("unroll") for(int r=0;r<16;++r)pA1[r]=__builtin_amdgcn_exp2f(pA1[r]);
  { const float bv0=cq2-mhat; CINIT(pB0,pB1,1,bv0); }
  WAIT_BAR(0);
  DMA_K(3,0);DMA_V(1,SLOTB);
  ROT();
  kload8(kf,kp0+sl_cur);
  WAIT_BAR(2);
  s16x4 vlo[8],vhi[8]; u32x4 pw0,pw1,pw2,pw3;
  #define PKW(P,B) cvtpk_s(P[B],P[B+1])
  #define PAF(k) __builtin_bit_cast(bf16x8,pw##k)
  #define VFR(i) (bf16x8){vlo[i][0],vlo[i][1],vlo[i][2],vlo[i][3],vhi[i][0],vhi[i][1],vhi[i][2],vhi[i][3]}
  #define PIN(x) asm volatile("":"+v"(x))
  #define MX3(a,b,c) __builtin_fmaxf(__builtin_fmaxf((a),(b)),(c))
  #define GAPA(MF,A0,A1,A2,A3,W0,W1,PW) do{ MF; sacc+=A0; sacc+=A1; sacc+=A2; sacc+=A3; PIN(sacc); W0; W1; PIN(PW); SBAR(); }while(0)
  #define EX(v) __builtin_amdgcn_exp2f(v)
  #define CKRD(i) (*(const __attribute__((address_space(3))) f32x4*)(clt_+(((i)>>2)*32+((i)&3)*8)))
  #define GAPB(MF,X,B,PN,G,CKU,CKN,INXT) do{ MF; X[B]=EX(X[B]); X[B+1]=EX(X[B+1]); X[B+2]=EX(X[B+2]); X[B+3]=EX(X[B+3]); PIN(X); \
      PN[4*(G)]=basev-CKU[0]; PN[4*(G)+1]=basev-CKU[1]; PN[4*(G)+2]=basev-CKU[2]; PN[4*(G)+3]=basev-CKU[3]; PIN(PN); CKN=CKRD(INXT); SBAR(); }while(0)
  #define VRD(i) do{ vlo[i]=vtr(vp_+(((i)>>2)*4096+((i)&3)*1024)); vhi[i]=vtr(vp_+(((i)>>2)*4096+((i)&3)*1024+512)); }while(0)
  #define KRD(G,j) do{ if(G){ kload2(kf,kp0+sl_next,j); SBAR(); } }while(0)
  #define STEP(C0,C1,P0,P1,t,GK,GV,GL) do{ SBAR(); \
    const lds_cptr vp_=vp0+sl_prev; const lds_fptr clt_=clh+64*((t)+1); \
    VRD(0); SBAR(); float sacc=(P0[0]+P0[1]); \
    GAPA(C0=__builtin_amdgcn_mfma_f32_32x32x16_bf16(kf[0],qr[0],C0,0,0,0), P0[2],P0[3],P0[4],P0[5],     pw0[0]=PKW(P0,0), pw0[1]=PKW(P0,2), pw0); \
    VRD(4); SBAR(); GAPA(C1=__builtin_amdgcn_mfma_f32_32x32x16_bf16(kf[1],qr[0],C1,0,0,0), P0[6],P0[7],P0[8],P0[9],     pw0[2]=PKW(P0,4), pw0[3]=PKW(P0,6), pw0); \
    VRD(1); SBAR(); GAPA(C0=__builtin_amdgcn_mfma_f32_32x32x16_bf16(kf[2],qr[1],C0,0,0,0),   P0[10],P0[11],P0[12],P0[13], pw1[0]=PKW(P0,8), pw1[1]=PKW(P0,10), pw1); \
    VRD(5); SBAR(); GAPA(C1=__builtin_amdgcn_mfma_f32_32x32x16_bf16(kf[3],qr[1],C1,0,0,0),   P0[14],P0[15],P1[0],P1[1],   pw1[2]=PKW(P0,12),pw1[3]=PKW(P0,14), pw1); \
    VRD(2); SBAR(); GAPA(C0=__builtin_amdgcn_mfma_f32_32x32x16_bf16(kf[4],qr[2],C0,0,0,0),   P1[2],P1[3],P1[4],P1[5],     pw2[0]=PKW(P1,0), pw2[1]=PKW(P1,2), pw2); \
    VRD(6); SBAR(); GAPA(C1=__builtin_amdgcn_mfma_f32_32x32x16_bf16(kf[5],qr[2],C1,0,0,0),   P1[6],P1[7],P1[8],P1[9],     pw2[2]=PKW(P1,4), pw2[3]=PKW(P1,6), pw2); \
    VRD(3); SBAR(); GAPA(C0=__builtin_amdgcn_mfma_f32_32x32x16_bf16(kf[6],qr[3],C0,0,0,0),   P1[10],P1[11],P1[12],P1[13], pw3[0]=PKW(P1,8), pw3[1]=PKW(P1,10), pw3); \
    VRD(7); SBAR(); GAPA(C1=__builtin_amdgcn_mfma_f32_32x32x16_bf16(kf[7],qr[3],C1,0,0,0),   P1[14],P1[15],0.f,0.f,       pw3[2]=PKW(P1,12),pw3[3]=PKW(P1,14), pw3); \
    l_reg+=sacc; \
    if(GK){DMA_K((t)+3,sl_cur);} if(GV){DMA_V((t)+1,sl_next);} \
    CMASK(C0,C1,t); \
    { float a=MX3(C0[0],C0[1],C1[0]),b=MX3(C0[2],C0[3],C1[1]); a=MX3(a,C1[2],C1[3]); \
      _Pragma("unroll") for(int r=4;r<16;r+=4){a=MX3(a,C0[r],C0[r+1]);b=MX3(b,C0[r+2],C0[r+3]);a=MX3(a,C1[r],C1[r+1]);b=MX3(b,C1[r+2],C1[r+3]);} \
      float rm=__builtin_fmaxf(a,b); { auto rr=__builtin_amdgcn_permlane32_swap(__float_as_uint(rm),__float_as_uint(rm),false,false); rm=__builtin_fmaxf(__uint_as_float(rr[0]),__uint_as_float(rr[1])); } \
      resc=false; \
      if(__builtin_expect(__any(rm>(float)THRL),0)){ const float dl=__builtin_fmaxf(rm,0.f); mhat+=dl; \
        _Pragma("unroll") for(int r=0;r<16;++r){C0[r]-=dl;C1[r]-=dl;} \
        const float f=__builtin_amdgcn_exp2f(-dl); l_reg*=f; if(hi==0)wsf[r32]=f; resc=true; } } \
    const float basev=cq2-mhat; f32x4 ckA_=CKRD(0),ckB_; \
    SBAR(); \
    GAPB(o[0]=__builtin_amdgcn_mfma_f32_32x32x16_bf16(PAF(0),VFR(0),o[0],0,0,0), C0,0,  P0,0,ckA_,ckB_,1); \
    GAPB(o[1]=__builtin_amdgcn_mfma_f32_32x32x16_bf16(PAF(0),VFR(4),o[1],0,0,0), C0,4,  P0,1,ckB_,ckA_,2); \
    KRD(GL,0); GAPB(o[0]=__builtin_amdgcn_mfma_f32_32x32x16_bf16(PAF(1),VFR(1),o[0],0,0,0), C0,8,  P0,2,ckA_,ckB_,3); \
    KRD(GL,1); GAPB(o[1]=__builtin_amdgcn_mfma_f32_32x32x16_bf16(PAF(1),VFR(5),o[1],0,0,0), C0,12, P0,3,ckB_,ckA_,4); \
    KRD(GL,2); GAPB(o[0]=__builtin_amdgcn_mfma_f32_32x32x16_bf16(PAF(2),VFR(2),o[0],0,0,0), C1,0,  P1,0,ckA_,ckB_,5); \
    KRD(GL,3); GAPB(o[1]=__builtin_amdgcn_mfma_f32_32x32x16_bf16(PAF(2),VFR(6),o[1],0,0,0), C1,4,  P1,1,ckB_,ckA_,6); \
    GAPB(o[0]=__builtin_amdgcn_mfma_f32_32x32x16_bf16(PAF(3),VFR(3),o[0],0,0,0), C1,8,  P1,2,ckA_,ckB_,7); \
    GAPB(o[1]=__builtin_amdgcn_mfma_f32_32x32x16_bf16(PAF(3),VFR(7),o[1],0,0,0), C1,12, P1,3,ckB_,ckA_,7); \
    }while(0)
  int t=1;
  #undef CMASK
  #define CMASK(P0,P1,t) do{}while(0)
  for(;t+5<NT;t+=2){
    STEP(pB0,pB1,pA0,pA1,t,true,true,true);     WAIT_BAR(2); RESC(); ROT();
    STEP(pA0,pA1,pB0,pB1,t+1,true,true,true);   WAIT_BAR(2); RESC(); ROT();
  }
  #undef CMASK
  #define CMASK(P0,P1,t) do{int jb_=(t)-(NT-4); if(jb_>=0)cmask(P0,P1,jb_,qrel,hi);}while(0)
  #define ENDW(tt) do{ if((tt)+3<NT){WAIT_BAR(2);} else if((tt)+2<NT){WAIT_BAR(1);} else {WAIT_BAR(0);} }while(0)
  for(;t+1<NT;t+=2){
    STEP(pB0,pB1,pA0,pA1,t,(t+3<NT),(t+1<NT),(t+1<NT));       ENDW(t);   RESC(); ROT();
    STEP(pA0,pA1,pB0,pB1,t+1,(t+4<NT),(t+2<NT),(t+2<NT));     ENDW(t+1); RESC(); ROT();
  }
  STEP(pB0,pB1,pA0,pA1,NT-1,false,false,false); RESC();
  { float sacc=pB0[0]+pB0[1]; _Pragma("unroll") for(int r=2;r<16;++r)sacc+=pB0[r]; _Pragma("unroll") for(int r=0;r<16;++r)sacc+=pB1[r]; l_reg+=sacc;
    pw0=(u32x4){PKW(pB0,0),PKW(pB0,2),PKW(pB0,4),PKW(pB0,6)};pw1=(u32x4){PKW(pB0,8),PKW(pB0,10),PKW(pB0,12),PKW(pB0,14)};pw2=(u32x4){PKW(pB1,0),PKW(pB1,2),PKW(pB1,4),PKW(pB1,6)};pw3=(u32x4){PKW(pB1,8),PKW(pB1,10),PKW(pB1,12),PKW(pB1,14)};
    SBAR(); pv(o,vb0+sl_cur,PAF(0),PAF(1),PAF(2),PAF(3)); }
  #undef PKW
  #undef PAF
  #undef VFR
  #undef PIN
  #undef MX3
  #undef GAPA
  #undef GAPB
  #undef CKRD
  #undef EX
  #undef VRD
  #undef KRD
  #undef STEP
  #undef ENDW
  {auto rr=__builtin_amdgcn_permlane32_swap(__float_as_uint(l_reg),__float_as_uint(l_reg),false,false);l_reg=__uint_as_float(rr[0])+__uint_as_float(rr[1]);}
  if(hi==0)wsf[32+r32]=l_reg;asm volatile("s_waitcnt lgkmcnt(0)":::"memory");
  float rli[16];
  #pragma unroll
  for(int r=0;r<16;++r)rli[r]=__builtin_amdgcn_rcpf(wsf[32+crow(r,hi)]);
  bf16_t*Ow=O+(rowbase+q0+wid*QBLK)*OPITCH+h*DH;
  { bf16_t*stg=(bf16_t*)(shm+LDS_OST)+wid*2048;
    #pragma unroll
    for(int r=0;r<16;++r){const int orow=crow(r,hi);
      #pragma unroll
      for(int d0=0;d0<2;++d0)stg[orow*64+d0*32+r32]=f2bf(o[d0][r]*rli[r]);}
    asm volatile("s_waitcnt lgkmcnt(0)":::"memory");
    #pragma unroll
    for(int i=0;i<4;++i){const int row=i*8+(lane>>3),ch=lane&7; const u32x4 v=*(const u32x4*)(stg+row*64+ch*8); *(u32x4*)(Ow+(long)row*OPITCH+ch*8)=v;
      float ss=0.f;
      #pragma unroll
      for(int j=0;j<4;++j){ const float lo_=__builtin_bit_cast(float,v[j]<<16), hi_=__builtin_bit_cast(float,v[j]&0xffff0000u); ss+=lo_*lo_+hi_*hi_; }
      ss+=__shfl_xor(ss,1); ss+=__shfl_xor(ss,2); ss+=__shfl_xor(ss,4);
      if(ch==0)psa[(rowbase+q0+wid*QBLK+row)*8+h]=ss; } }
  asm volatile("s_waitcnt lgkmcnt(0)\n\ts_barrier":::"memory");
  #undef DMA_K
  #undef DMA_V
  #undef CMASK
  #undef CINIT
  #undef START
  #undef RESC
  #undef ROT
}
#undef SBAR
#undef WAIT_BAR
}

struct Params {
    const float* in[29];
    float* out;
    unsigned char* ws;
};

__device__ __forceinline__ float wave_sum(float v) {
#pragma unroll
    for (int o = 1; o < 64; o <<= 1) v += __shfl_xor(v, o);
    return v;
}
__device__ __forceinline__ float wave_max(float v) {
#pragma unroll
    for (int o = 1; o < 64; o <<= 1) v = fmaxf(v, __shfl_xor(v, o));
    return v;
}

template <class AT> __device__ void rms_rows(const AT* in, int ldi, const float* g, float* out, int ldo, int ncols, int nrows, int gw, int ngw, int lane) {
    for (int r = gw; r < nrows; r += ngw) {
        const AT* row = in + (size_t)r * ldi; float ss = 0.f;
        for (int c = lane; c < ncols; c += 64) { const float v = ldf(row, c); ss += v * v; }
        ss = wave_sum(ss);
        const float rs = rsqrtf(ss / (float)ncols + EPS);
        float* orow = out + (size_t)r * ldo;
        for (int c = lane; c < ncols; c += 64) orow[c] = ldf(row, c) * rs * g[c];
    }
}

template <class AT, bool DUAL, class RowFn, class Epi>
__device__ void gemm_tile(const AT* A, int lda, RowFn arow, const float* B, int ldb, int K, int m0, int n0, int n1, int Nmax, float* sm, Epi epi) {
    float* As = sm;
    float* Bs = sm + 16 * 132;
    float* Bs2 = Bs + 16 * 128;
    const int tid = threadIdx.x, ty = tid >> 4, tx = tid & 15;
    float acc[4][8], acc2[4][8];
#pragma unroll
    for (int i = 0; i < 4; ++i)
#pragma unroll
        for (int j = 0; j < 8; ++j) { acc[i][j] = 0.f; acc2[i][j] = 0.f; }
    const int ar = tid >> 2, ak = (tid & 3) * 4;
    const int srow = arow(m0 + ar);
    const int bk = tid >> 5, bn = (tid & 31) * 4;
    for (int k0 = 0; k0 < K; k0 += 16) {
        float a4[4];
#pragma unroll
        for (int j = 0; j < 4; ++j) a4[j] = (srow >= 0) ? ldf(A, (size_t)srow * lda + k0 + ak + j) : 0.f;
        float b4[4], c4[4];
#pragma unroll
        for (int j = 0; j < 4; ++j) { const int col = n0 + bn + j; b4[j] = (col < Nmax) ? B[(size_t)(k0 + bk) * ldb + col] : 0.f; }
        if (DUAL) {
#pragma unroll
            for (int j = 0; j < 4; ++j) c4[j] = B[(size_t)(k0 + bk) * ldb + n1 + bn + j];
        }
        __syncthreads();
#pragma unroll
        for (int j = 0; j < 4; ++j) As[(ak + j) * 132 + ar] = a4[j];
#pragma unroll
        for (int j = 0; j < 4; ++j) Bs[bk * 128 + bn + j] = b4[j];
        if (DUAL) {
#pragma unroll
            for (int j = 0; j < 4; ++j) Bs2[bk * 128 + bn + j] = c4[j];
        }
        __syncthreads();
#pragma unroll 2
        for (int kk = 0; kk < 16; ++kk) {
            float a[4], b[8];
#pragma unroll
            for (int i = 0; i < 4; ++i) a[i] = As[kk * 132 + ty * 4 + i];
#pragma unroll
            for (int j = 0; j < 8; ++j) b[j] = Bs[kk * 128 + tx * 8 + j];
#pragma unroll
            for (int i = 0; i < 4; ++i)
#pragma unroll
                for (int j = 0; j < 8; ++j) acc[i][j] += a[i] * b[j];
            if (DUAL) {
#pragma unroll
                for (int j = 0; j < 8; ++j) b[j] = Bs2[kk * 128 + tx * 8 + j];
#pragma unroll
                for (int i = 0; i < 4; ++i)
#pragma unroll
                    for (int j = 0; j < 8; ++j) acc2[i][j] += a[i] * b[j];
            }
        }
    }
    __syncthreads();
#pragma unroll
    for (int i = 0; i < 4; ++i)
#pragma unroll
        for (int j = 0; j < 8; ++j) epi(m0 + ty * 4 + i, tx * 8 + j, acc[i][j], acc2[i][j]);
}

struct RowId { __device__ int operator()(int r) const { return r; } };
struct RowTok { const int* rowtok; __device__ int operator()(int r) const { const int id = rowtok[r]; return id < 0 ? -1 : (id >> 2); } };
struct RowSlot { const int* rowtok; __device__ int operator()(int r) const { return rowtok[r] < 0 ? -1 : r; } };

__device__ __forceinline__ float sigmoidf_(float x) { return 1.f / (1.f + __expf(-x)); }

__global__ void __launch_bounds__(NTHR) fwd_naive(Params P) {
    cg::grid_group grid = cg::this_grid();
    extern __shared__ __attribute__((aligned(16))) unsigned char lds[];
    float* sm = (float*)lds;
    int* ism = (int*)(lds + 57600);
    PG8_LAS unsigned char* ldsl = (PG8_LAS unsigned char*)lds;
    int tid = threadIdx.x, lane = tid & 63, wave = tid >> 6;
    const int nblk = gridDim.x, blk = blockIdx.x;
    int gw = blk * NWAVE + wave; const int ngw = nblk * NWAVE;
#define REFRESH_IDS() do { tid = threadIdx.x; asm volatile("" : "+v"(tid)); lane = tid & 63; wave = tid >> 6; gw = blk * NWAVE + wave; } while (0)
    unsigned char* ws = P.ws;
    int* ctl = (int*)(ws + WS_CTL);
    float* cbuf = (float*)(ws + WS_C); float* logf_ = (float*)(ws + WS_LOGF);
    float* mix = (float*)(ws + WS_MIXF);
    float* gbuf = (float*)(ws + WS_GF);
    float* x1 = (float*)(ws + WS_X1);
    int* topi = (int*)(ws + WS_TOPI); float* topg = (float*)(ws + WS_TOPG);
    int* rowtok = (int*)(ws + WS_ROWTOK); float* rowgate = (float*)(ws + WS_ROWGATE);
    bf16_t* act = (bf16_t*)(ws + WS_ACT); bf16_t* Y = (bf16_t*)(ws + WS_Y);
    float* Gs = (float*)(ws + WS_GS);
    bf16_t* Win_t = (bf16_t*)(ws + WS_WIN); bf16_t* XN = (bf16_t*)(ws + WS_XN); bf16_t* QB = (bf16_t*)(ws + WS_Q);
    bf16_t* KB = QB + (size_t)T * 512; bf16_t* VB = KB + (size_t)T * 512; bf16_t* UB = VB + (size_t)T * 512;
    bf16_t* Wgu_t = (bf16_t*)(ws + WS_WGU); bf16_t* Wdn_t = (bf16_t*)(ws + WS_WDN); bf16_t* X1B = (bf16_t*)(ws + WS_X1B);
    bf16_t* MIXB = (bf16_t*)(ws + WS_MIXB); float* psa = (float*)(ws + WS_PSA);
    int* rowsrc = (int*)(ws + WS_ROWSRC); float* rowscl = (float*)(ws + WS_ROWSCL); float* r1 = (float*)(ws + WS_R1);
    const float* x = P.in[0]; const float* pin = P.in[1]; const float* norm_mix_g = P.in[2]; const float* w_in = P.in[3]; const float* b_f = P.in[4];
    const float* lam_re = P.in[5]; const float* lam_im = P.in[6]; const float* log_dt = P.in[7]; const float* b_re = P.in[8]; const float* b_im = P.in[9];
    const float* c_re = P.in[10]; const float* c_im = P.in[11]; const float* d_skip = P.in[12]; const float* w_glu = P.in[13]; const float* b_glu = P.in[14];
    const float* attn_out_g = P.in[15]; const float* ssm_out_g = P.in[16]; const float* w_out = P.in[17]; const float* norm_ffn_g = P.in[18];
    const float* w_router = P.in[19]; const float* b_router = P.in[20]; const float* w_gu = P.in[21]; const float* b_gu = P.in[22];
    const float* w_dn = P.in[23]; const float* b_dn = P.in[24]; const float* norm_ple_g = P.in[25]; const float* w_ple_gate = P.in[26];
    const float* w_ple_proj = P.in[27]; const float* norm_final_g = P.in[28];

    if (blk == 0 && tid < 128) ctl[tid] = 0;
    {
        PG8_LAS float* scr = (PG8_LAS float*)(ldsl + wave * 16384);
        constexpr int I_IN = 16 * 64, I_GU = NE * 16 * 64, I_DN = NE * 16 * 32;
        for (int it = gw; it < I_IN + I_GU + I_DN; it += ngw) {
            int r = it;
            if (r < I_IN) { const int kb = r >> 6, nb = r & 63, n0 = nb * 32; const int c0 = (n0 < 1536) ? n0 : n0 + 8;
                transpose_item(w_in, INW, kb * 64, c0, norm_mix_g, Win_t, D, n0, scr, lane); continue; }
            r -= I_IN;
            if (r < I_GU) {
                const int e = r >> 10, kb = (r >> 6) & 15, nb = r & 63; const int n0 = nb * 32, pn = n0 >> 8, j0 = n0 & 255;
                const int c0 = (j0 < 128) ? pn * 128 + j0 : DFF + pn * 128 + (j0 - 128);
                transpose_item(w_gu + (size_t)e * D * 2 * DFF, 2 * DFF, kb * 64, c0, norm_ffn_g, Wgu_t + (size_t)e * 2 * DFF * D, D, n0, scr, lane); continue; }
            r -= I_GU;
            { const int e = r >> 9, kb = (r >> 5) & 15, nb = r & 31;
              transpose_item(w_dn + (size_t)e * DFF * D, D, kb * 64, nb * 32, nullptr, Wdn_t + (size_t)e * D * DFF, DFF, nb * 32, scr, lane); }
        }
    }
    {
        float wf[4][4][8];
#pragma unroll
        for (int j = 0; j < 4; ++j)
#pragma unroll
            for (int i = 0; i < 4; ++i) { const int k = 256 * j + 4 * lane + i; const float gk = norm_mix_g[k]; const float4 a = *(const float4*)(w_in + (size_t)k * INW + COL_F), b4 = *(const float4*)(w_in + (size_t)k * INW + COL_F + 4);
                wf[j][i][0] = a.x * gk; wf[j][i][1] = a.y * gk; wf[j][i][2] = a.z * gk; wf[j][i][3] = a.w * gk; wf[j][i][4] = b4.x * gk; wf[j][i][5] = b4.y * gk; wf[j][i][6] = b4.z * gk; wf[j][i][7] = b4.w * gk; }
        for (int r = gw; r < T; r += ngw) {
            const float4* xr = (const float4*)(x + (size_t)r * D) + lane; float4 v[4]; float ss = 0.f;
#pragma unroll
            for (int j = 0; j < 4; ++j) { v[j] = xr[64 * j]; ss += (v[j].x * v[j].x + v[j].y * v[j].y) + (v[j].z * v[j].z + v[j].w * v[j].w); }
            ss = wave_sum(ss); const float rs = rsqrtf(ss * (1.f / D) + EPS);
            float fl[8];
#pragma unroll
            for (int h = 0; h < 8; ++h) fl[h] = 0.f;
            uint2* o8 = (uint2*)(XN + (size_t)r * D) + lane;
#pragma unroll
            for (int j = 0; j < 4; ++j) { const float a0 = v[j].x * rs, a1 = v[j].y * rs, a2 = v[j].z * rs, a3 = v[j].w * rs;
                o8[64 * j] = make_uint2(pk2(a0, a1), pk2(a2, a3));
#pragma unroll
                for (int h = 0; h < 8; ++h) fl[h] += a0 * wf[j][0][h] + a1 * wf[j][1][h] + a2 * wf[j][2][h] + a3 * wf[j][3][h]; }
            float mine = 0.f;
#pragma unroll
            for (int h = 0; h < 8; ++h) { const float sfl = wave_sum(fl[h]); if (lane == h) mine = sfl; }
            if (lane < 8) { const float z = mine + b_f[lane]; logf_[(size_t)r * 8 + lane] = fminf(z, 0.f) - log1pf(__expf(-fabsf(z))); }
        }
    }
    __syncthreads();
    grid.sync(); REFRESH_IDS();

    {
        pg8::Order So; So.init(T / 256, 2048 / 256, nblk, blk, nullptr);
        pg8::EpiQKVU E{QB, (size_t)T * 512};
        pg8::gemm_phase<pg8::EpiQKVU, pg8::DenseRows>(ldsl, (const char*)XN, (const char*)Win_t, 0, D, So, pg8::DenseRows{}, E);
    }
    grid.sync(); REFRESH_IDS();

    for (int j = wave * nblk + blk; j < NB * NG; j += ngw) {
        const int b = j / NG, g = j % NG, p = lane;
        const float dt = __expf(log_dt[g]); const float lr = lam_re[g * NP + p], li = lam_im[g * NP + p];
        const float mag = __expf(lr * dt); const float abr = mag * cosf(li * dt), abi = mag * sinf(li * dt);
        const float den = lr * lr + li * li, nr = abr - 1.f; const float zr = (nr * lr + abi * li) / den, zi = (abi * lr - nr * li) / den;
        float bbr[NC], bbi[NC], cr[NC], ci[NC];
#pragma unroll
        for (int c = 0; c < NC; ++c) { const float br = b_re[(size_t)(g * NP + p) * NC + c], bi = b_im[(size_t)(g * NP + p) * NC + c]; bbr[c] = zr * br - zi * bi; bbi[c] = zr * bi + zi * br;
            cr[c] = c_re[(size_t)(g * NC + c) * NP + p]; ci[c] = c_im[(size_t)(g * NC + c) * NP + p]; }
        const float dsk = (lane < NC) ? d_skip[g * NC + lane] : 0.f;
        float xr = 0.f, xi = 0.f;
        for (int t = 0; t < S; ++t) {
            const bf16_t* up = UB + (size_t)(b * S + t) * SW + g * NC;
            const float ul = (lane < NC) ? bf2f(up[lane]) : 0.f;
            float bur = 0.f, bui = 0.f;
#pragma unroll
            for (int c = 0; c < NC; ++c) { const float uc = __shfl(ul, c); bur += bbr[c] * uc; bui += bbi[c] * uc; }
            const float nxr = abr * xr - abi * xi + bur, nxi = abr * xi + abi * xr + bui; xr = nxr; xi = nxi;
            float yv = 0.f;
#pragma unroll
            for (int c = 0; c < NC; ++c) { const float s = wave_sum(cr[c] * xr - ci[c] * xi); if (lane == c) yv = s; }
            if (lane < NC) { const float y = yv + dsk * ul; const float gl = 0.5f * y * (1.f + tanhf(0.7978845608028654f * (y + 0.044715f * y * y * y))); gbuf[(size_t)(b * S + t) * SW + g * NC + lane] = gl; }
        }
    }
    __syncthreads();
    {
        const int vcu = (blk % 8) * (nblk / 8) + blk / 8, bh = vcu >> 2, sg = vcu & 3, b = bh >> 3, h = bh & 7;
        attn_body::prep_c(b, h, logf_, (char*)lds);
        for (int i = 0; i < 4; ++i) { const int qb = (i == 0) ? sg : (i == 1) ? 7 - sg : (i == 2) ? 8 + sg : 15 - sg;
            attn_body::attn_unit<8>(b, h, qb, QB, KB, VB, MIXB, psa, (char*)lds); }
    }
    grid.sync(); REFRESH_IDS();

    {
        const int nN = SW / 128, nM = T / 128;
        for (int vb = blk; vb < nM * nN; vb += nblk) {
            const int mt = vb / nN, nt = vb % nN;
            auto epi = [&](int r, int c, float a, float) { const int col = nt * 128 + c; const float gv = gbuf[(size_t)r * SW + col]; mix[(size_t)r * D + AW + col] = gv * sigmoidf_(a + b_glu[col]); };
            gemm_tile<float, false>(gbuf, SW, RowId{}, w_glu, SW, SW, mt * 128, nt * 128, 0, SW, sm, epi);
        }
    }
    grid.sync(); REFRESH_IDS();

    rms_rows(MIXB, D, attn_out_g, mix, D, AW, T, gw, ngw, lane);
    rms_rows(mix + AW, D, ssm_out_g, mix + AW, D, SW, T, gw, ngw, lane);
    grid.sync(); REFRESH_IDS();

    {
        const int nN = D / 128, nM = T / 128;
        for (int vb = blk; vb < nM * nN; vb += nblk) {
            const int mt = vb / nN, nt = vb % nN;
            auto epi = [&](int r, int c, float a, float) { const size_t i = (size_t)r * D + nt * 128 + c; x1[i] = x[i] + a; };
            gemm_tile<float, false>(mix, D, RowId{}, w_out, D, D, mt * 128, nt * 128, 0, D, sm, epi);
        }
    }
    grid.sync(); REFRESH_IDS();

    for (int i = blk * NTHR + tid; i < CAP; i += nblk * NTHR) { rowtok[i] = -1; rowgate[i] = 0.f; rowsrc[i] = 0; rowscl[i] = 0.f; }
    {
        float* wbuf = sm + 16 * 132 + 2 * 16 * 128 + wave * 1024;
        for (int r = gw; r < T; r += ngw) {
            const float* row = x1 + (size_t)r * D; float ss = 0.f;
            for (int c = lane; c < D; c += 64) { const float v = row[c]; ss += v * v; }
            ss = wave_sum(ss); const float rs = rsqrtf(ss / (float)D + EPS);
            for (int c = lane; c < D; c += 64) { const float xv = row[c]; wbuf[c] = xv * rs * norm_ffn_g[c]; X1B[(size_t)r * D + c] = f2bf(xv); }
            if (lane == 0) r1[r] = rs;
            const int e = lane & 31, kh = lane >> 5; float part = 0.f;
            for (int k = kh * 512; k < kh * 512 + 512; ++k) part += wbuf[k] * w_router[(size_t)k * NE + e];
            part += __shfl_xor(part, 32);
            float lg = (lane < 32) ? part + b_router[e] : -INFINITY;
            float tv[TOPK]; int ti[TOPK];
#pragma unroll
            for (int k = 0; k < TOPK; ++k) { const float mx = wave_max(lg); const unsigned long long bm = __ballot(lg == mx); const int idx = __ffsll((long long)bm) - 1; tv[k] = mx; ti[k] = idx; if (lane == idx) lg = -INFINITY; }
            float es[TOPK], den = 0.f;
#pragma unroll
            for (int k = 0; k < TOPK; ++k) { es[k] = __expf(tv[k] - tv[0]); den += es[k]; }
            if (lane < TOPK) {
                float gsel = es[0]; int isel = ti[0];
#pragma unroll
                for (int k = 1; k < TOPK; ++k) if (lane == k) { gsel = es[k]; isel = ti[k]; }
                topi[(size_t)r * TOPK + lane] = isel; topg[(size_t)r * TOPK + lane] = gsel / den;
                atomicAdd(&ctl[CT_COUNT + isel], 1);
            }
        }
    }
    grid.sync(); REFRESH_IDS();

    if (tid == 0) {
        int run = 0;
        for (int e = 0; e < NE; ++e) { ism[e] = run; const int cnt = ctl[CT_COUNT + e]; run += (cnt + MB - 1) / MB * MB; }
        ism[NE] = run;
        if (blk == 0) {
            for (int e = 0; e <= NE; ++e) ctl[CT_PADSTART + e] = ism[e];
            ctl[CT_NTILES] = run / MB;
            for (int e = 0; e < NE; ++e) for (int tt = ism[e] / MB; tt < ism[e + 1] / MB; ++tt) ctl[CT_TILEEXP + tt] = e;
        }
    }
    __syncthreads();
    for (int i = blk * NTHR + tid; i < T * TOPK; i += nblk * NTHR) {
        const int e = topi[i]; const int pos = atomicAdd(&ctl[CT_CURSOR + e], 1); const int slot = ism[e] + pos;
        rowtok[slot] = i; rowgate[slot] = topg[i]; rowsrc[slot] = i >> 2; rowscl[slot] = r1[i >> 2];
    }
    grid.sync(); REFRESH_IDS();

    {
        pg8::Order So; So.init(ctl[CT_NTILES], 2 * DFF / 256, nblk, blk, ctl + CT_TILEEXP);
        pg8::EpiSwiglu E{act, b_gu, rowscl};
        pg8::gemm_phase<pg8::EpiSwiglu, pg8::GatherRows>(ldsl, (const char*)X1B, (const char*)Wgu_t, (size_t)2 * DFF * D * 2, D, So, pg8::GatherRows{rowsrc}, E);
    }
    grid.sync(); REFRESH_IDS();

    {
        pg8::Order So; So.init(ctl[CT_NTILES], D / 256, nblk, blk, ctl + CT_TILEEXP);
        pg8::EpiScatter E{Y, b_dn, rowtok, rowgate};
        pg8::gemm_phase<pg8::EpiScatter, pg8::DenseRows>(ldsl, (const char*)act, (const char*)Wdn_t, (size_t)D * DFF * 2, DFF, So, pg8::DenseRows{}, E);
    }
    grid.sync(); REFRESH_IDS();

    for (int r = gw; r < T; r += ngw) {
        float* row = x1 + (size_t)r * D; float ss = 0.f;
        for (int c = lane; c < D; c += 64) { float v = row[c];
#pragma unroll
            for (int k = 0; k < TOPK; ++k) v += bf2f(Y[((size_t)r * TOPK + k) * D + c]);
            row[c] = v; ss += v * v; }
        ss = wave_sum(ss); const float rs = rsqrtf(ss / (float)D + EPS);
        for (int c = lane; c < D; c += 64) mix[(size_t)r * D + c] = row[c] * rs * norm_ple_g[c];
    }
    grid.sync(); REFRESH_IDS();

    {
        const int nN = D / 128, nM = T / 128;
        for (int vb = blk; vb < nM * nN; vb += nblk) {
            const int mt = vb / nN, nt = vb % nN;
            auto epi = [&](int r, int c, float a, float) { Gs[(size_t)r * D + nt * 128 + c] = sigmoidf_(a); };
            gemm_tile<float, false>(mix, D, RowId{}, w_ple_gate, D, D, mt * 128, nt * 128, 0, D, sm, epi);
        }
    }
    grid.sync(); REFRESH_IDS();

    {
        const int nN = D / 128, nM = T / 128;
        for (int vb = blk; vb < nM * nN; vb += nblk) {
            const int mt = vb / nN, nt = vb % nN;
            auto epi = [&](int r, int c, float a, float) { const size_t i = (size_t)r * D + nt * 128 + c; x1[i] = x1[i] + Gs[i] * a; };
            gemm_tile<float, false>(pin, PLE, RowId{}, w_ple_proj, D, PLE, mt * 128, nt * 128, 0, D, sm, epi);
        }
    }
    grid.sync(); REFRESH_IDS();

    rms_rows(x1, D, norm_final_g, P.out, D, D, T, gw, ngw, lane);
}

extern "C" void kernel_launch(void* const* d_in, const int* in_sizes, int n_in, void* d_out, int out_size, void* d_ws, size_t ws_size, hipStream_t stream) {
    static int grid = 0;
    if (grid == 0) {
        int dev = 0, cus = 0, per_cu = 0;
        (void)hipGetDevice(&dev);
        (void)hipDeviceGetAttribute(&cus, hipDeviceAttributeMultiprocessorCount, dev);
        if (hipFuncSetAttribute((const void*)fwd_naive, hipFuncAttributeMaxDynamicSharedMemorySize, LDS_BYTES) != hipSuccess) fprintf(stderr, "kernel_launch: hipFuncSetAttribute failed\n");
        (void)hipOccupancyMaxActiveBlocksPerMultiprocessor(&per_cu, (const void*)fwd_naive, NTHR, LDS_BYTES);
        if (per_cu < 1) { fprintf(stderr, "kernel_launch: occupancy query says %d blocks per CU\n", per_cu); per_cu = 1; }
        grid = cus;
        if (n_in != 29 || ws_size < WS_END) { fprintf(stderr, "kernel_launch: unexpected n_in %d or ws_size %zu\n", n_in, ws_size); }
    }
    Params p{};
    for (int i = 0; i < 29; ++i) p.in[i] = (const float*)d_in[i];
    p.out = (float*)d_out; p.ws = (unsigned char*)d_ws;
    void* args[] = {&p};
    hipError_t e = hipLaunchCooperativeKernel((const void*)fwd_naive, dim3(grid), dim3(NTHR), args, LDS_BYTES, stream);
    if (e != hipSuccess) fprintf(stderr, "cooperative launch failed: %s (grid %d)\n", hipGetErrorString(e), grid);
}
```

```cpp
#include <hip/hip_runtime.h>
#include <hip/hip_cooperative_groups.h>
#include <cstdio>
#include <cstdint>
namespace cg = cooperative_groups;

constexpr int NB = 8, S = 4096, T = NB * S, D = 1024, NH = 8, HD = 64, AW = 512, SW = 512, INW = 2056;
constexpr int NG = 32, NP = 64, NC = 16, NE = 32, TOPK = 4, DFF = 1024, PLE = 256;
constexpr int COL_K = 512, COL_V = 1024, COL_F = 1536, COL_U = 1544;
constexpr float EPS = 1e-5f;
constexpr int NTHR = 512, NWAVE = 8;
constexpr int MB = 256;
constexpr int CAP = T * TOPK + NE * MB;
constexpr int MAXTILES = CAP / MB;
constexpr int LDS_BYTES = 147456;

typedef unsigned short bf16_t;
__device__ __forceinline__ bf16_t f2bf(float f) { unsigned u = __builtin_bit_cast(unsigned, f); return (bf16_t)((u + 0x7fffu + ((u >> 16) & 1u)) >> 16); }
__device__ __forceinline__ float bf2f(bf16_t b) { return __builtin_bit_cast(float, (unsigned)b << 16); }
__device__ __forceinline__ unsigned pk2(float lo, float hi) { return (unsigned)f2bf(lo) | ((unsigned)f2bf(hi) << 16); }
__device__ __forceinline__ float ldf(const float* p, size_t i) { return p[i]; }
__device__ __forceinline__ float ldf(const bf16_t* p, size_t i) { return bf2f(p[i]); }

constexpr size_t MiB = 1u << 20;
constexpr size_t WS_CTL = 0;
constexpr size_t WS_WIN = 1 * MiB;
constexpr size_t WS_WGLU = 5 * MiB;
constexpr size_t WS_WOUT = 6 * MiB;
constexpr size_t WS_WPG = 8 * MiB;
constexpr size_t WS_WPP = 10 * MiB;
constexpr size_t WS_A16 = 11 * MiB;
constexpr size_t WS_S5H = 12 * MiB;
constexpr size_t WS_S5TG = 16 * MiB;
constexpr size_t WS_WDN = 22 * MiB;
constexpr size_t WS_X1 = 86 * MiB;
constexpr size_t WS_TOPI = 214 * MiB;
constexpr size_t WS_TOPG = 214 * MiB + 512 * 1024;
constexpr size_t WS_ROWTOK = 215 * MiB;
constexpr size_t WS_ROWGATE = 216 * MiB;
constexpr size_t WS_ROWSRC = 217 * MiB;
constexpr size_t WS_ROWSCL = 218 * MiB;
constexpr size_t WS_R1 = 219 * MiB;
constexpr size_t WS_PSA = 220 * MiB;
constexpr size_t WS_PSS = 221 * MiB;
constexpr size_t WS_LOGF = 222 * MiB;
constexpr size_t WS_PB = 223 * MiB;
constexpr size_t WS_A = 239 * MiB;
constexpr size_t WS_XN = WS_A;
constexpr size_t WS_Q = WS_A + 64 * MiB;
constexpr size_t WS_UX = WS_A + 160 * MiB;
constexpr size_t WS_MIXB = WS_A + 212 * MiB;
constexpr size_t WS_GB = WS_A + 276 * MiB;
constexpr size_t WS_ACT = WS_A;
constexpr size_t WS_XN2 = WS_A;
constexpr size_t WS_GS = WS_A + 64 * MiB;
constexpr size_t WS_B = WS_A + 308 * MiB;
constexpr size_t WS_WGU = WS_B;
constexpr size_t WS_X1B = WS_B + 128 * MiB;
constexpr size_t WS_Y = WS_B;
constexpr size_t WS_END = WS_B + 256 * MiB;
static_assert((size_t)CAP * 4 <= MiB && (size_t)CAP * DFF * 2 <= 272 * MiB, "list arrays fit 1 MiB each; ACT fits");
constexpr int UXP = 384;
constexpr int CT_COUNT = 0, CT_CURSOR = 64, CT_PADSTART = 128, CT_NTILES = 192, CT_TILEEXP = 256;
constexpr float LOG2E = 1.4426950408889634f, C2 = 0.125f * LOG2E;

namespace pg8 {
#define PG8_LAS __attribute__((address_space(3)))
typedef short bf16x8 __attribute__((ext_vector_type(8)));
typedef float f32x4 __attribute__((ext_vector_type(4)));
typedef unsigned u32x4 __attribute__((ext_vector_type(4)));
constexpr int BM = 256, BK = 64, HALF = 128, HTB = HALF * BK * 2, STAGE_BYTES = 8 * HTB, NXCD = 8, WGM = 8;
__device__ __forceinline__ int lds_byte(int r, int c) { const int st = (r >> 4) * 2 + (c >> 5), rr = r & 15, cc = c & 31, ob = rr * 64 + cc * 2; return st * 1024 + (ob ^ (((ob >> 9) & 1) << 5)); }
__device__ __forceinline__ void stage_rc(int b, int& R, int& C) { const int st = b / 1024, sb = b % 1024, swz = sb ^ (((sb >> 9) & 1) << 5); R = (st >> 1) * 16 + swz / 64; C = (st & 1) * 32 + (swz % 64) / 2; }
__device__ __forceinline__ int perm32(int rho) { const int n = rho >> 4, i = rho & 15; return 8 * (i >> 2) + 4 * n + (i & 3); }
struct Unit { int pm, pn, e; };
struct Order {
    int nM, nN, nwg, G, c; const int* texp;
    __device__ void init(int nM_, int nN_, int G_, int c_, const int* texp_) { nM = nM_; nN = nN_; nwg = nM * nN; G = G_; c = c_; texp = texp_; }
    __device__ bool next(int i, Unit& u) const {
        const long L = (long)i * G + c; if (L >= nwg) return false;
        int wgid = (int)L; { const int q = nwg / NXCD, r = nwg % NXCD, xcd = wgid % NXCD, off = wgid / NXCD; wgid = (xcd < r ? xcd * (q + 1) : r * (q + 1) + (xcd - r) * q) + off; }
        const int nig = WGM * nN, gid = wgid / nig, fm = gid * WGM, gsz = (nM - fm) < WGM ? (nM - fm) : WGM;
        u.pm = fm + ((wgid % nig) % gsz); u.pn = (wgid % nig) / gsz; u.e = texp ? __builtin_amdgcn_readfirstlane(texp[u.pm]) : 0; return true;
    }
};
struct DenseRows { int lda; __device__ __forceinline__ unsigned rowoff(const Unit& u, int r) const { return (unsigned)(u.pm * BM + r) * (unsigned)lda; } };
struct GatherRows { const int* src; int lda; __device__ __forceinline__ unsigned rowoff(const Unit& u, int r) const { return (unsigned)src[u.pm * BM + r] * (unsigned)lda; } };
struct OneUnit { int pm, e; __device__ bool next(int i, Unit& u) const { if (i) return false; u.pm = pm; u.pn = 0; u.e = e; return true; } };
typedef float f32x2_t __attribute__((ext_vector_type(2))); typedef __bf16 bf16x2_t __attribute__((ext_vector_type(2)));
__device__ __forceinline__ unsigned cvt_pk_bf16(float lo, float hi) { f32x2_t v = {lo, hi}; bf16x2_t b = __builtin_convertvector(v, bf16x2_t); return __builtin_bit_cast(unsigned, b); }

template <class Epi, class ARow, class Sched>
__device__ __forceinline__ void gemm_phase(PG8_LAS unsigned char* lds, const char* Abase, const char* Bbase, size_t b_estride, int K, const Sched& S, const ARow& AR, const Epi& E) {
    int tid = threadIdx.x; asm volatile("" : "+v"(tid));
    const int wid = __builtin_amdgcn_readfirstlane(tid >> 6), lane = tid & 63, wr = wid >> 2, wc = wid & 3, fr = lane & 15, fq = lane >> 4;
    const int nt = K / BK;
    int Rr[2], Cc[2]; unsigned voffB[2];
#pragma unroll
    for (int i = 0; i < 2; ++i) { int R, C; stage_rc(tid * 16 + i * 8192, R, C); const int Rb = Epi::PERM ? ((R & ~31) + perm32(R & 31)) : R; Rr[i] = R; Cc[i] = C; voffB[i] = (unsigned)(Rb * K + C) * 2u; }
    const size_t kstep = (size_t)(BK * 2), hstep = (size_t)HALF * K * 2, tstep = 2 * hstep;
    const unsigned ldsw = (unsigned)wid * 1024u;
    const int aoff = lds_byte(wr * 64 + fr, fq * 8), boff = lds_byte(wc * 32 + fr, fq * 8);
#define PG8_SA(b, h) (((b) * 2 + (h)) * HTB)
#define PG8_SB(b, h) ((4 + (b) * 2 + (h)) * HTB)
#define PG8_STAGE(bufoff, gbase, voff) do { _Pragma("unroll") for (int _i = 0; _i < 2; ++_i) \
        __builtin_amdgcn_global_load_lds((const unsigned*)((const char*)(gbase) + (voff)[_i]), (PG8_LAS unsigned*)(lds + (bufoff) + ldsw + _i * 8192), 16, 0, 0); } while (0)
#define PG8_LDA(dst, b, h) do { _Pragma("unroll") for (int m = 0; m < 4; ++m) _Pragma("unroll") for (int k = 0; k < 2; ++k) dst[m][k] = *(const PG8_LAS bf16x8*)(lds + PG8_SA(b, h) + aoff + m * 2048 + k * 1024); } while (0)
#define PG8_LDB(dst, b, h) do { _Pragma("unroll") for (int n = 0; n < 2; ++n) _Pragma("unroll") for (int k = 0; k < 2; ++k) dst[n][k] = *(const PG8_LAS bf16x8*)(lds + PG8_SB(b, h) + boff + n * 2048 + k * 1024); } while (0)
#define PG8_MMA(ai, bj, At, Bt) do { __builtin_amdgcn_s_setprio(1); _Pragma("unroll") for (int m = 0; m < 4; ++m) _Pragma("unroll") for (int n = 0; n < 2; ++n) _Pragma("unroll") for (int k = 0; k < 2; ++k) \
        acc[ai][bj][m][n] = __builtin_amdgcn_mfma_f32_16x16x32_bf16(Bt[n][k], At[m][k], acc[ai][bj][m][n], 0, 0, 0); __builtin_amdgcn_s_setprio(0); } while (0)
#define PG8_WAIT_V(n) asm volatile("s_waitcnt vmcnt(" #n ")" ::: "memory")
#define PG8_WAIT_L(n) asm volatile("s_waitcnt lgkmcnt(" #n ")" ::: "memory")
#define PG8_BAR __builtin_amdgcn_s_barrier()
#define PG8_SCHED __builtin_amdgcn_sched_barrier(0)
#define PG8_VOFF(dst, u) do { _Pragma("unroll") for (int _h = 0; _h < 2; ++_h) _Pragma("unroll") for (int _i = 0; _i < 2; ++_i) dst[_h][_i] = (AR.rowoff(u, _h * HALF + Rr[_i]) + (unsigned)Cc[_i]) * 2u; } while (0)
    Unit cur, nxt; int ui = 0;
    if (!S.next(0, cur)) return;
    f32x4 acc[2][2][4][2];
#pragma unroll
    for (int a = 0; a < 2; ++a)
#pragma unroll
        for (int b = 0; b < 2; ++b)
#pragma unroll
            for (int m = 0; m < 4; ++m)
#pragma unroll
                for (int n = 0; n < 2; ++n) acc[a][b][m][n] = (f32x4){0.f, 0.f, 0.f, 0.f};
    bf16x8 At[4][2], B0[2][2], B1[2][2];
    unsigned cvA[2][2], nvA[2][2];
    PG8_VOFF(cvA, cur);
    const char* cB = Bbase + (size_t)cur.e * b_estride + (size_t)cur.pn * tstep;
    PG8_STAGE(PG8_SB(0, 0), cB, voffB); PG8_STAGE(PG8_SB(0, 1), cB + hstep, voffB); PG8_STAGE(PG8_SA(0, 0), Abase, cvA[0]); PG8_STAGE(PG8_SA(0, 1), Abase, cvA[1]);
    if (wr == 1) PG8_BAR;
    PG8_WAIT_V(2); PG8_BAR;
    PG8_STAGE(PG8_SB(1, 0), cB + kstep, voffB); PG8_STAGE(PG8_SA(1, 0), Abase + kstep, cvA[0]); PG8_STAGE(PG8_SB(1, 1), cB + hstep + kstep, voffB);
    PG8_WAIT_V(6); PG8_BAR;
    for (;;) {
        const bool has_next = S.next(ui + 1, nxt);
        if (has_next) { PG8_VOFF(nvA, nxt); } else {
#pragma unroll
            for (int h = 0; h < 2; ++h)
#pragma unroll
                for (int i = 0; i < 2; ++i) nvA[h][i] = cvA[h][i]; }
        const char* nB = has_next ? Bbase + (size_t)nxt.e * b_estride + (size_t)nxt.pn * tstep : cB;
        for (int t = 0; t < nt; t += 2) {
            const bool last = (t == nt - 2);
            if constexpr (Epi::MID) { if (t == nt / 2) E.mid(acc, cur, wr, wc, fr, fq); }
            const char* a1 = Abase + (size_t)(t + 1) * kstep;
            const char* a2 = last ? Abase : Abase + (size_t)(t + 2) * kstep; const char* b2 = last ? nB : cB + (size_t)(t + 2) * kstep;
            const char* a3 = a2 + kstep; const char* b3 = b2 + kstep;
            unsigned v2[2][2];
#pragma unroll
            for (int h = 0; h < 2; ++h)
#pragma unroll
                for (int i = 0; i < 2; ++i) v2[h][i] = last ? nvA[h][i] : cvA[h][i];
            PG8_LDB(B0, 0, 0); PG8_LDB(B1, 0, 1); PG8_SCHED; PG8_LDA(At, 0, 0); PG8_STAGE(PG8_SA(1, 1), a1, cvA[1]);
            PG8_WAIT_V(8); PG8_WAIT_L(0); PG8_BAR; PG8_MMA(0, 0, At, B0); PG8_MMA(0, 1, At, B1); PG8_BAR; PG8_SCHED;
            PG8_LDA(At, 0, 1); PG8_STAGE(PG8_SB(0, 0), b2, voffB); PG8_STAGE(PG8_SB(0, 1), b2 + hstep, voffB); PG8_STAGE(PG8_SA(0, 0), a2, v2[0]);
            PG8_WAIT_V(8); PG8_WAIT_L(0); PG8_BAR; PG8_MMA(1, 0, At, B0); PG8_MMA(1, 1, At, B1); PG8_BAR; PG8_SCHED;
            PG8_LDB(B0, 1, 0); PG8_LDB(B1, 1, 1); PG8_SCHED; PG8_LDA(At, 1, 0); PG8_STAGE(PG8_SA(0, 1), a2, v2[1]);
            PG8_WAIT_V(8); PG8_WAIT_L(0); PG8_BAR; PG8_MMA(0, 0, At, B0); PG8_MMA(0, 1, At, B1); PG8_BAR; PG8_SCHED;
            PG8_LDA(At, 1, 1); PG8_STAGE(PG8_SB(1, 0), b3, voffB); PG8_STAGE(PG8_SB(1, 1), b3 + hstep, voffB); PG8_STAGE(PG8_SA(1, 0), a3, v2[0]);
            PG8_WAIT_V(8); PG8_WAIT_L(0); PG8_BAR; PG8_MMA(1, 0, At, B0); PG8_MMA(1, 1, At, B1); PG8_BAR; PG8_SCHED;
        }
        if (wr == 0) PG8_BAR;
        if constexpr (!Epi::AFTER) E(acc, cur, wr, wc, fr, fq);
        if (!has_next) break;
#pragma unroll
        for (int a = 0; a < 2; ++a)
#pragma unroll
            for (int b = 0; b < 2; ++b)
#pragma unroll
                for (int m = 0; m < 4; ++m)
#pragma unroll
                    for (int n = 0; n < 2; ++n) acc[a][b][m][n] = (f32x4){0.f, 0.f, 0.f, 0.f};
        cur = nxt; cB = nB; ++ui;
#pragma unroll
        for (int h = 0; h < 2; ++h)
#pragma unroll
            for (int i = 0; i < 2; ++i) cvA[h][i] = nvA[h][i];
        if (wr == 1) PG8_BAR;
    }
    PG8_WAIT_V(0);
    PG8_BAR;
    if constexpr (Epi::AFTER) E.after(acc, cur, wr, wc, fr, fq, lds);
#undef PG8_SA
#undef PG8_SB
#undef PG8_STAGE
#undef PG8_LDA
#undef PG8_LDB
#undef PG8_MMA
#undef PG8_WAIT_V
#undef PG8_WAIT_L
#undef PG8_BAR
#undef PG8_SCHED
#undef PG8_VOFF
}

__device__ __forceinline__ float sigm(float x) { return __builtin_amdgcn_rcpf(1.f + __builtin_amdgcn_exp2f(-1.4426950408889634f * x)); }
struct EpiSwiglu {
    static constexpr bool PERM = true, MID = false, AFTER = false;
    bf16_t* act; const float* b_gu; const float* rowscale;
    __device__ __forceinline__ void operator()(const f32x4 (&acc)[2][2][4][2], const Unit& u, int wr, int wc, int fr, int fq) const {
        const int row0 = u.pm * BM + wr * 64 + fr, col0 = u.pn * HALF + wc * 32 + 8 * fq;
        const float* bias = b_gu + (size_t)u.e * (2 * DFF) + col0;
        f32x4 bg[2], bu[2];
#pragma unroll
        for (int n = 0; n < 2; ++n) { bg[n] = *(const f32x4*)(bias + 4 * n); bu[n] = *(const f32x4*)(bias + DFF + 4 * n); }
#pragma unroll
        for (int ai = 0; ai < 2; ++ai)
#pragma unroll
            for (int m = 0; m < 4; ++m) { const int row = row0 + ai * HALF + m * 16; const float rs = rowscale[row];
                float o[8];
#pragma unroll
                for (int n = 0; n < 2; ++n)
#pragma unroll
                    for (int j = 0; j < 4; ++j) { const float g = fminf(acc[ai][0][m][n][j] * rs + bg[n][j], 7.f); const float up = fminf(fmaxf(acc[ai][1][m][n][j] * rs + bu[n][j], -7.f), 7.f);
                        o[4 * n + j] = g * sigm(1.702f * g) * (up + 1.f); }
                u32x4 w; w.x = cvt_pk_bf16(o[0], o[1]); w.y = cvt_pk_bf16(o[2], o[3]); w.z = cvt_pk_bf16(o[4], o[5]); w.w = cvt_pk_bf16(o[6], o[7]);
                *(u32x4*)(act + (size_t)row * DFF + col0) = w; }
    }
};
struct EpiScatter {
    static constexpr bool PERM = true, MID = false, AFTER = false;
    bf16_t* Y; const float* b_dn; const int* rowtok; const float* rowgate;
    __device__ __forceinline__ void operator()(const f32x4 (&acc)[2][2][4][2], const Unit& u, int wr, int wc, int fr, int fq) const {
        const int row0 = u.pm * BM + wr * 64 + fr, col0 = u.pn * BM + wc * 32 + 8 * fq;
        const float* bias = b_dn + (size_t)u.e * D + col0;
        f32x4 bv[2][2];
#pragma unroll
        for (int bj = 0; bj < 2; ++bj)
#pragma unroll
            for (int n = 0; n < 2; ++n) bv[bj][n] = *(const f32x4*)(bias + bj * HALF + 4 * n);
#pragma unroll
        for (int ai = 0; ai < 2; ++ai)
#pragma unroll
            for (int m = 0; m < 4; ++m) { const int row = row0 + ai * HALF + m * 16; const int id = rowtok[row]; const float gt = rowgate[row];
                if (id >= 0) { bf16_t* yp = Y + (size_t)id * D + col0;
#pragma unroll
                    for (int bj = 0; bj < 2; ++bj) { const f32x4 v0 = (acc[ai][bj][m][0] + bv[bj][0]) * gt, v1 = (acc[ai][bj][m][1] + bv[bj][1]) * gt;
                        u32x4 w; w.x = cvt_pk_bf16(v0[0], v0[1]); w.y = cvt_pk_bf16(v0[2], v0[3]); w.z = cvt_pk_bf16(v1[0], v1[1]); w.w = cvt_pk_bf16(v1[2], v1[3]);
                        *(u32x4*)(yp + bj * HALF) = w; } } }
    }
};
struct EpiQKVU {
    static constexpr bool PERM = true, MID = false, AFTER = false;
    bf16_t* O; size_t stride; bf16_t* ux;
    __device__ __forceinline__ void operator()(const f32x4 (&acc)[2][2][4][2], const Unit& u, int wr, int wc, int fr, int fq) const {
        const int row0 = u.pm * BM + wr * 64 + fr, t = u.pn >> 1; const float sc = (t == 0) ? C2 : 1.f;
        const int colt = (u.pn & 1) * BM + wc * 32 + 8 * fq;
        bf16_t* base = O + (size_t)t * stride + colt;
#pragma unroll
        for (int ai = 0; ai < 2; ++ai)
#pragma unroll
            for (int m = 0; m < 4; ++m) { const int row = row0 + ai * HALF + m * 16;
#pragma unroll
                for (int bj = 0; bj < 2; ++bj) { const f32x4 v0 = acc[ai][bj][m][0] * sc, v1 = acc[ai][bj][m][1] * sc;
                    u32x4 w; w.x = cvt_pk_bf16(v0[0], v0[1]); w.y = cvt_pk_bf16(v0[2], v0[3]); w.z = cvt_pk_bf16(v1[0], v1[1]); w.w = cvt_pk_bf16(v1[2], v1[3]);
                    if (t < 3) *(u32x4*)(base + (size_t)row * 512 + bj * HALF) = w;
                    else { const int col = colt + bj * HALF, g = col >> 4, b = row >> 12, tt = row & (S - 1);
                        *(u32x4*)(ux + ((size_t)((g * NB + b) * 256 + (tt >> 4))) * UXP + (tt & 15) * 16 + (col & 15)) = w; } } }
    }
};
struct EpiS5H {
    static constexpr bool PERM = false, MID = false, AFTER = true;
    bf16_t* ux; const float* a16;
    __device__ __forceinline__ void operator()(const f32x4 (&)[2][2][4][2], const Unit&, int, int, int, int) const {}
    __device__ __forceinline__ void after(const f32x4 (&acc)[2][2][4][2], const Unit& u, int wr, int wc, int fr, int fq, PG8_LAS unsigned char* lds) const {
        PG8_LAS float* Sx = (PG8_LAS float*)lds;
        const int row0 = wr * 64 + fr, col0 = wc * 32 + 4 * fq;
#pragma unroll
        for (int ai = 0; ai < 2; ++ai)
#pragma unroll
            for (int m = 0; m < 4; ++m)
#pragma unroll
                for (int n = 0; n < 2; ++n) *(PG8_LAS f32x4*)(Sx + (row0 + ai * HALF + m * 16) * 128 + col0 + n * 16) = acc[ai][0][m][n];
        asm volatile("s_waitcnt lgkmcnt(0)" ::: "memory"); __builtin_amdgcn_s_barrier(); asm volatile("" ::: "memory");
        if (threadIdx.x < 64) {
            const int p = threadIdx.x; const float ar = a16[2 * p], ai_ = a16[2 * p + 1]; float xr = 0.f, xi = 0.f;
            bf16_t* urow = ux + (size_t)u.pm * 256 * UXP + 256;
            urow[p] = 0; urow[64 + p] = 0;
#pragma unroll 8
            for (int c = 0; c < 255; ++c) { const float sr = Sx[c * 128 + p], si = Sx[c * 128 + 64 + p];
                const float nxr = ar * xr - ai_ * xi + sr, nxi = ar * xi + ai_ * xr + si; xr = nxr; xi = nxi;
                urow[(size_t)(c + 1) * UXP + p] = f2bf(xr); urow[(size_t)(c + 1) * UXP + 64 + p] = f2bf(xi); }
            asm volatile("s_waitcnt vmcnt(0)" ::: "memory");
        }
        asm volatile("s_waitcnt lgkmcnt(0)" ::: "memory"); __builtin_amdgcn_s_barrier(); asm volatile("" ::: "memory");
    }
};
struct EpiS5Y {
    static constexpr bool PERM = true, MID = false, AFTER = false;
    const bf16_t* ux; const float* d_skip; bf16_t* G;
    __device__ __forceinline__ void operator()(const f32x4 (&acc)[2][2][4][2], const Unit& u, int wr, int wc, int fr, int fq) const {
        const int row0 = wr * 64 + fr, g = u.e, b = u.pm & 7, co0 = 8 * (fq & 1);
        const f32x4 d0 = *(const f32x4*)(d_skip + g * 16 + co0), d1 = *(const f32x4*)(d_skip + g * 16 + co0 + 4);
#pragma unroll
        for (int ai = 0; ai < 2; ++ai)
#pragma unroll
            for (int m = 0; m < 4; ++m) { const int c = row0 + ai * HALF + m * 16;
#pragma unroll
                for (int bj = 0; bj < 2; ++bj) { const int ncol = bj * HALF + wc * 32 + 8 * fq, i = ncol >> 4;
                    const u32x4 uv = *(const u32x4*)(ux + ((size_t)u.pm * 256 + c) * UXP + ncol); float o[8];
#pragma unroll
                    for (int n = 0; n < 2; ++n)
#pragma unroll
                        for (int j = 0; j < 4; ++j) { const unsigned w = uv[2 * n + (j >> 1)]; const float uu = __builtin_bit_cast(float, (j & 1) ? (w & 0xffff0000u) : (w << 16));
                            const float y = acc[ai][bj][m][n][j] + (n ? d1[j] : d0[j]) * uu; o[4 * n + j] = y * sigm(1.5957691216057308f * (y + 0.044715f * y * y * y)); }
                    u32x4 w; w.x = cvt_pk_bf16(o[0], o[1]); w.y = cvt_pk_bf16(o[2], o[3]); w.z = cvt_pk_bf16(o[4], o[5]); w.w = cvt_pk_bf16(o[6], o[7]);
                    *(u32x4*)(G + ((size_t)b * S + c * 16 + i) * SW + g * 16 + co0) = w; } }
    }
};
struct EpiGlu {
    static constexpr bool PERM = true, MID = false, AFTER = false;
    const bf16_t* G; bf16_t* mixb; const float* b_glu; float* pss;
    __device__ __forceinline__ void operator()(const f32x4 (&acc)[2][2][4][2], const Unit& u, int wr, int wc, int fr, int fq) const {
        const int row0 = u.pm * BM + wr * 64 + fr, col0 = u.pn * BM + wc * 32 + 8 * fq;
        f32x4 bv[2][2];
#pragma unroll
        for (int bj = 0; bj < 2; ++bj)
#pragma unroll
            for (int n = 0; n < 2; ++n) bv[bj][n] = *(const f32x4*)(b_glu + col0 + bj * HALF + 4 * n);
#pragma unroll
        for (int ai = 0; ai < 2; ++ai)
#pragma unroll
            for (int m = 0; m < 4; ++m) { const int row = row0 + ai * HALF + m * 16; float ss = 0.f;
#pragma unroll
                for (int bj = 0; bj < 2; ++bj) { const u32x4 gv = *(const u32x4*)(G + (size_t)row * SW + col0 + bj * HALF); float o[8];
#pragma unroll
                    for (int n = 0; n < 2; ++n)
#pragma unroll
                        for (int j = 0; j < 4; ++j) { const unsigned w = gv[2 * n + (j >> 1)]; const float g = __builtin_bit_cast(float, (j & 1) ? (w & 0xffff0000u) : (w << 16));
                            const float v = g * sigm(acc[ai][bj][m][n][j] + bv[bj][n][j]); o[4 * n + j] = v; ss += v * v; }
                    u32x4 w; w.x = cvt_pk_bf16(o[0], o[1]); w.y = cvt_pk_bf16(o[2], o[3]); w.z = cvt_pk_bf16(o[4], o[5]); w.w = cvt_pk_bf16(o[6], o[7]);
                    *(u32x4*)(mixb + (size_t)row * D + AW + col0 + bj * HALF) = w; }
                ss += __shfl_xor(ss, 16); ss += __shfl_xor(ss, 32);
                if (fq == 0) pss[(size_t)row * 8 + u.pn * 4 + wc] = ss; }
    }
};
struct EpiOut {
    static constexpr bool PERM = false, MID = true, AFTER = false;
    const float* x; float* x1; bf16_t* x1b; const float* psa; const float* pss;
    __device__ __forceinline__ float rsum8(const float* p) const { const f32x4 a = *(const f32x4*)p, b = *(const f32x4*)(p + 4); return ((a[0] + a[1]) + (a[2] + a[3])) + ((b[0] + b[1]) + (b[2] + b[3])); }
    __device__ __forceinline__ void mid(f32x4 (&acc)[2][2][4][2], const Unit& u, int wr, int wc, int fr, int fq) const {
        int row0 = u.pm * BM + wr * 64 + fr; asm volatile("" : "+v"(row0));
#pragma unroll
        for (int ai = 0; ai < 2; ++ai)
#pragma unroll
            for (int m = 0; m < 4; ++m) { const int row = row0 + ai * HALF + m * 16;
                const float ra = rsqrtf(rsum8(psa + (size_t)row * 8) * (1.f / AW) + EPS), rs = rsqrtf(rsum8(pss + (size_t)row * 8) * (1.f / SW) + EPS); const float f = ra / rs;
#pragma unroll
                for (int bj = 0; bj < 2; ++bj)
#pragma unroll
                    for (int n = 0; n < 2; ++n) acc[ai][bj][m][n] *= f;
                asm volatile("" ::: "memory"); }
    }
    __device__ __forceinline__ void operator()(const f32x4 (&acc)[2][2][4][2], const Unit& u, int wr, int wc, int fr, int fq) const {
        int row0 = u.pm * BM + wr * 64 + fr; asm volatile("" : "+v"(row0)); const int col0 = u.pn * BM + wc * 32 + 4 * fq;
#pragma unroll
        for (int ai = 0; ai < 2; ++ai)
#pragma unroll
            for (int m = 0; m < 4; ++m) { const int row = row0 + ai * HALF + m * 16; const float rs = rsqrtf(rsum8(pss + (size_t)row * 8) * (1.f / SW) + EPS); const size_t off = (size_t)row * D + col0;
#pragma unroll
                for (int bj = 0; bj < 2; ++bj)
#pragma unroll
                    for (int n = 0; n < 2; ++n) { const size_t o2 = off + bj * HALF + n * 16; const f32x4 v = *(const f32x4*)(x + o2) + acc[ai][bj][m][n] * rs;
                        *(f32x4*)(x1 + o2) = v; uint2 w; w.x = cvt_pk_bf16(v[0], v[1]); w.y = cvt_pk_bf16(v[2], v[3]); *(uint2*)(x1b + o2) = w; }
                asm volatile("" ::: "memory"); }
    }
};
struct EpiGate {
    static constexpr bool PERM = false, MID = false, AFTER = false;
    bf16_t* gs;
    __device__ __forceinline__ void operator()(const f32x4 (&acc)[2][2][4][2], const Unit& u, int wr, int wc, int fr, int fq) const {
        const int row0 = u.pm * BM + wr * 64 + fr, col0 = u.pn * BM + wc * 32 + 4 * fq;
#pragma unroll
        for (int ai = 0; ai < 2; ++ai)
#pragma unroll
            for (int m = 0; m < 4; ++m) { const size_t off = (size_t)(row0 + ai * HALF + m * 16) * D + col0;
#pragma unroll
                for (int bj = 0; bj < 2; ++bj)
#pragma unroll
                    for (int n = 0; n < 2; ++n) { const f32x4 a = acc[ai][bj][m][n]; uint2 w; w.x = cvt_pk_bf16(sigm(a[0]), sigm(a[1])); w.y = cvt_pk_bf16(sigm(a[2]), sigm(a[3])); *(uint2*)(gs + off + bj * HALF + n * 16) = w; } }
    }
};
struct EpiPle {
    static constexpr bool PERM = false, MID = false, AFTER = false;
    const bf16_t* gs; float* x2;
    __device__ __forceinline__ void operator()(const f32x4 (&acc)[2][2][4][2], const Unit& u, int wr, int wc, int fr, int fq) const {
        const int row0 = u.pm * BM + wr * 64 + fr, col0 = u.pn * BM + wc * 32 + 4 * fq;
#pragma unroll
        for (int ai = 0; ai < 2; ++ai)
#pragma unroll
            for (int m = 0; m < 4; ++m) { const size_t off = (size_t)(row0 + ai * HALF + m * 16) * D + col0;
#pragma unroll
                for (int bj = 0; bj < 2; ++bj)
#pragma unroll
                    for (int n = 0; n < 2; ++n) { const size_t o2 = off + bj * HALF + n * 16;
                        const unsigned long long gw_ = __hip_atomic_load((const unsigned long long*)(gs + o2), __ATOMIC_RELAXED, __HIP_MEMORY_SCOPE_AGENT);
                        const unsigned lo = (unsigned)gw_, hi = (unsigned)(gw_ >> 32);
                        f32x4 g; g[0] = __builtin_bit_cast(float, lo << 16); g[1] = __builtin_bit_cast(float, lo & 0xffff0000u); g[2] = __builtin_bit_cast(float, hi << 16); g[3] = __builtin_bit_cast(float, hi & 0xffff0000u);
                        *(f32x4*)(x2 + o2) = *(const f32x4*)(x2 + o2) + g * acc[ai][bj][m][n]; } }
    }
};
}

__device__ __forceinline__ void transpose_item(const float* W, int ldw, int k0, int c0, const float* kscale, bf16_t* WT, int K, int r0, __attribute__((address_space(3))) float* scr, int lane) {
#pragma unroll 8
    for (int i = 0; i < 32; ++i) { const int kk = 2 * i + (lane >> 5); float v = W[(size_t)(k0 + kk) * ldw + c0 + (lane & 31)]; if (kscale) v *= kscale[k0 + kk]; scr[kk * 33 + (lane & 31)] = v; }
    __builtin_amdgcn_s_waitcnt(0xC07F); asm volatile("" ::: "memory");
    const int c = lane & 7;
#pragma unroll
    for (int j = 0; j < 4; ++j) { const int n = (lane >> 3) + 8 * j; const __attribute__((address_space(3))) float* s = scr + (8 * c) * 33 + n;
        uint4 o; o.x = pk2(s[0 * 33], s[1 * 33]); o.y = pk2(s[2 * 33], s[3 * 33]); o.z = pk2(s[4 * 33], s[5 * 33]); o.w = pk2(s[6 * 33], s[7 * 33]);
        *(uint4*)(WT + (size_t)(r0 + n) * K + k0 + 8 * c) = o; }
    __builtin_amdgcn_s_waitcnt(0xC07F); asm volatile("" ::: "memory");
}


namespace attn_body {
using bf16x8=__attribute__((ext_vector_type(8)))short;
using s16x4=__attribute__((ext_vector_type(4)))short;
using f32x16=__attribute__((ext_vector_type(16)))float;
using f32x4=__attribute__((ext_vector_type(4)))float;
using u32x4=__attribute__((ext_vector_type(4)))unsigned;
constexpr int SEQ=S,DH=64,DM=NH*DH,OPITCH=D;
constexpr int NW=8,QBLK=32,QB=QBLK*NW,KVBLK=64,NQB=SEQ/QB;
__device__ __forceinline__ int crow(int r,int hi){return (r&3)+8*(r>>2)+4*hi;}
#define SBAR() __builtin_amdgcn_sched_barrier(0)
__device__ __forceinline__ void cmask(f32x16&p0,f32x16&p1,int jb,int qrel,int hi){
  const float NEG=-INFINITY; int kb=64*jb+4*hi;
  #pragma unroll
  for(int r=0;r<16;++r){int kv=kb+(r&3)+8*(r>>2); if(kv>qrel)p0[r]=NEG; if(kv+32>qrel)p1[r]=NEG;}
}
constexpr int NSLOT=3, SLOTB=8192;
constexpr int LDS_K=0, LDS_V=NSLOT*SLOTB, LDS_WS=2*NSLOT*SLOTB, LDS_OST=LDS_WS+NW*64*4, LDS_C=LDS_OST+NW*4096, ATT_LDS_BYTES=LDS_C+(SEQ+64)*4;
__device__ __forceinline__ void glds16(const void*gsrc,unsigned lds_dst){unsigned keep;
  asm volatile("s_mov_b32 %0, m0\n\ts_mov_b32 m0, %2\n\ts_nop 0\n\tglobal_load_lds_dwordx4 %1, off\n\ts_mov_b32 m0, %0":"=&s"(keep):"v"(gsrc),"s"(lds_dst):"memory");}
__device__ __forceinline__ float max3f(float a,float b,float c){float r;asm("v_max3_f32 %0, %1, %2, %3":"=v"(r):"v"(a),"v"(b),"v"(c));return r;}
__device__ __forceinline__ float max2f(float a,float b){float r;asm("v_max_f32_e32 %0, %1, %2":"=v"(r):"v"(a),"v"(b));return r;}
__device__ __forceinline__ float fadd_s(float a,float b){float r;asm("v_add_f32_e32 %0, %1, %2":"=v"(r):"v"(a),"v"(b));return r;}
__device__ __forceinline__ float fsub_s(float a,float b){float r;asm("v_sub_f32_e32 %0, %1, %2":"=v"(r):"v"(a),"v"(b));return r;}
typedef float f32x2_t __attribute__((ext_vector_type(2))); typedef __bf16 bf16x2_t __attribute__((ext_vector_type(2)));
__device__ __forceinline__ unsigned cvtpk_s(float lo,float hi){f32x2_t v={lo,hi};bf16x2_t b=__builtin_convertvector(v,bf16x2_t);return __builtin_bit_cast(unsigned,b);}
#define WAIT_BAR(N) asm volatile("s_waitcnt vmcnt(" #N ") lgkmcnt(0)\n\ts_barrier":::"memory")
typedef __attribute__((address_space(3))) const char* lds_cptr;
typedef __attribute__((address_space(3))) const float* lds_fptr;
typedef short v4i16_t __attribute__((ext_vector_type(4)));
__device__ __forceinline__ void qkt(f32x16&p0,f32x16&p1,const char*Kslot,const bf16x8*qr,int r32,int hi){
  const char*kb=Kslot+hi*1024+r32*16;
  #pragma unroll
  for(int d0=0;d0<4;++d0){
    const bf16x8 b0=*reinterpret_cast<const bf16x8*>(kb+d0*2048);
    const bf16x8 b1=*reinterpret_cast<const bf16x8*>(kb+d0*2048+512);
    p0=__builtin_amdgcn_mfma_f32_32x32x16_bf16(b0,qr[d0],p0,0,0,0);p1=__builtin_amdgcn_mfma_f32_32x32x16_bf16(b1,qr[d0],p1,0,0,0);}
}
__device__ __forceinline__ void kload8(bf16x8*kf,lds_cptr kp){
  kf[0]=*(const __attribute__((address_space(3))) bf16x8*)(kp);      kf[1]=*(const __attribute__((address_space(3))) bf16x8*)(kp+512);
  kf[2]=*(const __attribute__((address_space(3))) bf16x8*)(kp+2048); kf[3]=*(const __attribute__((address_space(3))) bf16x8*)(kp+2560);
  kf[4]=*(const __attribute__((address_space(3))) bf16x8*)(kp+4096); kf[5]=*(const __attribute__((address_space(3))) bf16x8*)(kp+4608);
  kf[6]=*(const __attribute__((address_space(3))) bf16x8*)(kp+6144); kf[7]=*(const __attribute__((address_space(3))) bf16x8*)(kp+6656);
}
__device__ __forceinline__ void kload2(bf16x8*kf,lds_cptr kp,int j){ kf[2*j]=*(const __attribute__((address_space(3))) bf16x8*)(kp+j*2048); kf[2*j+1]=*(const __attribute__((address_space(3))) bf16x8*)(kp+j*2048+512); }
__device__ __forceinline__ s16x4 vtr(lds_cptr p){ return __builtin_bit_cast(s16x4,__builtin_amdgcn_ds_read_tr16_b64_v4i16((__attribute__((address_space(3))) v4i16_t*)p)); }
__device__ __forceinline__ float rowmax(const f32x16&p0,const f32x16&p1){
  float a=max3f(p0[0],p0[1],p1[0]),b=max3f(p0[2],p0[3],p1[1]);a=max3f(a,p1[2],p1[3]);
  #pragma unroll
  for(int r=4;r<16;r+=4){a=max3f(a,p0[r],p0[r+1]);b=max3f(b,p0[r+2],p0[r+3]);a=max3f(a,p1[r],p1[r+1]);b=max3f(b,p1[r+2],p1[r+3]);}
  const float m=max2f(a,b);
  auto rr=__builtin_amdgcn_permlane32_swap(__float_as_uint(m),__float_as_uint(m),false,false);
  return max2f(__uint_as_float(rr[0]),__uint_as_float(rr[1]));
}
__device__ __forceinline__ void pv(f32x16*o,int vb,bf16x8 pa0,bf16x8 pa1,bf16x8 pa2,bf16x8 pa3){
  #pragma unroll
  for(int d0=0;d0<2;++d0){s16x4 lo[4],hi[4];
    #pragma unroll
    for(int ks=0;ks<4;++ks){
      asm volatile("ds_read_b64_tr_b16 %0,%1 offset:%c2":"=&v"(lo[ks]):"v"(vb),"i"(d0*4096+ks*1024):"memory");
      asm volatile("ds_read_b64_tr_b16 %0,%1 offset:%c2":"=&v"(hi[ks]):"v"(vb),"i"(d0*4096+ks*1024+512):"memory");}
    asm volatile("s_waitcnt lgkmcnt(0)":::"memory");SBAR();
    #define PK(k) (bf16x8){lo[k][0],lo[k][1],lo[k][2],lo[k][3],hi[k][0],hi[k][1],hi[k][2],hi[k][3]}
    o[d0]=__builtin_amdgcn_mfma_f32_32x32x16_bf16(pa0,PK(0),o[d0],0,0,0);
    o[d0]=__builtin_amdgcn_mfma_f32_32x32x16_bf16(pa1,PK(1),o[d0],0,0,0);
    o[d0]=__builtin_amdgcn_mfma_f32_32x32x16_bf16(pa2,PK(2),o[d0],0,0,0);
    o[d0]=__builtin_amdgcn_mfma_f32_32x32x16_bf16(pa3,PK(3),o[d0],0,0,0);
    #undef PK
  }
}
__device__ __forceinline__ void prep_c(int b,int h,const float*logf,char*shm){
  const int tid=threadIdx.x,lane=tid&63,wid=tid>>6;
  float*cl=(float*)(shm+LDS_C); float*wtot=(float*)(shm+LDS_WS);
  float v[8]; float tot=0.f;
  #pragma unroll
  for(int i=0;i<8;++i){ v[i]=logf[((size_t)b*SEQ+tid*8+i)*8+h]; tot+=v[i]; }
  float incl=tot;
  #pragma unroll
  for(int o=1;o<64;o<<=1){ const float n=__shfl_up(incl,o); if(lane>=o)incl+=n; }
  if(lane==63)wtot[wid]=incl;
  __syncthreads();
  float pre=incl-tot;
  #pragma unroll
  for(int w=0;w<8;++w) if(w<wid)pre+=wtot[w];
  #pragma unroll
  for(int i=0;i<8;++i){ pre+=v[i]; cl[tid*8+i]=pre*LOG2E; }
  if(tid<64)cl[SEQ+tid]=0.f;
  __syncthreads();
}
template<int THRL> __device__ __forceinline__ void attn_unit(int b,int h,int qb,const bf16_t*Q,const bf16_t*__restrict__ K,const bf16_t*__restrict__ V,bf16_t*O,float*psa,char*shm){
  int tid=threadIdx.x; asm volatile("":"+v"(tid)); const int lane=tid&63,r32=lane&31,hi=lane>>5; const int wid=__builtin_amdgcn_readfirstlane(tid>>6);
  const long rowbase=(long)b*SEQ; const int q0=qb*QB;
  const bf16_t*Qw=Q+(rowbase+q0+wid*QBLK)*DM+h*DH;
  const bf16_t*Kh=K+rowbase*DM+h*DH,*Vh=V+rowbase*DM+h*DH;
  const unsigned lds0=(unsigned)(uintptr_t)shm;
  float*wsf=(float*)(shm+LDS_WS)+wid*64;
  const bf16_t*ksrc=Kh+(long)lane*DM+wid*8;
  const bf16_t*vsrc=Vh+(long)(16*(wid&3)+(lane>>2))*DM+(wid>>2)*32+(lane&3)*8;
  const unsigned kdst=lds0+LDS_K+wid*1024, vdst=lds0+LDS_V+wid*1024;
  #define DMA_K(t,slot) glds16(ksrc+(long)(t)*KVBLK*DM,(unsigned)__builtin_amdgcn_readfirstlane(kdst+(slot)))
  #define DMA_V(t,slot) glds16(vsrc+(long)(t)*KVBLK*DM,(unsigned)__builtin_amdgcn_readfirstlane(vdst+(slot)))
  const int vb0=(int)(lds0+LDS_V)+((lane>>4)&1)*32+(lane&3)*8+(4*hi+((lane&15)>>2))*64;
  const char*Kbase=shm+LDS_K; bf16x8 kf[8];
  const lds_cptr shm3=(lds_cptr)shm; const lds_cptr kp0=shm3+LDS_K+hi*1024+r32*16; const lds_cptr vp0=shm3+LDS_V+((lane>>4)&1)*32+(lane&3)*8+(4*hi+((lane&15)>>2))*64;
  const lds_fptr clh=(lds_fptr)(shm3+LDS_C)+4*hi;
  const int NT=(q0+QB)/KVBLK;
  DMA_K(0,0);DMA_V(0,0);DMA_K(1,SLOTB);
  bf16x8 qr[4];
  #pragma unroll
  for(int d0=0;d0<4;++d0)qr[d0]=*reinterpret_cast<const bf16x8*>(&Qw[(long)r32*DM+d0*16+hi*8]);
  float mhat=0.f,l_reg=0.f;f32x16 o[2];o[0]=f32x16{};o[1]=f32x16{};
  const int qrel=wid*QBLK+r32;
  const float cq2=((lds_fptr)(shm3+LDS_C))[q0+qrel];
  #define CMASK(P0,P1,t) do{int jb_=(t)-(NT-4); if(jb_>=0)cmask(P0,P1,jb_,qrel,hi);}while(0)
  #define CINIT(P0,P1,tt,basev_) do{ _Pragma("unroll") for(int g_=0;g_<4;++g_){ const f32x4 a_=*(const __attribute__((address_space(3))) f32x4*)(clh+64*(tt)+8*g_); const f32x4 b_=*(const __attribute__((address_space(3))) f32x4*)(clh+64*(tt)+32+8*g_); \
      _Pragma("unroll") for(int j_=0;j_<4;++j_){ P0[4*g_+j_]=(basev_)-a_[j_]; P1[4*g_+j_]=(basev_)-b_[j_]; } } }while(0)
  bool resc=false;
  #define START(P0,P1) do{ const float rm=rowmax(P0,P1); resc=false; \
    { const float dl=rm; mhat=fadd_s(mhat,dl); \
      _Pragma("unroll") for(int r=0;r<16;++r){P0[r]=fsub_s(P0[r],dl);P1[r]=fsub_s(P1[r],dl);} } \
    _Pragma("unroll") for(int r=0;r<16;++r)P0[r]=__builtin_amdgcn_exp2f(P0[r]); }while(0)
  #define RESC() do{ if(resc){ asm volatile("s_waitcnt lgkmcnt(0)":::"memory"); \
      _Pragma("unroll") for(int d_=0;d_<2;++d_) _Pragma("unroll") for(int r=0;r<16;++r)o[d_][r]*=wsf[crow(r,hi)]; } }while(0)
  f32x16 pA0,pA1,pB0,pB1;
  int sl_prev=0,sl_cur=0,sl_next=SLOTB;
  #define ROT() do{sl_prev=sl_cur;sl_cur=sl_next;sl_next=(sl_next==(NSLOT-1)*SLOTB)?0:sl_next+SLOTB;}while(0)
  DMA_K(2,2*SLOTB);
  CINIT(pA0,pA1,0,cq2);
  WAIT_BAR(3);
  qkt(pA0,pA1,Kbase,qr,r32,hi);asm volatile("s_nop 15\n\ts_nop 7":"+v"(pA0),"+v"(pA1));CMASK(pA0,pA1,0);
  START(pA0,pA1);
  _Pragma("unroll") for(int r=0;r<16;++r)pA1[r]=__builtin_amdgcn_exp2f(pA1[r]);
  { const float bv0=cq2-mhat; CINIT(pB0,pB1,1,bv0); }
  WAIT_BAR(0);
  DMA_K(3,0);DMA_V(1,SLOTB);
  ROT();
  kload8(kf,kp0+sl_cur);
  WAIT_BAR(2);
  s16x4 vlo[8],vhi[8]; u32x4 pw0,pw1,pw2,pw3;
  #define PKW(P,B) cvtpk_s(P[B],P[B+1])
  #define PAF(k) __builtin_bit_cast(bf16x8,pw##k)
  #define VFR(i) (bf16x8){vlo[i][0],vlo[i][1],vlo[i][2],vlo[i][3],vhi[i][0],vhi[i][1],vhi[i][2],vhi[i][3]}
  #define PIN(x) asm volatile("":"+v"(x))
  #define MX3(a,b,c) __builtin_fmaxf(__builtin_fmaxf((a),(b)),(c))
  #define GAPA(MF,A0,A1,A2,A3,W0,W1,PW) do{ MF; sacc+=A0; sacc+=A1; sacc+=A2; sacc+=A3; PIN(sacc); W0; W1; PIN(PW); SBAR(); }while(0)
  #define EX(v) __builtin_amdgcn_exp2f(v)
  #define CKRD(i) (*(const __attribute__((address_space(3))) f32x4*)(clt_+(((i)>>2)*32+((i)&3)*8)))
  #define GAPB(MF,X,B,PN,G,CKU,CKN,INXT) do{ MF; X[B]=EX(X[B]); X[B+1]=EX(X[B+1]); X[B+2]=EX(X[B+2]); X[B+3]=EX(X[B+3]); PIN(X); \
      PN[4*(G)]=basev-CKU[0]; PN[4*(G)+1]=basev-CKU[1]; PN[4*(G)+2]=basev-CKU[2]; PN[4*(G)+3]=basev-CKU[3]; PIN(PN); CKN=CKRD(INXT); SBAR(); }while(0)
  #define VRD(i) do{ vlo[i]=vtr(vp_+(((i)>>2)*4096+((i)&3)*1024)); vhi[i]=vtr(vp_+(((i)>>2)*4096+((i)&3)*1024+512)); }while(0)
  #define KRD(G,j) do{ if(G){ kload2(kf,kp0+sl_next,j); SBAR(); } }while(0)
  #define STEP(C0,C1,P0,P1,t,GK,GV,GL) do{ SBAR(); \
    const lds_cptr vp_=vp0+sl_prev; const lds_fptr clt_=clh+64*((t)+1); \
    VRD(0); SBAR(); float sacc=(P0[0]+P0[1]); \
    GAPA(C0=__builtin_amdgcn_mfma_f32_32x32x16_bf16(kf[0],qr[0],C0,0,0,0), P0[2],P0[3],P0[4],P0[5],     pw0[0]=PKW(P0,0), pw0[1]=PKW(P0,2), pw0); \
    VRD(4); SBAR(); GAPA(C1=__builtin_amdgcn_mfma_f32_32x32x16_bf16(kf[1],qr[0],C1,0,0,0), P0[6],P0[7],P0[8],P0[9],     pw0[2]=PKW(P0,4), pw0[3]=PKW(P0,6), pw0); \
    VRD(1); SBAR(); GAPA(C0=__builtin_amdgcn_mfma_f32_32x32x16_bf16(kf[2],qr[1],C0,0,0,0),   P0[10],P0[11],P0[12],P0[13], pw1[0]=PKW(P0,8), pw1[1]=PKW(P0,10), pw1); \
    VRD(5); SBAR(); GAPA(C1=__builtin_amdgcn_mfma_f32_32x32x16_bf16(kf[3],qr[1],C1,0,0,0),   P0[14],P0[15],P1[0],P1[1],   pw1[2]=PKW(P0,12),pw1[3]=PKW(P0,14), pw1); \
    VRD(2); SBAR(); GAPA(C0=__builtin_amdgcn_mfma_f32_32x32x16_bf16(kf[4],qr[2],C0,0,0,0),   P1[2],P1[3],P1[4],P1[5],     pw2[0]=PKW(P1,0), pw2[1]=PKW(P1,2), pw2); \
    VRD(6); SBAR(); GAPA(C1=__builtin_amdgcn_mfma_f32_32x32x16_bf16(kf[5],qr[2],C1,0,0,0),   P1[6],P1[7],P1[8],P1[9],     pw2[2]=PKW(P1,4), pw2[3]=PKW(P1,6), pw2); \
    VRD(3); SBAR(); GAPA(C0=__builtin_amdgcn_mfma_f32_32x32x16_bf16(kf[6],qr[3],C0,0,0,0),   P1[10],P1[11],P1[12],P1[13], pw3[0]=PKW(P1,8), pw3[1]=PKW(P1,10), pw3); \
    VRD(7); SBAR(); GAPA(C1=__builtin_amdgcn_mfma_f32_32x32x16_bf16(kf[7],qr[3],C1,0,0,0),   P1[14],P1[15],0.f,0.f,       pw3[2]=PKW(P1,12),pw3[3]=PKW(P1,14), pw3); \
    l_reg+=sacc; \
    if(GK){DMA_K((t)+3,sl_cur);} if(GV){DMA_V((t)+1,sl_next);} \
    CMASK(C0,C1,t); \
    { float a=MX3(C0[0],C0[1],C1[0]),b=MX3(C0[2],C0[3],C1[1]); a=MX3(a,C1[2],C1[3]); \
      _Pragma("unroll") for(int r=4;r<16;r+=4){a=MX3(a,C0[r],C0[r+1]);b=MX3(b,C0[r+2],C0[r+3]);a=MX3(a,C1[r],C1[r+1]);b=MX3(b,C1[r+2],C1[r+3]);} \
      float rm=__builtin_fmaxf(a,b); { auto rr=__builtin_amdgcn_permlane32_swap(__float_as_uint(rm),__float_as_uint(rm),false,false); rm=__builtin_fmaxf(__uint_as_float(rr[0]),__uint_as_float(rr[1])); } \
      resc=false; \
      if(__builtin_expect(__any(rm>(float)THRL),0)){ const float dl=__builtin_fmaxf(rm,0.f); mhat+=dl; \
        _Pragma("unroll") for(int r=0;r<16;++r){C0[r]-=dl;C1[r]-=dl;} \
        const float f=__builtin_amdgcn_exp2f(-dl); l_reg*=f; if(hi==0)wsf[r32]=f; resc=true; } } \
    const float basev=cq2-mhat; f32x4 ckA_=CKRD(0),ckB_; \
    SBAR(); \
    GAPB(o[0]=__builtin_amdgcn_mfma_f32_32x32x16_bf16(PAF(0),VFR(0),o[0],0,0,0), C0,0,  P0,0,ckA_,ckB_,1); \
    GAPB(o[1]=__builtin_amdgcn_mfma_f32_32x32x16_bf16(PAF(0),VFR(4),o[1],0,0,0), C0,4,  P0,1,ckB_,ckA_,2); \
    KRD(GL,0); GAPB(o[0]=__builtin_amdgcn_mfma_f32_32x32x16_bf16(PAF(1),VFR(1),o[0],0,0,0), C0,8,  P0,2,ckA_,ckB_,3); \
    KRD(GL,1); GAPB(o[1]=__builtin_amdgcn_mfma_f32_32x32x16_bf16(PAF(1),VFR(5),o[1],0,0,0), C0,12, P0,3,ckB_,ckA_,4); \
    KRD(GL,2); GAPB(o[0]=__builtin_amdgcn_mfma_f32_32x32x16_bf16(PAF(2),VFR(2),o[0],0,0,0), C1,0,  P1,0,ckA_,ckB_,5); \
    KRD(GL,3); GAPB(o[1]=__builtin_amdgcn_mfma_f32_32x32x16_bf16(PAF(2),VFR(6),o[1],0,0,0), C1,4,  P1,1,ckB_,ckA_,6); \
    GAPB(o[0]=__builtin_amdgcn_mfma_f32_32x32x16_bf16(PAF(3),VFR(3),o[0],0,0,0), C1,8,  P1,2,ckA_,ckB_,7); \
    GAPB(o[1]=__builtin_amdgcn_mfma_f32_32x32x16_bf16(PAF(3),VFR(7),o[1],0,0,0), C1,12, P1,3,ckB_,ckA_,7); \
    }while(0)
  int t=1;
  #undef CMASK
  #define CMASK(P0,P1,t) do{}while(0)
  for(;t+5<NT;t+=2){
    STEP(pB0,pB1,pA0,pA1,t,true,true,true);     WAIT_BAR(2); RESC(); ROT();
    STEP(pA0,pA1,pB0,pB1,t+1,true,true,true);   WAIT_BAR(2); RESC(); ROT();
  }
  #undef CMASK
  #define CMASK(P0,P1,t) do{int jb_=(t)-(NT-4); if(jb_>=0)cmask(P0,P1,jb_,qrel,hi);}while(0)
  #define ENDW(tt) do{ if((tt)+3<NT){WAIT_BAR(2);} else if((tt)+2<NT){WAIT_BAR(1);} else {WAIT_BAR(0);} }while(0)
  for(;t+1<NT;t+=2){
    STEP(pB0,pB1,pA0,pA1,t,(t+3<NT),(t+1<NT),(t+1<NT));       ENDW(t);   RESC(); ROT();
    STEP(pA0,pA1,pB0,pB1,t+1,(t+4<NT),(t+2<NT),(t+2<NT));     ENDW(t+1); RESC(); ROT();
  }
  STEP(pB0,pB1,pA0,pA1,NT-1,false,false,false); RESC();
  { float sacc=pB0[0]+pB0[1]; _Pragma("unroll") for(int r=2;r<16;++r)sacc+=pB0[r]; _Pragma("unroll") for(int r=0;r<16;++r)sacc+=pB1[r]; l_reg+=sacc;
    pw0=(u32x4){PKW(pB0,0),PKW(pB0,2),PKW(pB0,4),PKW(pB0,6)};pw1=(u32x4){PKW(pB0,8),PKW(pB0,10),PKW(pB0,12),PKW(pB0,14)};pw2=(u32x4){PKW(pB1,0),PKW(pB1,2),PKW(pB1,4),PKW(pB1,6)};pw3=(u32x4){PKW(pB1,8),PKW(pB1,10),PKW(pB1,12),PKW(pB1,14)};
    SBAR(); pv(o,vb0+sl_cur,PAF(0),PAF(1),PAF(2),PAF(3)); }
  #undef PKW
  #undef PAF
  #undef VFR
  #undef PIN
  #undef MX3
  #undef GAPA
  #undef GAPB
  #undef CKRD
  #undef EX
  #undef VRD
  #undef KRD
  #undef STEP
  #undef ENDW
  {auto rr=__builtin_amdgcn_permlane32_swap(__float_as_uint(l_reg),__float_as_uint(l_reg),false,false);l_reg=__uint_as_float(rr[0])+__uint_as_float(rr[1]);}
  if(hi==0)wsf[32+r32]=l_reg;asm volatile("s_waitcnt lgkmcnt(0)":::"memory");
  float rli[16];
  #pragma unroll
  for(int r=0;r<16;++r)rli[r]=__builtin_amdgcn_rcpf(wsf[32+crow(r,hi)]);
  bf16_t*Ow=O+(rowbase+q0+wid*QBLK)*OPITCH+h*DH;
  { bf16_t*stg=(bf16_t*)(shm+LDS_OST)+wid*2048;
    #pragma unroll
    for(int r=0;r<16;++r){const int orow=crow(r,hi);
      #pragma unroll
      for(int d0=0;d0<2;++d0)stg[orow*64+d0*32+r32]=f2bf(o[d0][r]*rli[r]);}
    asm volatile("s_waitcnt lgkmcnt(0)":::"memory");
    #pragma unroll
    for(int i=0;i<4;++i){const int row=i*8+(lane>>3),ch=lane&7; const u32x4 v=*(const u32x4*)(stg+row*64+ch*8); *(u32x4*)(Ow+(long)row*OPITCH+ch*8)=v;
      float ss=0.f;
      #pragma unroll
      for(int j=0;j<4;++j){ const float lo_=__builtin_bit_cast(float,v[j]<<16), hi_=__builtin_bit_cast(float,v[j]&0xffff0000u); ss+=lo_*lo_+hi_*hi_; }
      ss+=__shfl_xor(ss,1); ss+=__shfl_xor(ss,2); ss+=__shfl_xor(ss,4);
      if(ch==0)psa[(rowbase+q0+wid*QBLK+row)*8+h]=ss; } }
  asm volatile("s_waitcnt lgkmcnt(0)\n\ts_barrier":::"memory");
  #undef DMA_K
  #undef DMA_V
  #undef CMASK
  #undef CINIT
  #undef START
  #undef RESC
  #undef ROT
}
#undef SBAR
#undef WAIT_BAR
}

__device__ void s5_precompute(int g, const float* lam_re, const float* lam_im, const float* log_dt, const float* b_re, const float* b_im, const float* c_re, const float* c_im,
                              bf16_t* bth, bf16_t* bttg, float* a16, float* sm) {
    float* apr = sm; float* api = apr + 17 * 64; float* bbr = api + 17 * 64; float* bbi = bbr + 1024; float* cr = bbi + 1024; float* ci = cr + 1024; float* Kt = ci + 1024;
    const int tid = threadIdx.x;
    if (tid < 64) { const int p = tid; const float dt = __expf(log_dt[g]); const float lr = lam_re[g * NP + p], li = lam_im[g * NP + p];
        for (int tau = 0; tau <= 16; ++tau) { const float mag = __expf(lr * dt * (float)tau), ang = li * dt * (float)tau; apr[tau * 64 + p] = mag * cosf(ang); api[tau * 64 + p] = mag * sinf(ang); }
        const float abr = apr[64 + p], abi = api[64 + p], den = lr * lr + li * li, nr = abr - 1.f; const float zr = (nr * lr + abi * li) / den, zi = (abi * lr - nr * li) / den;
        for (int c = 0; c < NC; ++c) { const float br = b_re[(size_t)(g * NP + p) * NC + c], bi = b_im[(size_t)(g * NP + p) * NC + c]; bbr[p * 16 + c] = zr * br - zi * bi; bbi[p * 16 + c] = zr * bi + zi * br; }
        a16[(g * 64 + p) * 2] = apr[16 * 64 + p]; a16[(g * 64 + p) * 2 + 1] = api[16 * 64 + p]; }
    for (int i = tid; i < 1024; i += NTHR) { cr[i] = c_re[(size_t)g * 1024 + i]; ci[i] = c_im[(size_t)g * 1024 + i]; }
    __syncthreads();
    for (int idx = tid; idx < 4096; idx += NTHR) { const int tau = idx >> 8, co = (idx >> 4) & 15, cin = idx & 15; float sacc = 0.f;
        for (int p = 0; p < 64; ++p) { const float c_r = cr[co * 64 + p], c_i = ci[co * 64 + p], a_r = apr[tau * 64 + p], a_i = api[tau * 64 + p]; const float wr_ = c_r * a_r - c_i * a_i, wi_ = c_r * a_i + c_i * a_r;
            sacc += wr_ * bbr[p * 16 + cin] - wi_ * bbi[p * 16 + cin]; }
        Kt[idx] = sacc; }
    __syncthreads();
    bf16_t* tg = bttg + (size_t)g * 256 * UXP; bf16_t* hh = bth + (size_t)g * 256 * 256;
    for (int idx = tid; idx < 256 * UXP; idx += NTHR) { const int n = idx / UXP, k = idx - n * UXP, i = n >> 4, co = n & 15; float v;
        if (k < 256) { const int j = k >> 4, cin = k & 15; v = (j <= i) ? Kt[((i - j) << 8) + (co << 4) + cin] : 0.f; }
        else if (k < 320) { const int p = k - 256; v = cr[co * 64 + p] * apr[(i + 1) * 64 + p] - ci[co * 64 + p] * api[(i + 1) * 64 + p]; }
        else { const int p = k - 320; v = -(cr[co * 64 + p] * api[(i + 1) * 64 + p] + ci[co * 64 + p] * apr[(i + 1) * 64 + p]); }
        tg[idx] = f2bf(v); }
    for (int idx = tid; idx < 256 * 256; idx += NTHR) { const int n = idx >> 8, k = idx & 255, j = k >> 4, cin = k & 15; float v = 0.f;
        if (n < 64) v = apr[(15 - j) * 64 + n] * bbr[n * 16 + cin] - api[(15 - j) * 64 + n] * bbi[n * 16 + cin];
        else if (n < 128) { const int p = n - 64; v = apr[(15 - j) * 64 + p] * bbi[p * 16 + cin] + api[(15 - j) * 64 + p] * bbr[p * 16 + cin]; }
        hh[idx] = f2bf(v); }
    __syncthreads();
}

struct Params {
    const float* in[29];
    float* out;
    unsigned char* ws;
};

__device__ __forceinline__ float wave_sum(float v) {
#pragma unroll
    for (int o = 1; o < 64; o <<= 1) v += __shfl_xor(v, o);
    return v;
}
__device__ __forceinline__ float wave_max(float v) {
#pragma unroll
    for (int o = 1; o < 64; o <<= 1) v = fmaxf(v, __shfl_xor(v, o));
    return v;
}

template <class AT> __device__ void rms_rows(const AT* in, int ldi, const float* g, float* out, int ldo, int ncols, int nrows, int gw, int ngw, int lane) {
    for (int r = gw; r < nrows; r += ngw) {
        const AT* row = in + (size_t)r * ldi; float ss = 0.f;
        for (int c = lane; c < ncols; c += 64) { const float v = ldf(row, c); ss += v * v; }
        ss = wave_sum(ss);
        const float rs = rsqrtf(ss / (float)ncols + EPS);
        float* orow = out + (size_t)r * ldo;
        for (int c = lane; c < ncols; c += 64) orow[c] = ldf(row, c) * rs * g[c];
    }
}

template <class AT, bool DUAL, class RowFn, class Epi>
__device__ void gemm_tile(const AT* A, int lda, RowFn arow, const float* B, int ldb, int K, int m0, int n0, int n1, int Nmax, float* sm, Epi epi) {
    float* As = sm;
    float* Bs = sm + 16 * 132;
    float* Bs2 = Bs + 16 * 128;
    const int tid = threadIdx.x, ty = tid >> 4, tx = tid & 15;
    float acc[4][8], acc2[4][8];
#pragma unroll
    for (int i = 0; i < 4; ++i)
#pragma unroll
        for (int j = 0; j < 8; ++j) { acc[i][j] = 0.f; acc2[i][j] = 0.f; }
    const int ar = tid >> 2, ak = (tid & 3) * 4;
    const int srow = arow(m0 + ar);
    const int bk = tid >> 5, bn = (tid & 31) * 4;
    for (int k0 = 0; k0 < K; k0 += 16) {
        float a4[4];
#pragma unroll
        for (int j = 0; j < 4; ++j) a4[j] = (srow >= 0) ? ldf(A, (size_t)srow * lda + k0 + ak + j) : 0.f;
        float b4[4], c4[4];
#pragma unroll
        for (int j = 0; j < 4; ++j) { const int col = n0 + bn + j; b4[j] = (col < Nmax) ? B[(size_t)(k0 + bk) * ldb + col] : 0.f; }
        if (DUAL) {
#pragma unroll
            for (int j = 0; j < 4; ++j) c4[j] = B[(size_t)(k0 + bk) * ldb + n1 + bn + j];
        }
        __syncthreads();
#pragma unroll
        for (int j = 0; j < 4; ++j) As[(ak + j) * 132 + ar] = a4[j];
#pragma unroll
        for (int j = 0; j < 4; ++j) Bs[bk * 128 + bn + j] = b4[j];
        if (DUAL) {
#pragma unroll
            for (int j = 0; j < 4; ++j) Bs2[bk * 128 + bn + j] = c4[j];
        }
        __syncthreads();
#pragma unroll 2
        for (int kk = 0; kk < 16; ++kk) {
            float a[4], b[8];
#pragma unroll
            for (int i = 0; i < 4; ++i) a[i] = As[kk * 132 + ty * 4 + i];
#pragma unroll
            for (int j = 0; j < 8; ++j) b[j] = Bs[kk * 128 + tx * 8 + j];
#pragma unroll
            for (int i = 0; i < 4; ++i)
#pragma unroll
                for (int j = 0; j < 8; ++j) acc[i][j] += a[i] * b[j];
            if (DUAL) {
#pragma unroll
                for (int j = 0; j < 8; ++j) b[j] = Bs2[kk * 128 + tx * 8 + j];
#pragma unroll
                for (int i = 0; i < 4; ++i)
#pragma unroll
                    for (int j = 0; j < 8; ++j) acc2[i][j] += a[i] * b[j];
            }
        }
    }
    __syncthreads();
#pragma unroll
    for (int i = 0; i < 4; ++i)
#pragma unroll
        for (int j = 0; j < 8; ++j) epi(m0 + ty * 4 + i, tx * 8 + j, acc[i][j], acc2[i][j]);
}

struct RowId { __device__ int operator()(int r) const { return r; } };
struct RowTok { const int* rowtok; __device__ int operator()(int r) const { const int id = rowtok[r]; return id < 0 ? -1 : (id >> 2); } };
struct RowSlot { const int* rowtok; __device__ int operator()(int r) const { return rowtok[r] < 0 ? -1 : r; } };

__device__ __forceinline__ float sigmoidf_(float x) { return 1.f / (1.f + __expf(-x)); }

__global__ void __launch_bounds__(NTHR) fwd_naive(Params P) {
    cg::grid_group grid = cg::this_grid();
    extern __shared__ __attribute__((aligned(16))) unsigned char lds[];
    float* sm = (float*)lds;
    int* ism = (int*)(lds + 57600);
    PG8_LAS unsigned char* ldsl = (PG8_LAS unsigned char*)lds;
    int tid = threadIdx.x, lane = tid & 63, wave = tid >> 6;
    const int nblk = gridDim.x, blk = blockIdx.x;
    int gw = blk * NWAVE + wave; const int ngw = nblk * NWAVE;
#define REFRESH_IDS() do { tid = threadIdx.x; asm volatile("" : "+v"(tid)); lane = tid & 63; wave = tid >> 6; gw = blk * NWAVE + wave; } while (0)
    unsigned char* ws = P.ws;
    int* ctl = (int*)(ws + WS_CTL);
    float* logf_ = (float*)(ws + WS_LOGF);
    float* x1 = (float*)(ws + WS_X1);
    int* topi = (int*)(ws + WS_TOPI); float* topg = (float*)(ws + WS_TOPG);
    int* rowtok = (int*)(ws + WS_ROWTOK); float* rowgate = (float*)(ws + WS_ROWGATE);
    bf16_t* act = (bf16_t*)(ws + WS_ACT); bf16_t* Y = (bf16_t*)(ws + WS_Y);
    float* Gs = (float*)(ws + WS_GS);
    bf16_t* Win_t = (bf16_t*)(ws + WS_WIN); bf16_t* XN = (bf16_t*)(ws + WS_XN); bf16_t* QB = (bf16_t*)(ws + WS_Q);
    bf16_t* KB = QB + (size_t)T * 512; bf16_t* VB = KB + (size_t)T * 512; bf16_t* UX = (bf16_t*)(ws + WS_UX);
    bf16_t* S5H = (bf16_t*)(ws + WS_S5H); bf16_t* S5TG = (bf16_t*)(ws + WS_S5TG); float* A16 = (float*)(ws + WS_A16);
    bf16_t* Wgu_t = (bf16_t*)(ws + WS_WGU); bf16_t* Wdn_t = (bf16_t*)(ws + WS_WDN); bf16_t* X1B = (bf16_t*)(ws + WS_X1B);
    bf16_t* MIXB = (bf16_t*)(ws + WS_MIXB); float* psa = (float*)(ws + WS_PSA); float* pss = (float*)(ws + WS_PSS);
    bf16_t* GB = (bf16_t*)(ws + WS_GB); bf16_t* Wglu_t = (bf16_t*)(ws + WS_WGLU); bf16_t* Wout_t = (bf16_t*)(ws + WS_WOUT); bf16_t* Wpg_t = (bf16_t*)(ws + WS_WPG); bf16_t* Wpp_t = (bf16_t*)(ws + WS_WPP);
    bf16_t* PB = (bf16_t*)(ws + WS_PB); bf16_t* XN2 = (bf16_t*)(ws + WS_XN2); bf16_t* GSB = (bf16_t*)(ws + WS_GS);
    int* rowsrc = (int*)(ws + WS_ROWSRC); float* rowscl = (float*)(ws + WS_ROWSCL); float* r1 = (float*)(ws + WS_R1);
    const float* x = P.in[0]; const float* pin = P.in[1]; const float* norm_mix_g = P.in[2]; const float* w_in = P.in[3]; const float* b_f = P.in[4];
    const float* lam_re = P.in[5]; const float* lam_im = P.in[6]; const float* log_dt = P.in[7]; const float* b_re = P.in[8]; const float* b_im = P.in[9];
    const float* c_re = P.in[10]; const float* c_im = P.in[11]; const float* d_skip = P.in[12]; const float* w_glu = P.in[13]; const float* b_glu = P.in[14];
    const float* attn_out_g = P.in[15]; const float* ssm_out_g = P.in[16]; const float* w_out = P.in[17]; const float* norm_ffn_g = P.in[18];
    const float* w_router = P.in[19]; const float* b_router = P.in[20]; const float* w_gu = P.in[21]; const float* b_gu = P.in[22];
    const float* w_dn = P.in[23]; const float* b_dn = P.in[24]; const float* norm_ple_g = P.in[25]; const float* w_ple_gate = P.in[26];
    const float* w_ple_proj = P.in[27]; const float* norm_final_g = P.in[28];

    if (blk == 0 && tid < 128) ctl[tid] = 0;
    if (blk < NG) s5_precompute(blk, lam_re, lam_im, log_dt, b_re, b_im, c_re, c_im, S5H, S5TG, A16, sm);
    {
        PG8_LAS float* scr = (PG8_LAS float*)(ldsl + wave * 16384);
        constexpr int I_IN = 16 * 64, I_GU = NE * 16 * 64, I_DN = NE * 16 * 32, I_GLU = 8 * 16, I_OUT = 16 * 32, I_PG = 16 * 32, I_PP = 4 * 32;
        for (int it = gw; it < I_IN + I_GLU + I_OUT + I_PG + I_PP + I_GU + I_DN; it += ngw) {
            int r = it;
            if (r < I_GLU) { const int kb = r >> 4, nb = r & 15; transpose_item(w_glu, SW, kb * 64, nb * 32, nullptr, Wglu_t, SW, nb * 32, scr, lane); continue; }
            r -= I_GLU;
            if (r < I_OUT) { const int kb = r >> 5, nb = r & 31; transpose_item(w_out, D, kb * 64, nb * 32, kb < 8 ? attn_out_g : ssm_out_g - AW, Wout_t, D, nb * 32, scr, lane); continue; }
            r -= I_OUT;
            if (r < I_PG) { const int kb = r >> 5, nb = r & 31; transpose_item(w_ple_gate, D, kb * 64, nb * 32, norm_ple_g, Wpg_t, D, nb * 32, scr, lane); continue; }
            r -= I_PG;
            if (r < I_PP) { const int kb = r >> 5, nb = r & 31; transpose_item(w_ple_proj, D, kb * 64, nb * 32, nullptr, Wpp_t, PLE, nb * 32, scr, lane); continue; }
            r -= I_PP;
            if (r < I_IN) { const int kb = r >> 6, nb = r & 63, n0 = nb * 32; const int c0 = (n0 < 1536) ? n0 : n0 + 8;
                transpose_item(w_in, INW, kb * 64, c0, norm_mix_g, Win_t, D, n0, scr, lane); continue; }
            r -= I_IN;
            if (r < I_GU) {
                const int e = r >> 10, kb = (r >> 6) & 15, nb = r & 63; const int n0 = nb * 32, pn = n0 >> 8, j0 = n0 & 255;
                const int c0 = (j0 < 128) ? pn * 128 + j0 : DFF + pn * 128 + (j0 - 128);
                transpose_item(w_gu + (size_t)e * D * 2 * DFF, 2 * DFF, kb * 64, c0, norm_ffn_g, Wgu_t + (size_t)e * 2 * DFF * D, D, n0, scr, lane); continue; }
            r -= I_GU;
            { const int e = r >> 9, kb = (r >> 5) & 15, nb = r & 31;
              transpose_item(w_dn + (size_t)e * DFF * D, D, kb * 64, nb * 32, nullptr, Wdn_t + (size_t)e * D * DFF, DFF, nb * 32, scr, lane); }
        }
    }
    for (size_t i = (size_t)(blk * NTHR + tid) * 8; i < (size_t)T * PLE; i += (size_t)nblk * NTHR * 8) {
        const float4 a = *(const float4*)(pin + i), b4 = *(const float4*)(pin + i + 4);
        *(uint4*)(PB + i) = make_uint4(pk2(a.x, a.y), pk2(a.z, a.w), pk2(b4.x, b4.y), pk2(b4.z, b4.w)); }
    {
        float wf[4][4][8];
#pragma unroll
        for (int j = 0; j < 4; ++j)
#pragma unroll
            for (int i = 0; i < 4; ++i) { const int k = 256 * j + 4 * lane + i; const float gk = norm_mix_g[k]; const float4 a = *(const float4*)(w_in + (size_t)k * INW + COL_F), b4 = *(const float4*)(w_in + (size_t)k * INW + COL_F + 4);
                wf[j][i][0] = a.x * gk; wf[j][i][1] = a.y * gk; wf[j][i][2] = a.z * gk; wf[j][i][3] = a.w * gk; wf[j][i][4] = b4.x * gk; wf[j][i][5] = b4.y * gk; wf[j][i][6] = b4.z * gk; wf[j][i][7] = b4.w * gk; }
        for (int r = gw; r < T; r += ngw) {
            const float4* xr = (const float4*)(x + (size_t)r * D) + lane; float4 v[4]; float ss = 0.f;
#pragma unroll
            for (int j = 0; j < 4; ++j) { v[j] = xr[64 * j]; ss += (v[j].x * v[j].x + v[j].y * v[j].y) + (v[j].z * v[j].z + v[j].w * v[j].w); }
            ss = wave_sum(ss); const float rs = rsqrtf(ss * (1.f / D) + EPS);
            float fl[8];
#pragma unroll
            for (int h = 0; h < 8; ++h) fl[h] = 0.f;
            uint2* o8 = (uint2*)(XN + (size_t)r * D) + lane;
#pragma unroll
            for (int j = 0; j < 4; ++j) { const float a0 = v[j].x * rs, a1 = v[j].y * rs, a2 = v[j].z * rs, a3 = v[j].w * rs;
                o8[64 * j] = make_uint2(pk2(a0, a1), pk2(a2, a3));
#pragma unroll
                for (int h = 0; h < 8; ++h) fl[h] += a0 * wf[j][0][h] + a1 * wf[j][1][h] + a2 * wf[j][2][h] + a3 * wf[j][3][h]; }
            float mine = 0.f;
#pragma unroll
            for (int h = 0; h < 8; ++h) { const float sfl = wave_sum(fl[h]); if (lane == h) mine = sfl; }
            if (lane < 8) { const float z = mine + b_f[lane]; logf_[(size_t)r * 8 + lane] = fminf(z, 0.f) - log1pf(__expf(-fabsf(z))); }
        }
    }
    __syncthreads();
    grid.sync(); REFRESH_IDS();

    {
        pg8::Order So; So.init(T / 256, 2048 / 256, nblk, blk, nullptr);
        pg8::EpiQKVU E{QB, (size_t)T * 512, UX};
        pg8::gemm_phase(ldsl, (const char*)XN, (const char*)Win_t, 0, D, So, pg8::DenseRows{D}, E);
    }
    grid.sync(); REFRESH_IDS();

    {
        const int pm = (blk % 8) * (nblk / 8) + blk / 8, g = pm >> 3;
        pg8::OneUnit So{pm, g};
        pg8::EpiS5H E1{UX, A16 + g * 128};
        pg8::gemm_phase(ldsl, (const char*)UX, (const char*)S5H, (size_t)256 * 256 * 2, 256, So, pg8::DenseRows{UXP}, E1);
        pg8::EpiS5Y E2{UX, d_skip, GB};
        pg8::gemm_phase(ldsl, (const char*)UX, (const char*)S5TG, (size_t)256 * UXP * 2, UXP, So, pg8::DenseRows{UXP}, E2);
    }
    {
        const int vcu = (blk % 8) * (nblk / 8) + blk / 8, bh = vcu >> 2, sg = vcu & 3, b = bh >> 3, h = bh & 7;
        attn_body::prep_c(b, h, logf_, (char*)lds);
        for (int i = 0; i < 4; ++i) { const int qb = (i == 0) ? sg : (i == 1) ? 7 - sg : (i == 2) ? 8 + sg : 15 - sg;
            attn_body::attn_unit<8>(b, h, qb, QB, KB, VB, MIXB, psa, (char*)lds); }
    }
    grid.sync(); REFRESH_IDS();

    {
        pg8::Order So; So.init(T / 256, SW / 256, nblk, blk, nullptr);
        pg8::EpiGlu E{GB, MIXB, b_glu, pss};
        pg8::gemm_phase(ldsl, (const char*)GB, (const char*)Wglu_t, 0, SW, So, pg8::DenseRows{SW}, E);
    }
    grid.sync(); REFRESH_IDS();

    {
        pg8::Order So; So.init(T / 256, D / 256, nblk, blk, nullptr);
        pg8::EpiOut E{x, x1, X1B, psa, pss};
        pg8::gemm_phase(ldsl, (const char*)MIXB, (const char*)Wout_t, 0, D, So, pg8::DenseRows{D}, E);
    }
    grid.sync(); REFRESH_IDS();

    for (int i = blk * NTHR + tid; i < CAP; i += nblk * NTHR) { rowtok[i] = -1; rowgate[i] = 0.f; rowsrc[i] = 0; rowscl[i] = 0.f; }
    {
        float* wbuf = sm + 16 * 132 + 2 * 16 * 128 + wave * 1024;
        for (int r = gw; r < T; r += ngw) {
            const float* row = x1 + (size_t)r * D; float ss = 0.f;
            for (int c = lane; c < D; c += 64) { const float v = row[c]; ss += v * v; }
            ss = wave_sum(ss); const float rs = rsqrtf(ss / (float)D + EPS);
            for (int c = lane; c < D; c += 64) wbuf[c] = row[c] * rs * norm_ffn_g[c];
            if (lane == 0) r1[r] = rs;
            const int e = lane & 31, kh = lane >> 5; float part = 0.f;
            for (int k = kh * 512; k < kh * 512 + 512; ++k) part += wbuf[k] * w_router[(size_t)k * NE + e];
            part += __shfl_xor(part, 32);
            float lg = (lane < 32) ? part + b_router[e] : -INFINITY;
            float tv[TOPK]; int ti[TOPK];
#pragma unroll
            for (int k = 0; k < TOPK; ++k) { const float mx = wave_max(lg); const unsigned long long bm = __ballot(lg == mx); const int idx = __ffsll((long long)bm) - 1; tv[k] = mx; ti[k] = idx; if (lane == idx) lg = -INFINITY; }
            float es[TOPK], den = 0.f;
#pragma unroll
            for (int k = 0; k < TOPK; ++k) { es[k] = __expf(tv[k] - tv[0]); den += es[k]; }
            if (lane < TOPK) {
                float gsel = es[0]; int isel = ti[0];
#pragma unroll
                for (int k = 1; k < TOPK; ++k) if (lane == k) { gsel = es[k]; isel = ti[k]; }
                topi[(size_t)r * TOPK + lane] = isel; topg[(size_t)r * TOPK + lane] = gsel / den;
                atomicAdd(&ctl[CT_COUNT + isel], 1);
            }
        }
    }
    grid.sync(); REFRESH_IDS();

    if (tid == 0) {
        int run = 0;
        for (int e = 0; e < NE; ++e) { ism[e] = run; const int cnt = ctl[CT_COUNT + e]; run += (cnt + MB - 1) / MB * MB; }
        ism[NE] = run;
        if (blk == 0) {
            for (int e = 0; e <= NE; ++e) ctl[CT_PADSTART + e] = ism[e];
            ctl[CT_NTILES] = run / MB;
            for (int e = 0; e < NE; ++e) for (int tt = ism[e] / MB; tt < ism[e + 1] / MB; ++tt) ctl[CT_TILEEXP + tt] = e;
        }
    }
    __syncthreads();
    for (int i = blk * NTHR + tid; i < T * TOPK; i += nblk * NTHR) {
        const int e = topi[i]; const int pos = atomicAdd(&ctl[CT_CURSOR + e], 1); const int slot = ism[e] + pos;
        rowtok[slot] = i; rowgate[slot] = topg[i]; rowsrc[slot] = i >> 2; rowscl[slot] = r1[i >> 2];
    }
    grid.sync(); REFRESH_IDS();

    {
        pg8::Order So; So.init(ctl[CT_NTILES], 2 * DFF / 256, nblk, blk, ctl + CT_TILEEXP);
        pg8::EpiSwiglu E{act, b_gu, rowscl};
        pg8::gemm_phase(ldsl, (const char*)X1B, (const char*)Wgu_t, (size_t)2 * DFF * D * 2, D, So, pg8::GatherRows{rowsrc, D}, E);
    }
    grid.sync(); REFRESH_IDS();

    {
        pg8::Order So; So.init(ctl[CT_NTILES], D / 256, nblk, blk, ctl + CT_TILEEXP);
        pg8::EpiScatter E{Y, b_dn, rowtok, rowgate};
        pg8::gemm_phase(ldsl, (const char*)act, (const char*)Wdn_t, (size_t)D * DFF * 2, DFF, So, pg8::DenseRows{DFF}, E);
    }
    grid.sync(); REFRESH_IDS();

    for (int r = gw; r < T; r += ngw) {
        float* row = x1 + (size_t)r * D; float ss = 0.f;
        for (int c = lane; c < D; c += 64) { float v = row[c];
#pragma unroll
            for (int k = 0; k < TOPK; ++k) v += bf2f(Y[((size_t)r * TOPK + k) * D + c]);
            row[c] = v; ss += v * v; }
        ss = wave_sum(ss); const float rs = rsqrtf(ss / (float)D + EPS);
        for (int c = lane; c < D; c += 64) XN2[(size_t)r * D + c] = f2bf(row[c] * rs);
    }
    grid.sync(); REFRESH_IDS();

    {
        pg8::Order So; So.init(T / 256, D / 256, nblk, blk, nullptr);
        pg8::EpiGate E1{GSB};
        pg8::gemm_phase(ldsl, (const char*)XN2, (const char*)Wpg_t, 0, D, So, pg8::DenseRows{D}, E1);
        pg8::EpiPle E2{GSB, x1};
        pg8::gemm_phase(ldsl, (const char*)PB, (const char*)Wpp_t, 0, PLE, So, pg8::DenseRows{PLE}, E2);
    }
    grid.sync(); REFRESH_IDS();

    rms_rows(x1, D, norm_final_g, P.out, D, D, T, gw, ngw, lane);
}

extern "C" void kernel_launch(void* const* d_in, const int* in_sizes, int n_in, void* d_out, int out_size, void* d_ws, size_t ws_size, hipStream_t stream) {
    static int grid = 0;
    if (grid == 0) {
        int dev = 0, cus = 0, per_cu = 0;
        (void)hipGetDevice(&dev);
        (void)hipDeviceGetAttribute(&cus, hipDeviceAttributeMultiprocessorCount, dev);
        if (hipFuncSetAttribute((const void*)fwd_naive, hipFuncAttributeMaxDynamicSharedMemorySize, LDS_BYTES) != hipSuccess) fprintf(stderr, "kernel_launch: hipFuncSetAttribute failed\n");
        (void)hipOccupancyMaxActiveBlocksPerMultiprocessor(&per_cu, (const void*)fwd_naive, NTHR, LDS_BYTES);
        if (per_cu < 1) { fprintf(stderr, "kernel_launch: occupancy query says %d blocks per CU\n", per_cu); per_cu = 1; }
        grid = cus;
        if (n_in != 29 || ws_size < WS_END) { fprintf(stderr, "kernel_launch: unexpected n_in %d or ws_size %zu\n", n_in, ws_size); }
    }
    Params p{};
    for (int i = 0; i < 29; ++i) p.in[i] = (const float*)d_in[i];
    p.out = (float*)d_out; p.ws = (unsigned char*)d_ws;
    void* args[] = {&p};
    hipError_t e = hipLaunchCooperativeKernel((const void*)fwd_naive, dim3(grid), dim3(NTHR), args, LDS_BYTES, stream);
    if (e != hipSuccess) fprintf(stderr, "cooperative launch failed: %s (grid %d)\n", hipGetErrorString(e), grid);
}
```

```cpp
#include <hip/hip_runtime.h>
#include <hip/hip_cooperative_groups.h>
#include <cstdio>
#include <cstdint>
namespace cg = cooperative_groups;

constexpr int NB = 8, S = 4096, T = NB * S, D = 1024, NH = 8, HD = 64, AW = 512, SW = 512, INW = 2056;
constexpr int NG = 32, NP = 64, NC = 16, NE = 32, TOPK = 4, DFF = 1024, PLE = 256;
constexpr int COL_K = 512, COL_V = 1024, COL_F = 1536, COL_U = 1544;
constexpr float EPS = 1e-5f;
constexpr int NTHR = 512, NWAVE = 8;
constexpr int MB = 256;
constexpr int CAP = T * TOPK + NE * MB;
constexpr int MAXTILES = CAP / MB;
constexpr int LDS_BYTES = 147456;

typedef unsigned short bf16_t;
__device__ __forceinline__ bf16_t f2bf(float f) { unsigned u = __builtin_bit_cast(unsigned, f); return (bf16_t)((u + 0x7fffu + ((u >> 16) & 1u)) >> 16); }
__device__ __forceinline__ float bf2f(bf16_t b) { return __builtin_bit_cast(float, (unsigned)b << 16); }
__device__ __forceinline__ unsigned pk2(float lo, float hi) { return (unsigned)f2bf(lo) | ((unsigned)f2bf(hi) << 16); }
__device__ __forceinline__ float ldf(const float* p, size_t i) { return p[i]; }
__device__ __forceinline__ float ldf(const bf16_t* p, size_t i) { return bf2f(p[i]); }

constexpr size_t MiB = 1u << 20;
constexpr size_t WS_CTL = 0;
constexpr size_t WS_WIN = 1 * MiB;
constexpr size_t WS_WGLU = 5 * MiB;
constexpr size_t WS_WOUT = 6 * MiB;
constexpr size_t WS_WPG = 8 * MiB;
constexpr size_t WS_WPP = 10 * MiB;
constexpr size_t WS_A16 = 11 * MiB;
constexpr size_t WS_S5H = 12 * MiB;
constexpr size_t WS_S5TG = 16 * MiB;
constexpr size_t WS_WDN = 22 * MiB;
constexpr size_t WS_X1 = 86 * MiB;
constexpr size_t WS_TOPI = 214 * MiB;
constexpr size_t WS_TOPG = 214 * MiB + 512 * 1024;
constexpr size_t WS_ROWTOK = 215 * MiB;
constexpr size_t WS_ROWGATE = 216 * MiB;
constexpr size_t WS_ROWSRC = 217 * MiB;
constexpr size_t WS_ROWSCL = 218 * MiB;
constexpr size_t WS_R1 = 219 * MiB;
constexpr size_t WS_PSA = 220 * MiB;
constexpr size_t WS_PSS = 221 * MiB;
constexpr size_t WS_LOGF = 222 * MiB;
constexpr size_t WS_PB = 223 * MiB;
constexpr size_t WS_A = 239 * MiB;
constexpr size_t WS_XN = WS_A;
constexpr size_t WS_Q = WS_A + 64 * MiB;
constexpr size_t WS_UX = WS_A + 160 * MiB;
constexpr size_t WS_MIXB = WS_A + 212 * MiB;
constexpr size_t WS_GB = WS_A + 276 * MiB;
constexpr size_t WS_ACT = WS_A;
constexpr size_t WS_XN2 = WS_A;
constexpr size_t WS_GS = WS_A + 64 * MiB;
constexpr size_t WS_B = WS_A + 308 * MiB;
constexpr size_t WS_WGU = WS_B;
constexpr size_t WS_X1B = WS_B + 128 * MiB;
constexpr size_t WS_Y = WS_B;
constexpr size_t WS_END = WS_B + 256 * MiB;
static_assert((size_t)CAP * 4 <= MiB && (size_t)CAP * DFF * 2 <= 272 * MiB, "list arrays fit 1 MiB each; ACT fits");
constexpr int UXP = 384;
constexpr int CT_COUNT = 0, CT_CURSOR = 64, CT_PADSTART = 128, CT_NTILES = 192, CT_TILEEXP = 256;
constexpr float LOG2E = 1.4426950408889634f, C2 = 0.125f * LOG2E;

namespace pg8 {
#define PG8_LAS __attribute__((address_space(3)))
typedef short bf16x8 __attribute__((ext_vector_type(8)));
typedef float f32x4 __attribute__((ext_vector_type(4)));
typedef unsigned u32x4 __attribute__((ext_vector_type(4)));
constexpr int BM = 256, BK = 64, HALF = 128, HTB = HALF * BK * 2, STAGE_BYTES = 8 * HTB, NXCD = 8, WGM = 8;
__device__ __forceinline__ int lds_byte(int r, int c) { const int st = (r >> 4) * 2 + (c >> 5), rr = r & 15, cc = c & 31, ob = rr * 64 + cc * 2; return st * 1024 + (ob ^ (((ob >> 9) & 1) << 5)); }
__device__ __forceinline__ void stage_rc(int b, int& R, int& C) { const int st = b / 1024, sb = b % 1024, swz = sb ^ (((sb >> 9) & 1) << 5); R = (st >> 1) * 16 + swz / 64; C = (st & 1) * 32 + (swz % 64) / 2; }
__device__ __forceinline__ int perm32(int rho) { const int n = rho >> 4, i = rho & 15; return 8 * (i >> 2) + 4 * n + (i & 3); }
struct Unit { int pm, pn, e; };
struct Order {
    int nM, nN, nwg, G, c; const int* texp;
    __device__ void init(int nM_, int nN_, int G_, int c_, const int* texp_) { nM = nM_; nN = nN_; nwg = nM * nN; G = G_; c = c_; texp = texp_; }
    __device__ bool next(int i, Unit& u) const {
        const long L = (long)i * G + c; if (L >= nwg) return false;
        int wgid = (int)L; { const int q = nwg / NXCD, r = nwg % NXCD, xcd = wgid % NXCD, off = wgid / NXCD; wgid = (xcd < r ? xcd * (q + 1) : r * (q + 1) + (xcd - r) * q) + off; }
        const int nig = WGM * nN, gid = wgid / nig, fm = gid * WGM, gsz = (nM - fm) < WGM ? (nM - fm) : WGM;
        u.pm = fm + ((wgid % nig) % gsz); u.pn = (wgid % nig) / gsz; u.e = texp ? __builtin_amdgcn_readfirstlane(texp[u.pm]) : 0; return true;
    }
};
struct DenseRows { int lda; __device__ __forceinline__ unsigned rowoff(const Unit& u, int r) const { return (unsigned)(u.pm * BM + r) * (unsigned)lda; } };
struct GatherRows { const int* src; int lda; __device__ __forceinline__ unsigned rowoff(const Unit& u, int r) const { return (unsigned)src[u.pm * BM + r] * (unsigned)lda; } };
struct OneUnit { int pm, e; __device__ bool next(int i, Unit& u) const { if (i) return false; u.pm = pm; u.pn = 0; u.e = e; return true; } };
typedef float f32x2_t __attribute__((ext_vector_type(2))); typedef __bf16 bf16x2_t __attribute__((ext_vector_type(2)));
__device__ __forceinline__ unsigned cvt_pk_bf16(float lo, float hi) { f32x2_t v = {lo, hi}; bf16x2_t b = __builtin_convertvector(v, bf16x2_t); return __builtin_bit_cast(unsigned, b); }

template <class Epi, class ARow, class Sched>
__device__ __forceinline__ void gemm_phase(int tid0, PG8_LAS unsigned char* lds, const char* Abase, const char* Bbase, size_t b_estride, int K, const Sched& S, const ARow& AR, const Epi& E) {
    int tid = tid0; asm volatile("" : "+v"(tid));
    const int wid = __builtin_amdgcn_readfirstlane(tid >> 6), lane = tid & 63, wr = wid >> 2, wc = wid & 3, fr = lane & 15, fq = lane >> 4;
    const int nt = K / BK;
    int Rr[2], Cc[2]; unsigned voffB[2];
#pragma unroll
    for (int i = 0; i < 2; ++i) { int R, C; stage_rc(tid * 16 + i * 8192, R, C); const int Rb = Epi::PERM ? ((R & ~31) + perm32(R & 31)) : R; Rr[i] = R; Cc[i] = C; voffB[i] = (unsigned)(Rb * K + C) * 2u; }
    const size_t kstep = (size_t)(BK * 2), hstep = (size_t)HALF * K * 2, tstep = 2 * hstep;
    const unsigned ldsw = (unsigned)wid * 1024u;
    const int aoff = lds_byte(wr * 64 + fr, fq * 8), boff = lds_byte(wc * 32 + fr, fq * 8);
#define PG8_SA(b, h) (((b) * 2 + (h)) * HTB)
#define PG8_SB(b, h) ((4 + (b) * 2 + (h)) * HTB)
#define PG8_STAGE(bufoff, gbase, voff) do { _Pragma("unroll") for (int _i = 0; _i < 2; ++_i) \
        __builtin_amdgcn_global_load_lds((const unsigned*)((const char*)(gbase) + (voff)[_i]), (PG8_LAS unsigned*)(lds + (bufoff) + ldsw + _i * 8192), 16, 0, 0); } while (0)
#define PG8_LDA(dst, b, h) do { _Pragma("unroll") for (int m = 0; m < 4; ++m) _Pragma("unroll") for (int k = 0; k < 2; ++k) dst[m][k] = *(const PG8_LAS bf16x8*)(lds + PG8_SA(b, h) + aoff + m * 2048 + k * 1024); } while (0)
#define PG8_LDB(dst, b, h) do { _Pragma("unroll") for (int n = 0; n < 2; ++n) _Pragma("unroll") for (int k = 0; k < 2; ++k) dst[n][k] = *(const PG8_LAS bf16x8*)(lds + PG8_SB(b, h) + boff + n * 2048 + k * 1024); } while (0)
#define PG8_MMA(ai, bj, At, Bt) do { __builtin_amdgcn_s_setprio(1); _Pragma("unroll") for (int m = 0; m < 4; ++m) _Pragma("unroll") for (int n = 0; n < 2; ++n) _Pragma("unroll") for (int k = 0; k < 2; ++k) \
        acc[ai][bj][m][n] = __builtin_amdgcn_mfma_f32_16x16x32_bf16(Bt[n][k], At[m][k], acc[ai][bj][m][n], 0, 0, 0); __builtin_amdgcn_s_setprio(0); } while (0)
#define PG8_WAIT_V(n) asm volatile("s_waitcnt vmcnt(" #n ")" ::: "memory")
#define PG8_WAIT_L(n) asm volatile("s_waitcnt lgkmcnt(" #n ")" ::: "memory")
#define PG8_BAR __builtin_amdgcn_s_barrier()
#define PG8_SCHED __builtin_amdgcn_sched_barrier(0)
#define PG8_VOFF(dst, u) do { _Pragma("unroll") for (int _h = 0; _h < 2; ++_h) _Pragma("unroll") for (int _i = 0; _i < 2; ++_i) dst[_h][_i] = (AR.rowoff(u, _h * HALF + Rr[_i]) + (unsigned)Cc[_i]) * 2u; } while (0)
    Unit cur, nxt; int ui = 0;
    if (!S.next(0, cur)) return;
    f32x4 acc[2][2][4][2];
#pragma unroll
    for (int a = 0; a < 2; ++a)
#pragma unroll
        for (int b = 0; b < 2; ++b)
#pragma unroll
            for (int m = 0; m < 4; ++m)
#pragma unroll
                for (int n = 0; n < 2; ++n) acc[a][b][m][n] = (f32x4){0.f, 0.f, 0.f, 0.f};
    bf16x8 At[4][2], B0[2][2], B1[2][2];
    unsigned cvA[2][2], nvA[2][2];
    PG8_VOFF(cvA, cur);
    const char* cB = Bbase + (size_t)cur.e * b_estride + (size_t)cur.pn * tstep;
    PG8_STAGE(PG8_SB(0, 0), cB, voffB); PG8_STAGE(PG8_SB(0, 1), cB + hstep, voffB); PG8_STAGE(PG8_SA(0, 0), Abase, cvA[0]); PG8_STAGE(PG8_SA(0, 1), Abase, cvA[1]);
    if (wr == 1) PG8_BAR;
    PG8_WAIT_V(2); PG8_BAR;
    PG8_STAGE(PG8_SB(1, 0), cB + kstep, voffB); PG8_STAGE(PG8_SA(1, 0), Abase + kstep, cvA[0]); PG8_STAGE(PG8_SB(1, 1), cB + hstep + kstep, voffB);
    PG8_WAIT_V(6); PG8_BAR;
    for (;;) {
        const bool has_next = S.next(ui + 1, nxt);
        if (has_next) { PG8_VOFF(nvA, nxt); } else {
#pragma unroll
            for (int h = 0; h < 2; ++h)
#pragma unroll
                for (int i = 0; i < 2; ++i) nvA[h][i] = cvA[h][i]; }
        const char* nB = has_next ? Bbase + (size_t)nxt.e * b_estride + (size_t)nxt.pn * tstep : cB;
        for (int t = 0; t < nt; t += 2) {
            const bool last = (t == nt - 2);
            if constexpr (Epi::MID) { if (t == nt / 2) E.mid(acc, cur, wr, wc, fr, fq); }
            const char* a1 = Abase + (size_t)(t + 1) * kstep;
            const char* a2 = last ? Abase : Abase + (size_t)(t + 2) * kstep; const char* b2 = last ? nB : cB + (size_t)(t + 2) * kstep;
            const char* a3 = a2 + kstep; const char* b3 = b2 + kstep;
            unsigned v2[2][2];
#pragma unroll
            for (int h = 0; h < 2; ++h)
#pragma unroll
                for (int i = 0; i < 2; ++i) v2[h][i] = last ? nvA[h][i] : cvA[h][i];
            PG8_LDB(B0, 0, 0); PG8_LDB(B1, 0, 1); PG8_SCHED; PG8_LDA(At, 0, 0); PG8_STAGE(PG8_SA(1, 1), a1, cvA[1]);
            PG8_WAIT_V(8); PG8_WAIT_L(0); PG8_BAR; PG8_MMA(0, 0, At, B0); PG8_MMA(0, 1, At, B1); PG8_BAR; PG8_SCHED;
            PG8_LDA(At, 0, 1); PG8_STAGE(PG8_SB(0, 0), b2, voffB); PG8_STAGE(PG8_SB(0, 1), b2 + hstep, voffB); PG8_STAGE(PG8_SA(0, 0), a2, v2[0]);
            PG8_WAIT_V(8); PG8_WAIT_L(0); PG8_BAR; PG8_MMA(1, 0, At, B0); PG8_MMA(1, 1, At, B1); PG8_BAR; PG8_SCHED;
            PG8_LDB(B0, 1, 0); PG8_LDB(B1, 1, 1); PG8_SCHED; PG8_LDA(At, 1, 0); PG8_STAGE(PG8_SA(0, 1), a2, v2[1]);
            PG8_WAIT_V(8); PG8_WAIT_L(0); PG8_BAR; PG8_MMA(0, 0, At, B0); PG8_MMA(0, 1, At, B1); PG8_BAR; PG8_SCHED;
            PG8_LDA(At, 1, 1); PG8_STAGE(PG8_SB(1, 0), b3, voffB); PG8_STAGE(PG8_SB(1, 1), b3 + hstep, voffB); PG8_STAGE(PG8_SA(1, 0), a3, v2[0]);
            PG8_WAIT_V(8); PG8_WAIT_L(0); PG8_BAR; PG8_MMA(1, 0, At, B0); PG8_MMA(1, 1, At, B1); PG8_BAR; PG8_SCHED;
        }
        if (wr == 0) PG8_BAR;
        if constexpr (!Epi::AFTER) E(acc, cur, wr, wc, fr, fq);
        if (!has_next) break;
#pragma unroll
        for (int a = 0; a < 2; ++a)
#pragma unroll
            for (int b = 0; b < 2; ++b)
#pragma unroll
                for (int m = 0; m < 4; ++m)
#pragma unroll
                    for (int n = 0; n < 2; ++n) acc[a][b][m][n] = (f32x4){0.f, 0.f, 0.f, 0.f};
        cur = nxt; cB = nB; ++ui;
#pragma unroll
        for (int h = 0; h < 2; ++h)
#pragma unroll
            for (int i = 0; i < 2; ++i) cvA[h][i] = nvA[h][i];
        if (wr == 1) PG8_BAR;
    }
    PG8_WAIT_V(0);
    PG8_BAR;
    if constexpr (Epi::AFTER) E.after(acc, cur, wr, wc, fr, fq, lds);
#undef PG8_SA
#undef PG8_SB
#undef PG8_STAGE
#undef PG8_LDA
#undef PG8_LDB
#undef PG8_MMA
#undef PG8_WAIT_V
#undef PG8_WAIT_L
#undef PG8_BAR
#undef PG8_SCHED
#undef PG8_VOFF
}

__device__ __forceinline__ float sigm(float x) { return __builtin_amdgcn_rcpf(1.f + __builtin_amdgcn_exp2f(-1.4426950408889634f * x)); }
struct EpiSwiglu {
    static constexpr bool PERM = true, MID = false, AFTER = false;
    bf16_t* act; const float* b_gu; const float* rowscale;
    __device__ __forceinline__ void operator()(const f32x4 (&acc)[2][2][4][2], const Unit& u, int wr, int wc, int fr, int fq) const {
        const int row0 = u.pm * BM + wr * 64 + fr, col0 = u.pn * HALF + wc * 32 + 8 * fq;
        const float* bias = b_gu + (size_t)u.e * (2 * DFF) + col0;
        f32x4 bg[2], bu[2];
#pragma unroll
        for (int n = 0; n < 2; ++n) { bg[n] = *(const f32x4*)(bias + 4 * n); bu[n] = *(const f32x4*)(bias + DFF + 4 * n); }
#pragma unroll
        for (int ai = 0; ai < 2; ++ai)
#pragma unroll
            for (int m = 0; m < 4; ++m) { const int row = row0 + ai * HALF + m * 16; const float rs = rowscale[row];
                float o[8];
#pragma unroll
                for (int n = 0; n < 2; ++n)
#pragma unroll
                    for (int j = 0; j < 4; ++j) { const float g = fminf(acc[ai][0][m][n][j] * rs + bg[n][j], 7.f); const float up = fminf(fmaxf(acc[ai][1][m][n][j] * rs + bu[n][j], -7.f), 7.f);
                        o[4 * n + j] = g * sigm(1.702f * g) * (up + 1.f); }
                u32x4 w; w.x = cvt_pk_bf16(o[0], o[1]); w.y = cvt_pk_bf16(o[2], o[3]); w.z = cvt_pk_bf16(o[4], o[5]); w.w = cvt_pk_bf16(o[6], o[7]);
                *(u32x4*)(act + (size_t)row * DFF + col0) = w; }
    }
};
struct EpiScatter {
    static constexpr bool PERM = true, MID = false, AFTER = false;
    bf16_t* Y; const float* b_dn; const int* rowtok; const float* rowgate;
    __device__ __forceinline__ void operator()(const f32x4 (&acc)[2][2][4][2], const Unit& u, int wr, int wc, int fr, int fq) const {
        const int row0 = u.pm * BM + wr * 64 + fr, col0 = u.pn * BM + wc * 32 + 8 * fq;
        const float* bias = b_dn + (size_t)u.e * D + col0;
        f32x4 bv[2][2];
#pragma unroll
        for (int bj = 0; bj < 2; ++bj)
#pragma unroll
            for (int n = 0; n < 2; ++n) bv[bj][n] = *(const f32x4*)(bias + bj * HALF + 4 * n);
#pragma unroll
        for (int ai = 0; ai < 2; ++ai)
#pragma unroll
            for (int m = 0; m < 4; ++m) { const int row = row0 + ai * HALF + m * 16; const int id = rowtok[row]; const float gt = rowgate[row];
                if (id >= 0) { bf16_t* yp = Y + (size_t)id * D + col0;
#pragma unroll
                    for (int bj = 0; bj < 2; ++bj) { const f32x4 v0 = (acc[ai][bj][m][0] + bv[bj][0]) * gt, v1 = (acc[ai][bj][m][1] + bv[bj][1]) * gt;
                        u32x4 w; w.x = cvt_pk_bf16(v0[0], v0[1]); w.y = cvt_pk_bf16(v0[2], v0[3]); w.z = cvt_pk_bf16(v1[0], v1[1]); w.w = cvt_pk_bf16(v1[2], v1[3]);
                        *(u32x4*)(yp + bj * HALF) = w; } } }
    }
};
struct EpiQKVU {
    static constexpr bool PERM = true, MID = false, AFTER = false;
    bf16_t* O; size_t stride; bf16_t* ux;
    __device__ __forceinline__ void operator()(const f32x4 (&acc)[2][2][4][2], const Unit& u, int wr, int wc, int fr, int fq) const {
        const int row0 = u.pm * BM + wr * 64 + fr, t = u.pn >> 1; const float sc = (t == 0) ? C2 : 1.f;
        const int colt = (u.pn & 1) * BM + wc * 32 + 8 * fq;
        bf16_t* base = O + (size_t)t * stride + colt;
#pragma unroll
        for (int ai = 0; ai < 2; ++ai)
#pragma unroll
            for (int m = 0; m < 4; ++m) { const int row = row0 + ai * HALF + m * 16;
#pragma unroll
                for (int bj = 0; bj < 2; ++bj) { const f32x4 v0 = acc[ai][bj][m][0] * sc, v1 = acc[ai][bj][m][1] * sc;
                    u32x4 w; w.x = cvt_pk_bf16(v0[0], v0[1]); w.y = cvt_pk_bf16(v0[2], v0[3]); w.z = cvt_pk_bf16(v1[0], v1[1]); w.w = cvt_pk_bf16(v1[2], v1[3]);
                    if (t < 3) *(u32x4*)(base + (size_t)row * 512 + bj * HALF) = w;
                    else { const int col = colt + bj * HALF, g = col >> 4, b = row >> 12, tt = row & (S - 1);
                        *(u32x4*)(ux + ((size_t)((g * NB + b) * 256 + (tt >> 4))) * UXP + (tt & 15) * 16 + (col & 15)) = w; } } }
    }
};
struct EpiS5H {
    static constexpr bool PERM = false, MID = false, AFTER = true;
    bf16_t* ux; const float* a16;
    __device__ __forceinline__ void operator()(const f32x4 (&)[2][2][4][2], const Unit&, int, int, int, int) const {}
    __device__ __forceinline__ void after(const f32x4 (&acc)[2][2][4][2], const Unit& u, int wr, int wc, int fr, int fq, PG8_LAS unsigned char* lds) const {
        PG8_LAS float* Sx = (PG8_LAS float*)lds;
        const int row0 = wr * 64 + fr, col0 = wc * 32 + 4 * fq;
#pragma unroll
        for (int ai = 0; ai < 2; ++ai)
#pragma unroll
            for (int m = 0; m < 4; ++m)
#pragma unroll
                for (int n = 0; n < 2; ++n) *(PG8_LAS f32x4*)(Sx + (row0 + ai * HALF + m * 16) * 128 + col0 + n * 16) = acc[ai][0][m][n];
        asm volatile("s_waitcnt lgkmcnt(0)" ::: "memory"); __builtin_amdgcn_s_barrier(); asm volatile("" ::: "memory");
        int tq = (wr * 4 + wc) * 64 + fq * 16 + fr; asm volatile("" : "+v"(tq));
        if (tq < 64) {
            const int p = tq; const float ar = a16[2 * p], ai_ = a16[2 * p + 1]; float xr = 0.f, xi = 0.f;
            bf16_t* urow = ux + (size_t)u.pm * 256 * UXP + 256;
            urow[p] = 0; urow[64 + p] = 0;
#pragma unroll 8
            for (int c = 0; c < 255; ++c) { const float sr = Sx[c * 128 + p], si = Sx[c * 128 + 64 + p];
                const float nxr = ar * xr - ai_ * xi + sr, nxi = ar * xi + ai_ * xr + si; xr = nxr; xi = nxi;
                urow[(size_t)(c + 1) * UXP + p] = f2bf(xr); urow[(size_t)(c + 1) * UXP + 64 + p] = f2bf(xi); }
            asm volatile("s_waitcnt vmcnt(0)" ::: "memory");
        }
        asm volatile("s_waitcnt lgkmcnt(0)" ::: "memory"); __builtin_amdgcn_s_barrier(); asm volatile("" ::: "memory");
    }
};
struct EpiS5Y {
    static constexpr bool PERM = true, MID = false, AFTER = false;
    const bf16_t* ux; const float* d_skip; bf16_t* G;
    __device__ __forceinline__ void operator()(const f32x4 (&acc)[2][2][4][2], const Unit& u, int wr, int wc, int fr, int fq) const {
        const int row0 = wr * 64 + fr, g = u.e, b = u.pm & 7, co0 = 8 * (fq & 1);
        const f32x4 d0 = *(const f32x4*)(d_skip + g * 16 + co0), d1 = *(const f32x4*)(d_skip + g * 16 + co0 + 4);
#pragma unroll
        for (int ai = 0; ai < 2; ++ai)
#pragma unroll
            for (int m = 0; m < 4; ++m) { const int c = row0 + ai * HALF + m * 16;
#pragma unroll
                for (int bj = 0; bj < 2; ++bj) { const int ncol = bj * HALF + wc * 32 + 8 * fq, i = ncol >> 4;
                    const u32x4 uv = *(const u32x4*)(ux + ((size_t)u.pm * 256 + c) * UXP + ncol); float o[8];
#pragma unroll
                    for (int n = 0; n < 2; ++n)
#pragma unroll
                        for (int j = 0; j < 4; ++j) { const unsigned w = uv[2 * n + (j >> 1)]; const float uu = __builtin_bit_cast(float, (j & 1) ? (w & 0xffff0000u) : (w << 16));
                            const float y = acc[ai][bj][m][n][j] + (n ? d1[j] : d0[j]) * uu; o[4 * n + j] = y * sigm(1.5957691216057308f * (y + 0.044715f * y * y * y)); }
                    u32x4 w; w.x = cvt_pk_bf16(o[0], o[1]); w.y = cvt_pk_bf16(o[2], o[3]); w.z = cvt_pk_bf16(o[4], o[5]); w.w = cvt_pk_bf16(o[6], o[7]);
                    *(u32x4*)(G + ((size_t)b * S + c * 16 + i) * SW + g * 16 + co0) = w; } }
    }
};
struct EpiGlu {
    static constexpr bool PERM = true, MID = false, AFTER = false;
    const bf16_t* G; bf16_t* mixb; const float* b_glu; float* pss;
    __device__ __forceinline__ void operator()(const f32x4 (&acc)[2][2][4][2], const Unit& u, int wr, int wc, int fr, int fq) const {
        const int row0 = u.pm * BM + wr * 64 + fr, col0 = u.pn * BM + wc * 32 + 8 * fq;
        f32x4 bv[2][2];
#pragma unroll
        for (int bj = 0; bj < 2; ++bj)
#pragma unroll
            for (int n = 0; n < 2; ++n) bv[bj][n] = *(const f32x4*)(b_glu + col0 + bj * HALF + 4 * n);
#pragma unroll
        for (int ai = 0; ai < 2; ++ai)
#pragma unroll
            for (int m = 0; m < 4; ++m) { const int row = row0 + ai * HALF + m * 16; float ss = 0.f;
#pragma unroll
                for (int bj = 0; bj < 2; ++bj) { const u32x4 gv = *(const u32x4*)(G + (size_t)row * SW + col0 + bj * HALF); float o[8];
#pragma unroll
                    for (int n = 0; n < 2; ++n)
#pragma unroll
                        for (int j = 0; j < 4; ++j) { const unsigned w = gv[2 * n + (j >> 1)]; const float g = __builtin_bit_cast(float, (j & 1) ? (w & 0xffff0000u) : (w << 16));
                            const float v = g * sigm(acc[ai][bj][m][n][j] + bv[bj][n][j]); o[4 * n + j] = v; ss += v * v; }
                    u32x4 w; w.x = cvt_pk_bf16(o[0], o[1]); w.y = cvt_pk_bf16(o[2], o[3]); w.z = cvt_pk_bf16(o[4], o[5]); w.w = cvt_pk_bf16(o[6], o[7]);
                    *(u32x4*)(mixb + (size_t)row * D + AW + col0 + bj * HALF) = w; }
                ss += __shfl_xor(ss, 16); ss += __shfl_xor(ss, 32);
                if (fq == 0) pss[(size_t)row * 8 + u.pn * 4 + wc] = ss; }
    }
};
struct EpiOut {
    static constexpr bool PERM = false, MID = true, AFTER = false;
    const float* x; float* x1; bf16_t* x1b; const float* psa; const float* pss;
    __device__ __forceinline__ float rsum8(const float* p) const { const f32x4 a = *(const f32x4*)p, b = *(const f32x4*)(p + 4); return ((a[0] + a[1]) + (a[2] + a[3])) + ((b[0] + b[1]) + (b[2] + b[3])); }
    __device__ __forceinline__ void mid(f32x4 (&acc)[2][2][4][2], const Unit& u, int wr, int wc, int fr, int fq) const {
        int row0 = u.pm * BM + wr * 64 + fr; asm volatile("" : "+v"(row0));
#pragma unroll
        for (int ai = 0; ai < 2; ++ai)
#pragma unroll
            for (int m = 0; m < 4; ++m) { const int row = row0 + ai * HALF + m * 16;
                const float ra = rsqrtf(rsum8(psa + (size_t)row * 8) * (1.f / AW) + EPS), rs = rsqrtf(rsum8(pss + (size_t)row * 8) * (1.f / SW) + EPS); const float f = ra / rs;
#pragma unroll
                for (int bj = 0; bj < 2; ++bj)
#pragma unroll
                    for (int n = 0; n < 2; ++n) acc[ai][bj][m][n] *= f;
                asm volatile("" ::: "memory"); }
    }
    __device__ __forceinline__ void operator()(const f32x4 (&acc)[2][2][4][2], const Unit& u, int wr, int wc, int fr, int fq) const {
        int row0 = u.pm * BM + wr * 64 + fr; asm volatile("" : "+v"(row0)); const int col0 = u.pn * BM + wc * 32 + 4 * fq;
#pragma unroll
        for (int ai = 0; ai < 2; ++ai)
#pragma unroll
            for (int m = 0; m < 4; ++m) { const int row = row0 + ai * HALF + m * 16; const float rs = rsqrtf(rsum8(pss + (size_t)row * 8) * (1.f / SW) + EPS); const size_t off = (size_t)row * D + col0;
#pragma unroll
                for (int bj = 0; bj < 2; ++bj)
#pragma unroll
                    for (int n = 0; n < 2; ++n) { const size_t o2 = off + bj * HALF + n * 16; const f32x4 v = *(const f32x4*)(x + o2) + acc[ai][bj][m][n] * rs;
                        *(f32x4*)(x1 + o2) = v; uint2 w; w.x = cvt_pk_bf16(v[0], v[1]); w.y = cvt_pk_bf16(v[2], v[3]); *(uint2*)(x1b + o2) = w; }
                asm volatile("" ::: "memory"); }
    }
};
struct EpiGate {
    static constexpr bool PERM = false, MID = false, AFTER = false;
    bf16_t* gs;
    __device__ __forceinline__ void operator()(const f32x4 (&acc)[2][2][4][2], const Unit& u, int wr, int wc, int fr, int fq) const {
        const int row0 = u.pm * BM + wr * 64 + fr, col0 = u.pn * BM + wc * 32 + 4 * fq;
#pragma unroll
        for (int ai = 0; ai < 2; ++ai)
#pragma unroll
            for (int m = 0; m < 4; ++m) { const size_t off = (size_t)(row0 + ai * HALF + m * 16) * D + col0;
#pragma unroll
                for (int bj = 0; bj < 2; ++bj)
#pragma unroll
                    for (int n = 0; n < 2; ++n) { const f32x4 a = acc[ai][bj][m][n]; uint2 w; w.x = cvt_pk_bf16(sigm(a[0]), sigm(a[1])); w.y = cvt_pk_bf16(sigm(a[2]), sigm(a[3])); *(uint2*)(gs + off + bj * HALF + n * 16) = w; } }
    }
};
struct EpiPle {
    static constexpr bool PERM = false, MID = false, AFTER = false;
    const bf16_t* gs; float* x2;
    __device__ __forceinline__ void operator()(const f32x4 (&acc)[2][2][4][2], const Unit& u, int wr, int wc, int fr, int fq) const {
        const int row0 = u.pm * BM + wr * 64 + fr, col0 = u.pn * BM + wc * 32 + 4 * fq;
#pragma unroll
        for (int ai = 0; ai < 2; ++ai)
#pragma unroll
            for (int m = 0; m < 4; ++m) { const size_t off = (size_t)(row0 + ai * HALF + m * 16) * D + col0;
#pragma unroll
                for (int bj = 0; bj < 2; ++bj)
#pragma unroll
                    for (int n = 0; n < 2; ++n) { const size_t o2 = off + bj * HALF + n * 16;
                        const unsigned long long gw_ = __hip_atomic_load((const unsigned long long*)(gs + o2), __ATOMIC_RELAXED, __HIP_MEMORY_SCOPE_AGENT);
                        const unsigned lo = (unsigned)gw_, hi = (unsigned)(gw_ >> 32);
                        f32x4 g; g[0] = __builtin_bit_cast(float, lo << 16); g[1] = __builtin_bit_cast(float, lo & 0xffff0000u); g[2] = __builtin_bit_cast(float, hi << 16); g[3] = __builtin_bit_cast(float, hi & 0xffff0000u);
                        *(f32x4*)(x2 + o2) = *(const f32x4*)(x2 + o2) + g * acc[ai][bj][m][n]; } }
    }
};
}

__device__ __forceinline__ void transpose_item(const float* W, int ldw, int k0, int c0, const float* kscale, bf16_t* WT, int K, int r0, __attribute__((address_space(3))) float* scr, int lane) {
#pragma unroll 8
    for (int i = 0; i < 32; ++i) { const int kk = 2 * i + (lane >> 5); float v = W[(size_t)(k0 + kk) * ldw + c0 + (lane & 31)]; if (kscale) v *= kscale[k0 + kk]; scr[kk * 33 + (lane & 31)] = v; }
    __builtin_amdgcn_s_waitcnt(0xC07F); asm volatile("" ::: "memory");
    const int c = lane & 7;
#pragma unroll
    for (int j = 0; j < 4; ++j) { const int n = (lane >> 3) + 8 * j; const __attribute__((address_space(3))) float* s = scr + (8 * c) * 33 + n;
        uint4 o; o.x = pk2(s[0 * 33], s[1 * 33]); o.y = pk2(s[2 * 33], s[3 * 33]); o.z = pk2(s[4 * 33], s[5 * 33]); o.w = pk2(s[6 * 33], s[7 * 33]);
        *(uint4*)(WT + (size_t)(r0 + n) * K + k0 + 8 * c) = o; }
    __builtin_amdgcn_s_waitcnt(0xC07F); asm volatile("" ::: "memory");
}


namespace attn_body {
using bf16x8=__attribute__((ext_vector_type(8)))short;
using s16x4=__attribute__((ext_vector_type(4)))short;
using f32x16=__attribute__((ext_vector_type(16)))float;
using f32x4=__attribute__((ext_vector_type(4)))float;
using u32x4=__attribute__((ext_vector_type(4)))unsigned;
constexpr int SEQ=S,DH=64,DM=NH*DH,OPITCH=D;
constexpr int NW=8,QBLK=32,QB=QBLK*NW,KVBLK=64,NQB=SEQ/QB;
__device__ __forceinline__ int crow(int r,int hi){return (r&3)+8*(r>>2)+4*hi;}
#define SBAR() __builtin_amdgcn_sched_barrier(0)
__device__ __forceinline__ void cmask(f32x16&p0,f32x16&p1,int jb,int qrel,int hi){
  const float NEG=-INFINITY; int kb=64*jb+4*hi;
  #pragma unroll
  for(int r=0;r<16;++r){int kv=kb+(r&3)+8*(r>>2); if(kv>qrel)p0[r]=NEG; if(kv+32>qrel)p1[r]=NEG;}
}
constexpr int NSLOT=3, SLOTB=8192;
constexpr int LDS_K=0, LDS_V=NSLOT*SLOTB, LDS_WS=2*NSLOT*SLOTB, LDS_OST=LDS_WS+NW*64*4, LDS_C=LDS_OST+NW*4096, ATT_LDS_BYTES=LDS_C+(SEQ+64)*4;
__device__ __forceinline__ void glds16(const void*gsrc,unsigned lds_dst){unsigned keep;
  asm volatile("s_mov_b32 %0, m0\n\ts_mov_b32 m0, %2\n\ts_nop 0\n\tglobal_load_lds_dwordx4 %1, off\n\ts_mov_b32 m0, %0":"=&s"(keep):"v"(gsrc),"s"(lds_dst):"memory");}
__device__ __forceinline__ float max3f(float a,float b,float c){float r;asm("v_max3_f32 %0, %1, %2, %3":"=v"(r):"v"(a),"v"(b),"v"(c));return r;}
__device__ __forceinline__ float max2f(float a,float b){float r;asm("v_max_f32_e32 %0, %1, %2":"=v"(r):"v"(a),"v"(b));return r;}
__device__ __forceinline__ float fadd_s(float a,float b){float r;asm("v_add_f32_e32 %0, %1, %2":"=v"(r):"v"(a),"v"(b));return r;}
__device__ __forceinline__ float fsub_s(float a,float b){float r;asm("v_sub_f32_e32 %0, %1, %2":"=v"(r):"v"(a),"v"(b));return r;}
typedef float f32x2_t __attribute__((ext_vector_type(2))); typedef __bf16 bf16x2_t __attribute__((ext_vector_type(2)));
__device__ __forceinline__ unsigned cvtpk_s(float lo,float hi){f32x2_t v={lo,hi};bf16x2_t b=__builtin_convertvector(v,bf16x2_t);return __builtin_bit_cast(unsigned,b);}
#define WAIT_BAR(N) asm volatile("s_waitcnt vmcnt(" #N ") lgkmcnt(0)\n\ts_barrier":::"memory")
typedef __attribute__((address_space(3))) const char* lds_cptr;
typedef __attribute__((address_space(3))) const float* lds_fptr;
typedef short v4i16_t __attribute__((ext_vector_type(4)));
__device__ __forceinline__ void qkt(f32x16&p0,f32x16&p1,const char*Kslot,const bf16x8*qr,int r32,int hi){
  const char*kb=Kslot+hi*1024+r32*16;
  #pragma unroll
  for(int d0=0;d0<4;++d0){
    const bf16x8 b0=*reinterpret_cast<const bf16x8*>(kb+d0*2048);
    const bf16x8 b1=*reinterpret_cast<const bf16x8*>(kb+d0*2048+512);
    p0=__builtin_amdgcn_mfma_f32_32x32x16_bf16(b0,qr[d0],p0,0,0,0);p1=__builtin_amdgcn_mfma_f32_32x32x16_bf16(b1,qr[d0],p1,0,0,0);}
}
__device__ __forceinline__ void kload8(bf16x8*kf,lds_cptr kp){
  kf[0]=*(const __attribute__((address_space(3))) bf16x8*)(kp);      kf[1]=*(const __attribute__((address_space(3))) bf16x8*)(kp+512);
  kf[2]=*(const __attribute__((address_space(3))) bf16x8*)(kp+2048); kf[3]=*(const __attribute__((address_space(3))) bf16x8*)(kp+2560);
  kf[4]=*(const __attribute__((address_space(3))) bf16x8*)(kp+4096); kf[5]=*(const __attribute__((address_space(3))) bf16x8*)(kp+4608);
  kf[6]=*(const __attribute__((address_space(3))) bf16x8*)(kp+6144); kf[7]=*(const __attribute__((address_space(3))) bf16x8*)(kp+6656);
}
__device__ __forceinline__ void kload2(bf16x8*kf,lds_cptr kp,int j){ kf[2*j]=*(const __attribute__((address_space(3))) bf16x8*)(kp+j*2048); kf[2*j+1]=*(const __attribute__((address_space(3))) bf16x8*)(kp+j*2048+512); }
__device__ __forceinline__ s16x4 vtr(lds_cptr p){ return __builtin_bit_cast(s16x4,__builtin_amdgcn_ds_read_tr16_b64_v4i16((__attribute__((address_space(3))) v4i16_t*)p)); }
__device__ __forceinline__ float rowmax(const f32x16&p0,const f32x16&p1){
  float a=max3f(p0[0],p0[1],p1[0]),b=max3f(p0[2],p0[3],p1[1]);a=max3f(a,p1[2],p1[3]);
  #pragma unroll
  for(int r=4;r<16;r+=4){a=max3f(a,p0[r],p0[r+1]);b=max3f(b,p0[r+2],p0[r+3]);a=max3f(a,p1[r],p1[r+1]);b=max3f(b,p1[r+2],p1[r+3]);}
  const float m=max2f(a,b);
  auto rr=__builtin_amdgcn_permlane32_swap(__float_as_uint(m),__float_as_uint(m),false,false);
  return max2f(__uint_as_float(rr[0]),__uint_as_float(rr[1]));
}
__device__ __forceinline__ void pv(f32x16*o,int vb,bf16x8 pa0,bf16x8 pa1,bf16x8 pa2,bf16x8 pa3){
  #pragma unroll
  for(int d0=0;d0<2;++d0){s16x4 lo[4],hi[4];
    #pragma unroll
    for(int ks=0;ks<4;++ks){
      asm volatile("ds_read_b64_tr_b16 %0,%1 offset:%c2":"=&v"(lo[ks]):"v"(vb),"i"(d0*4096+ks*1024):"memory");
      asm volatile("ds_read_b64_tr_b16 %0,%1 offset:%c2":"=&v"(hi[ks]):"v"(vb),"i"(d0*4096+ks*1024+512):"memory");}
    asm volatile("s_waitcnt lgkmcnt(0)":::"memory");SBAR();
    #define PK(k) (bf16x8){lo[k][0],lo[k][1],lo[k][2],lo[k][3],hi[k][0],hi[k][1],hi[k][2],hi[k][3]}
    o[d0]=__builtin_amdgcn_mfma_f32_32x32x16_bf16(pa0,PK(0),o[d0],0,0,0);
    o[d0]=__builtin_amdgcn_mfma_f32_32x32x16_bf16(pa1,PK(1),o[d0],0,0,0);
    o[d0]=__builtin_amdgcn_mfma_f32_32x32x16_bf16(pa2,PK(2),o[d0],0,0,0);
    o[d0]=__builtin_amdgcn_mfma_f32_32x32x16_bf16(pa3,PK(3),o[d0],0,0,0);
    #undef PK
  }
}
__device__ __forceinline__ void prep_c(int tid0,int b,int h,const float*logf,char*shm){
  int tid=tid0; asm volatile("":"+v"(tid)); const int lane=tid&63,wid=tid>>6;
  float*cl=(float*)(shm+LDS_C); float*wtot=(float*)(shm+LDS_WS);
  float v[8]; float tot=0.f;
  #pragma unroll
  for(int i=0;i<8;++i){ v[i]=logf[((size_t)b*SEQ+tid*8+i)*8+h]; tot+=v[i]; }
  float incl=tot;
  #pragma unroll
  for(int o=1;o<64;o<<=1){ const float n=__shfl_up(incl,o); if(lane>=o)incl+=n; }
  if(lane==63)wtot[wid]=incl;
  __syncthreads();
  float pre=incl-tot;
  #pragma unroll
  for(int w=0;w<8;++w) if(w<wid)pre+=wtot[w];
  #pragma unroll
  for(int i=0;i<8;++i){ pre+=v[i]; cl[tid*8+i]=pre*LOG2E; }
  if(tid<64)cl[SEQ+tid]=0.f;
  __syncthreads();
}
template<int THRL> __device__ __forceinline__ void attn_unit(int tid0,int b,int h,int qb,const bf16_t*Q,const bf16_t*__restrict__ K,const bf16_t*__restrict__ V,bf16_t*O,float*psa,char*shm){
  int tid=tid0; asm volatile("":"+v"(tid)); const int lane=tid&63,r32=lane&31,hi=lane>>5; const int wid=__builtin_amdgcn_readfirstlane(tid>>6);
  const long rowbase=(long)b*SEQ; const int q0=qb*QB;
  const bf16_t*Qw=Q+(rowbase+q0+wid*QBLK)*DM+h*DH;
  const bf16_t*Kh=K+rowbase*DM+h*DH,*Vh=V+rowbase*DM+h*DH;
  const unsigned lds0=(unsigned)(uintptr_t)shm;
  float*wsf=(float*)(shm+LDS_WS)+wid*64;
  const bf16_t*ksrc=Kh+(long)lane*DM+wid*8;
  const bf16_t*vsrc=Vh+(long)(16*(wid&3)+(lane>>2))*DM+(wid>>2)*32+(lane&3)*8;
  const unsigned kdst=lds0+LDS_K+wid*1024, vdst=lds0+LDS_V+wid*1024;
  #define DMA_K(t,slot) glds16(ksrc+(long)(t)*KVBLK*DM,(unsigned)__builtin_amdgcn_readfirstlane(kdst+(slot)))
  #define DMA_V(t,slot) glds16(vsrc+(long)(t)*KVBLK*DM,(unsigned)__builtin_amdgcn_readfirstlane(vdst+(slot)))
  const int vb0=(int)(lds0+LDS_V)+((lane>>4)&1)*32+(lane&3)*8+(4*hi+((lane&15)>>2))*64;
  const char*Kbase=shm+LDS_K; bf16x8 kf[8];
  const lds_cptr shm3=(lds_cptr)shm; const lds_cptr kp0=shm3+LDS_K+hi*1024+r32*16; const lds_cptr vp0=shm3+LDS_V+((lane>>4)&1)*32+(lane&3)*8+(4*hi+((lane&15)>>2))*64;
  const lds_fptr clh=(lds_fptr)(shm3+LDS_C)+4*hi;
  const int NT=(q0+QB)/KVBLK;
  DMA_K(0,0);DMA_V(0,0);DMA_K(1,SLOTB);
  bf16x8 qr[4];
  #pragma unroll
  for(int d0=0;d0<4;++d0)qr[d0]=*reinterpret_cast<const bf16x8*>(&Qw[(long)r32*DM+d0*16+hi*8]);
  float mhat=0.f,l_reg=0.f;f32x16 o[2];o[0]=f32x16{};o[1]=f32x16{};
  const int qrel=wid*QBLK+r32;
  const float cq2=((lds_fptr)(shm3+LDS_C))[q0+qrel];
  #define CMASK(P0,P1,t) do{int jb_=(t)-(NT-4); if(jb_>=0)cmask(P0,P1,jb_,qrel,hi);}while(0)
  #define CINIT(P0,P1,tt,basev_) do{ _Pragma("unroll") for(int g_=0;g_<4;++g_){ const f32x4 a_=*(const __attribute__((address_space(3))) f32x4*)(clh+64*(tt)+8*g_); const f32x4 b_=*(const __attribute__((address_space(3))) f32x4*)(clh+64*(tt)+32+8*g_); \
      _Pragma("unroll") for(int j_=0;j_<4;++j_){ P0[4*g_+j_]=(basev_)-a_[j_]; P1[4*g_+j_]=(basev_)-b_[j_]; } } }while(0)
  bool resc=false;
  #define START(P0,P1) do{ const float rm=rowmax(P0,P1); resc=false; \
    { const float dl=rm; mhat=fadd_s(mhat,dl); \
      _Pragma("unroll") for(int r=0;r<16;++r){P0[r]=fsub_s(P0[r],dl);P1[r]=fsub_s(P1[r],dl);} } \
    _Pragma("unroll") for(int r=0;r<16;++r)P0[r]=__builtin_amdgcn_exp2f(P0[r]); }while(0)
  #define RESC() do{ if(resc){ asm volatile("s_waitcnt lgkmcnt(0)":::"memory"); \
      _Pragma("unroll") for(int d_=0;d_<2;++d_) _Pragma("unroll") for(int r=0;r<16;++r)o[d_][r]*=wsf[crow(r,hi)]; } }while(0)
  f32x16 pA0,pA1,pB0,pB1;
  int sl_prev=0,sl_cur=0,sl_next=SLOTB;
  #define ROT() do{sl_prev=sl_cur;sl_cur=sl_next;sl_next=(sl_next==(NSLOT-1)*SLOTB)?0:sl_next+SLOTB;}while(0)
  DMA_K(2,2*SLOTB);
  CINIT(pA0,pA1,0,cq2);
  WAIT_BAR(3);
  qkt(pA0,pA1,Kbase,qr,r32,hi);asm volatile("s_nop 15\n\ts_nop 7":"+v"(pA0),"+v"(pA1));CMASK(pA0,pA1,0);
  START(pA0,pA1);
  _Pragma("unroll") for(int r=0;r<16;++r)pA1[r]=__builtin_amdgcn_exp2f(pA1[r]);
  { const float bv0=cq2-mhat; CINIT(pB0,pB1,1,bv0); }
  WAIT_BAR(0);
  DMA_K(3,0);DMA_V(1,SLOTB);
  ROT();
  kload8(kf,kp0+sl_cur);
  WAIT_BAR(2);
  s16x4 vlo[8],vhi[8]; u32x4 pw0,pw1,pw2,pw3;
  #define PKW(P,B) cvtpk_s(P[B],P[B+1])
  #define PAF(k) __builtin_bit_cast(bf16x8,pw##k)
  #define VFR(i) (bf16x8){vlo[i][0],vlo[i][1],vlo[i][2],vlo[i][3],vhi[i][0],vhi[i][1],vhi[i][2],vhi[i][3]}
  #define PIN(x) asm volatile("":"+v"(x))
  #define MX3(a,b,c) __builtin_fmaxf(__builtin_fmaxf((a),(b)),(c))
  #define GAPA(MF,A0,A1,A2,A3,W0,W1,PW) do{ MF; sacc+=A0; sacc+=A1; sacc+=A2; sacc+=A3; PIN(sacc); W0; W1; PIN(PW); SBAR(); }while(0)
  #define EX(v) __builtin_amdgcn_exp2f(v)
  #define CKRD(i) (*(const __attribute__((address_space(3))) f32x4*)(clt_+(((i)>>2)*32+((i)&3)*8)))
  #define GAPB(MF,X,B,PN,G,IROW) do{ const f32x4 ck_=CKRD(IROW); MF; X[B]=EX(X[B]); X[B+1]=EX(X[B+1]); X[B+2]=EX(X[B+2]); X[B+3]=EX(X[B+3]); PIN(X); \
      PN[4*(G)]=basev-ck_[0]; PN[4*(G)+1]=basev-ck_[1]; PN[4*(G)+2]=basev-ck_[2]; PN[4*(G)+3]=basev-ck_[3]; PIN(PN); SBAR(); }while(0)
  #define VRD(i) do{ vlo[i]=vtr(vp_+(((i)>>2)*4096+((i)&3)*1024)); vhi[i]=vtr(vp_+(((i)>>2)*4096+((i)&3)*1024+512)); }while(0)
  #define KRD(G,j) do{ if(G){ kload2(kf,kp0+sl_next,j); SBAR(); } }while(0)
  #define STEP(C0,C1,P0,P1,t,GK,GV,GL) do{ SBAR(); \
    const lds_cptr vp_=vp0+sl_prev; const lds_fptr clt_=clh+64*((t)+1); \
    VRD(0); SBAR(); float sacc=(P0[0]+P0[1]); \
    GAPA(C0=__builtin_amdgcn_mfma_f32_32x32x16_bf16(kf[0],qr[0],C0,0,0,0), P0[2],P0[3],P0[4],P0[5],     pw0[0]=PKW(P0,0), pw0[1]=PKW(P0,2), pw0); \
    VRD(4); SBAR(); GAPA(C1=__builtin_amdgcn_mfma_f32_32x32x16_bf16(kf[1],qr[0],C1,0,0,0), P0[6],P0[7],P0[8],P0[9],     pw0[2]=PKW(P0,4), pw0[3]=PKW(P0,6), pw0); \
    VRD(1); SBAR(); GAPA(C0=__builtin_amdgcn_mfma_f32_32x32x16_bf16(kf[2],qr[1],C0,0,0,0),   P0[10],P0[11],P0[12],P0[13], pw1[0]=PKW(P0,8), pw1[1]=PKW(P0,10), pw1); \
    VRD(5); SBAR(); GAPA(C1=__builtin_amdgcn_mfma_f32_32x32x16_bf16(kf[3],qr[1],C1,0,0,0),   P0[14],P0[15],P1[0],P1[1],   pw1[2]=PKW(P0,12),pw1[3]=PKW(P0,14), pw1); \
    VRD(2); SBAR(); GAPA(C0=__builtin_amdgcn_mfma_f32_32x32x16_bf16(kf[4],qr[2],C0,0,0,0),   P1[2],P1[3],P1[4],P1[5],     pw2[0]=PKW(P1,0), pw2[1]=PKW(P1,2), pw2); \
    VRD(6); SBAR(); GAPA(C1=__builtin_amdgcn_mfma_f32_32x32x16_bf16(kf[5],qr[2],C1,0,0,0),   P1[6],P1[7],P1[8],P1[9],     pw2[2]=PKW(P1,4), pw2[3]=PKW(P1,6), pw2); \
    VRD(3); SBAR(); GAPA(C0=__builtin_amdgcn_mfma_f32_32x32x16_bf16(kf[6],qr[3],C0,0,0,0),   P1[10],P1[11],P1[12],P1[13], pw3[0]=PKW(P1,8), pw3[1]=PKW(P1,10), pw3); \
    VRD(7); SBAR(); GAPA(C1=__builtin_amdgcn_mfma_f32_32x32x16_bf16(kf[7],qr[3],C1,0,0,0),   P1[14],P1[15],0.f,0.f,       pw3[2]=PKW(P1,12),pw3[3]=PKW(P1,14), pw3); \
    l_reg+=sacc; \
    if(GK){DMA_K((t)+3,sl_cur);} if(GV){DMA_V((t)+1,sl_next);} \
    CMASK(C0,C1,t); \
    { float a=MX3(C0[0],C0[1],C1[0]),b=MX3(C0[2],C0[3],C1[1]); a=MX3(a,C1[2],C1[3]); \
      _Pragma("unroll") for(int r=4;r<16;r+=4){a=MX3(a,C0[r],C0[r+1]);b=MX3(b,C0[r+2],C0[r+3]);a=MX3(a,C1[r],C1[r+1]);b=MX3(b,C1[r+2],C1[r+3]);} \
      float rm=__builtin_fmaxf(a,b); { auto rr=__builtin_amdgcn_permlane32_swap(__float_as_uint(rm),__float_as_uint(rm),false,false); rm=__builtin_fmaxf(__uint_as_float(rr[0]),__uint_as_float(rr[1])); } \
      resc=false; \
      if(__builtin_expect(__any(rm>(float)THRL),0)){ const float dl=__builtin_fmaxf(rm,0.f); mhat+=dl; \
        _Pragma("unroll") for(int r=0;r<16;++r){C0[r]-=dl;C1[r]-=dl;} \
        const float f=__builtin_amdgcn_exp2f(-dl); l_reg*=f; if(hi==0)wsf[r32]=f; resc=true; } } \
    const float basev=cq2-mhat; \
    SBAR(); \
    GAPB(o[0]=__builtin_amdgcn_mfma_f32_32x32x16_bf16(PAF(0),VFR(0),o[0],0,0,0), C0,0,  P0,0,0); \
    GAPB(o[1]=__builtin_amdgcn_mfma_f32_32x32x16_bf16(PAF(0),VFR(4),o[1],0,0,0), C0,4,  P0,1,1); \
    KRD(GL,0); GAPB(o[0]=__builtin_amdgcn_mfma_f32_32x32x16_bf16(PAF(1),VFR(1),o[0],0,0,0), C0,8,  P0,2,2); \
    KRD(GL,1); GAPB(o[1]=__builtin_amdgcn_mfma_f32_32x32x16_bf16(PAF(1),VFR(5),o[1],0,0,0), C0,12, P0,3,3); \
    KRD(GL,2); GAPB(o[0]=__builtin_amdgcn_mfma_f32_32x32x16_bf16(PAF(2),VFR(2),o[0],0,0,0), C1,0,  P1,0,4); \
    KRD(GL,3); GAPB(o[1]=__builtin_amdgcn_mfma_f32_32x32x16_bf16(PAF(2),VFR(6),o[1],0,0,0), C1,4,  P1,1,5); \
    GAPB(o[0]=__builtin_amdgcn_mfma_f32_32x32x16_bf16(PAF(3),VFR(3),o[0],0,0,0), C1,8,  P1,2,6); \
    GAPB(o[1]=__builtin_amdgcn_mfma_f32_32x32x16_bf16(PAF(3),VFR(7),o[1],0,0,0), C1,12, P1,3,7); \
    }while(0)
  int t=1;
  #undef CMASK
  #define CMASK(P0,P1,t) do{}while(0)
  for(;t+5<NT;t+=2){
    STEP(pB0,pB1,pA0,pA1,t,true,true,true);     WAIT_BAR(2); RESC(); ROT();
    STEP(pA0,pA1,pB0,pB1,t+1,true,true,true);   WAIT_BAR(2); RESC(); ROT();
  }
  #undef CMASK
  #define CMASK(P0,P1,t) do{int jb_=(t)-(NT-4); if(jb_>=0)cmask(P0,P1,jb_,qrel,hi);}while(0)
  #define ENDW(tt) do{ if((tt)+3<NT){WAIT_BAR(2);} else if((tt)+2<NT){WAIT_BAR(1);} else {WAIT_BAR(0);} }while(0)
  for(;t+1<NT;t+=2){
    STEP(pB0,pB1,pA0,pA1,t,(t+3<NT),(t+1<NT),(t+1<NT));       ENDW(t);   RESC(); ROT();
    STEP(pA0,pA1,pB0,pB1,t+1,(t+4<NT),(t+2<NT),(t+2<NT));     ENDW(t+1); RESC(); ROT();
  }
  STEP(pB0,pB1,pA0,pA1,NT-1,false,false,false); RESC();
  { float sacc=pB0[0]+pB0[1]; _Pragma("unroll") for(int r=2;r<16;++r)sacc+=pB0[r]; _Pragma("unroll") for(int r=0;r<16;++r)sacc+=pB1[r]; l_reg+=sacc;
    pw0=(u32x4){PKW(pB0,0),PKW(pB0,2),PKW(pB0,4),PKW(pB0,6)};pw1=(u32x4){PKW(pB0,8),PKW(pB0,10),PKW(pB0,12),PKW(pB0,14)};pw2=(u32x4){PKW(pB1,0),PKW(pB1,2),PKW(pB1,4),PKW(pB1,6)};pw3=(u32x4){PKW(pB1,8),PKW(pB1,10),PKW(pB1,12),PKW(pB1,14)};
    SBAR(); pv(o,vb0+sl_cur,PAF(0),PAF(1),PAF(2),PAF(3)); }
  #undef PKW
  #undef PAF
  #undef VFR
  #undef PIN
  #undef MX3
  #undef GAPA
  #undef GAPB
  #undef CKRD
  #undef EX
  #undef VRD
  #undef KRD
  #undef STEP
  #undef ENDW
  {auto rr=__builtin_amdgcn_permlane32_swap(__float_as_uint(l_reg),__float_as_uint(l_reg),false,false);l_reg=__uint_as_float(rr[0])+__uint_as_float(rr[1]);}
  if(hi==0)wsf[32+r32]=l_reg;asm volatile("s_waitcnt lgkmcnt(0)":::"memory");
  float rli[16];
  #pragma unroll
  for(int r=0;r<16;++r)rli[r]=__builtin_amdgcn_rcpf(wsf[32+crow(r,hi)]);
  bf16_t*Ow=O+(rowbase+q0+wid*QBLK)*OPITCH+h*DH;
  { bf16_t*stg=(bf16_t*)(shm+LDS_OST)+wid*2048;
    #pragma unroll
    for(int r=0;r<16;++r){const int orow=crow(r,hi);
      #pragma unroll
      for(int d0=0;d0<2;++d0)stg[orow*64+d0*32+r32]=f2bf(o[d0][r]*rli[r]);}
    asm volatile("s_waitcnt lgkmcnt(0)":::"memory");
    #pragma unroll
    for(int i=0;i<4;++i){const int row=i*8+(lane>>3),ch=lane&7; const u32x4 v=*(const u32x4*)(stg+row*64+ch*8); *(u32x4*)(Ow+(long)row*OPITCH+ch*8)=v;
      float ss=0.f;
      #pragma unroll
      for(int j=0;j<4;++j){ const float lo_=__builtin_bit_cast(float,v[j]<<16), hi_=__builtin_bit_cast(float,v[j]&0xffff0000u); ss+=lo_*lo_+hi_*hi_; }
      ss+=__shfl_xor(ss,1); ss+=__shfl_xor(ss,2); ss+=__shfl_xor(ss,4);
      if(ch==0)psa[(rowbase+q0+wid*QBLK+row)*8+h]=ss; } }
  asm volatile("s_waitcnt lgkmcnt(0)\n\ts_barrier":::"memory");
  #undef DMA_K
  #undef DMA_V
  #undef CMASK
  #undef CINIT
  #undef START
  #undef RESC
  #undef ROT
}
#undef SBAR
#undef WAIT_BAR
}

__device__ void s5_precompute(int g, const float* lam_re, const float* lam_im, const float* log_dt, const float* b_re, const float* b_im, const float* c_re, const float* c_im,
                              bf16_t* bth, bf16_t* bttg, float* a16, float* sm) {
    float* apr = sm; float* api = apr + 17 * 64; float* bbr = api + 17 * 64; float* bbi = bbr + 1024; float* cr = bbi + 1024; float* ci = cr + 1024; float* Kt = ci + 1024;
    const int tid = threadIdx.x;
    if (tid < 64) { const int p = tid; const float dt = __expf(log_dt[g]); const float lr = lam_re[g * NP + p], li = lam_im[g * NP + p];
        for (int tau = 0; tau <= 16; ++tau) { const float mag = __expf(lr * dt * (float)tau), ang = li * dt * (float)tau; apr[tau * 64 + p] = mag * cosf(ang); api[tau * 64 + p] = mag * sinf(ang); }
        const float abr = apr[64 + p], abi = api[64 + p], den = lr * lr + li * li, nr = abr - 1.f; const float zr = (nr * lr + abi * li) / den, zi = (abi * lr - nr * li) / den;
        for (int c = 0; c < NC; ++c) { const float br = b_re[(size_t)(g * NP + p) * NC + c], bi = b_im[(size_t)(g * NP + p) * NC + c]; bbr[p * 16 + c] = zr * br - zi * bi; bbi[p * 16 + c] = zr * bi + zi * br; }
        a16[(g * 64 + p) * 2] = apr[16 * 64 + p]; a16[(g * 64 + p) * 2 + 1] = api[16 * 64 + p]; }
    for (int i = tid; i < 1024; i += NTHR) { cr[i] = c_re[(size_t)g * 1024 + i]; ci[i] = c_im[(size_t)g * 1024 + i]; }
    __syncthreads();
    for (int idx = tid; idx < 4096; idx += NTHR) { const int tau = idx >> 8, co = (idx >> 4) & 15, cin = idx & 15; float sacc = 0.f;
        for (int p = 0; p < 64; ++p) { const float c_r = cr[co * 64 + p], c_i = ci[co * 64 + p], a_r = apr[tau * 64 + p], a_i = api[tau * 64 + p]; const float wr_ = c_r * a_r - c_i * a_i, wi_ = c_r * a_i + c_i * a_r;
            sacc += wr_ * bbr[p * 16 + cin] - wi_ * bbi[p * 16 + cin]; }
        Kt[idx] = sacc; }
    __syncthreads();
    bf16_t* tg = bttg + (size_t)g * 256 * UXP; bf16_t* hh = bth + (size_t)g * 256 * 256;
    for (int idx = tid; idx < 256 * UXP; idx += NTHR) { const int n = idx / UXP, k = idx - n * UXP, i = n >> 4, co = n & 15; float v;
        if (k < 256) { const int j = k >> 4, cin = k & 15; v = (j <= i) ? Kt[((i - j) << 8) + (co << 4) + cin] : 0.f; }
        else if (k < 320) { const int p = k - 256; v = cr[co * 64 + p] * apr[(i + 1) * 64 + p] - ci[co * 64 + p] * api[(i + 1) * 64 + p]; }
        else { const int p = k - 320; v = -(cr[co * 64 + p] * api[(i + 1) * 64 + p] + ci[co * 64 + p] * apr[(i + 1) * 64 + p]); }
        tg[idx] = f2bf(v); }
    for (int idx = tid; idx < 256 * 256; idx += NTHR) { const int n = idx >> 8, k = idx & 255, j = k >> 4, cin = k & 15; float v = 0.f;
        if (n < 64) v = apr[(15 - j) * 64 + n] * bbr[n * 16 + cin] - api[(15 - j) * 64 + n] * bbi[n * 16 + cin];
        else if (n < 128) { const int p = n - 64; v = apr[(15 - j) * 64 + p] * bbi[p * 16 + cin] + api[(15 - j) * 64 + p] * bbr[p * 16 + cin]; }
        hh[idx] = f2bf(v); }
    __syncthreads();
}

__device__ __forceinline__ int lane_now() { int l; asm volatile("v_mbcnt_lo_u32_b32 %0, -1, 0\n\tv_mbcnt_hi_u32_b32 %0, -1, %0" : "=v"(l)); return l; }

struct Params {
    const float* in[29];
    float* out;
    unsigned char* ws;
};

__device__ __forceinline__ float wave_sum(float v) {
#pragma unroll
    for (int o = 1; o < 64; o <<= 1) v += __shfl_xor(v, o);
    return v;
}
__device__ __forceinline__ float wave_max(float v) {
#pragma unroll
    for (int o = 1; o < 64; o <<= 1) v = fmaxf(v, __shfl_xor(v, o));
    return v;
}

template <class AT> __device__ void rms_rows(const AT* in, int ldi, const float* g, float* out, int ldo, int ncols, int nrows, int gw, int ngw, int lane) {
    for (int r = gw; r < nrows; r += ngw) {
        const AT* row = in + (size_t)r * ldi; float ss = 0.f;
        for (int c = lane; c < ncols; c += 64) { const float v = ldf(row, c); ss += v * v; }
        ss = wave_sum(ss);
        const float rs = rsqrtf(ss / (float)ncols + EPS);
        float* orow = out + (size_t)r * ldo;
        for (int c = lane; c < ncols; c += 64) orow[c] = ldf(row, c) * rs * g[c];
    }
}

template <class AT, bool DUAL, class RowFn, class Epi>
__device__ void gemm_tile(const AT* A, int lda, RowFn arow, const float* B, int ldb, int K, int m0, int n0, int n1, int Nmax, float* sm, Epi epi) {
    float* As = sm;
    float* Bs = sm + 16 * 132;
    float* Bs2 = Bs + 16 * 128;
    const int tid = threadIdx.x, ty = tid >> 4, tx = tid & 15;
    float acc[4][8], acc2[4][8];
#pragma unroll
    for (int i = 0; i < 4; ++i)
#pragma unroll
        for (int j = 0; j < 8; ++j) { acc[i][j] = 0.f; acc2[i][j] = 0.f; }
    const int ar = tid >> 2, ak = (tid & 3) * 4;
    const int srow = arow(m0 + ar);
    const int bk = tid >> 5, bn = (tid & 31) * 4;
    for (int k0 = 0; k0 < K; k0 += 16) {
        float a4[4];
#pragma unroll
        for (int j = 0; j < 4; ++j) a4[j] = (srow >= 0) ? ldf(A, (size_t)srow * lda + k0 + ak + j) : 0.f;
        float b4[4], c4[4];
#pragma unroll
        for (int j = 0; j < 4; ++j) { const int col = n0 + bn + j; b4[j] = (col < Nmax) ? B[(size_t)(k0 + bk) * ldb + col] : 0.f; }
        if (DUAL) {
#pragma unroll
            for (int j = 0; j < 4; ++j) c4[j] = B[(size_t)(k0 + bk) * ldb + n1 + bn + j];
        }
        __syncthreads();
#pragma unroll
        for (int j = 0; j < 4; ++j) As[(ak + j) * 132 + ar] = a4[j];
#pragma unroll
        for (int j = 0; j < 4; ++j) Bs[bk * 128 + bn + j] = b4[j];
        if (DUAL) {
#pragma unroll
            for (int j = 0; j < 4; ++j) Bs2[bk * 128 + bn + j] = c4[j];
        }
        __syncthreads();
#pragma unroll 2
        for (int kk = 0; kk < 16; ++kk) {
            float a[4], b[8];
#pragma unroll
            for (int i = 0; i < 4; ++i) a[i] = As[kk * 132 + ty * 4 + i];
#pragma unroll
            for (int j = 0; j < 8; ++j) b[j] = Bs[kk * 128 + tx * 8 + j];
#pragma unroll
            for (int i = 0; i < 4; ++i)
#pragma unroll
                for (int j = 0; j < 8; ++j) acc[i][j] += a[i] * b[j];
            if (DUAL) {
#pragma unroll
                for (int j = 0; j < 8; ++j) b[j] = Bs2[kk * 128 + tx * 8 + j];
#pragma unroll
                for (int i = 0; i < 4; ++i)
#pragma unroll
                    for (int j = 0; j < 8; ++j) acc2[i][j] += a[i] * b[j];
            }
        }
    }
    __syncthreads();
#pragma unroll
    for (int i = 0; i < 4; ++i)
#pragma unroll
        for (int j = 0; j < 8; ++j) epi(m0 + ty * 4 + i, tx * 8 + j, acc[i][j], acc2[i][j]);
}

struct RowId { __device__ int operator()(int r) const { return r; } };
struct RowTok { const int* rowtok; __device__ int operator()(int r) const { const int id = rowtok[r]; return id < 0 ? -1 : (id >> 2); } };
struct RowSlot { const int* rowtok; __device__ int operator()(int r) const { return rowtok[r] < 0 ? -1 : r; } };

__device__ __forceinline__ float sigmoidf_(float x) { return 1.f / (1.f + __expf(-x)); }

__global__ void __launch_bounds__(NTHR) fwd_naive(Params P) {
    cg::grid_group grid = cg::this_grid();
    extern __shared__ __attribute__((aligned(16))) unsigned char lds[];
    float* sm = (float*)lds;
    int* ism = (int*)(lds + 57600);
    PG8_LAS unsigned char* ldsl = (PG8_LAS unsigned char*)lds;
    const int wave_s = __builtin_amdgcn_readfirstlane((int)threadIdx.x >> 6);
#define TID_NOW() (wave_s * 64 + lane_now())
    int tid = TID_NOW(), lane = tid & 63, wave = tid >> 6;
    const int nblk = gridDim.x, blk = blockIdx.x;
    int gw = blk * NWAVE + wave; const int ngw = nblk * NWAVE;
#define REFRESH_IDS() do { tid = TID_NOW(); asm volatile("" : "+v"(tid)); lane = tid & 63; wave = tid >> 6; gw = blk * NWAVE + wave; } while (0)
    unsigned char* ws = P.ws;
    int* ctl = (int*)(ws + WS_CTL);
    float* logf_ = (float*)(ws + WS_LOGF);
    float* x1 = (float*)(ws + WS_X1);
    int* topi = (int*)(ws + WS_TOPI); float* topg = (float*)(ws + WS_TOPG);
    int* rowtok = (int*)(ws + WS_ROWTOK); float* rowgate = (float*)(ws + WS_ROWGATE);
    bf16_t* act = (bf16_t*)(ws + WS_ACT); bf16_t* Y = (bf16_t*)(ws + WS_Y);
    float* Gs = (float*)(ws + WS_GS);
    bf16_t* Win_t = (bf16_t*)(ws + WS_WIN); bf16_t* XN = (bf16_t*)(ws + WS_XN); bf16_t* QB = (bf16_t*)(ws + WS_Q);
    bf16_t* KB = QB + (size_t)T * 512; bf16_t* VB = KB + (size_t)T * 512; bf16_t* UX = (bf16_t*)(ws + WS_UX);
    bf16_t* S5H = (bf16_t*)(ws + WS_S5H); bf16_t* S5TG = (bf16_t*)(ws + WS_S5TG); float* A16 = (float*)(ws + WS_A16);
    bf16_t* Wgu_t = (bf16_t*)(ws + WS_WGU); bf16_t* Wdn_t = (bf16_t*)(ws + WS_WDN); bf16_t* X1B = (bf16_t*)(ws + WS_X1B);
    bf16_t* MIXB = (bf16_t*)(ws + WS_MIXB); float* psa = (float*)(ws + WS_PSA); float* pss = (float*)(ws + WS_PSS);
    bf16_t* GB = (bf16_t*)(ws + WS_GB); bf16_t* Wglu_t = (bf16_t*)(ws + WS_WGLU); bf16_t* Wout_t = (bf16_t*)(ws + WS_WOUT); bf16_t* Wpg_t = (bf16_t*)(ws + WS_WPG); bf16_t* Wpp_t = (bf16_t*)(ws + WS_WPP);
    bf16_t* PB = (bf16_t*)(ws + WS_PB); bf16_t* XN2 = (bf16_t*)(ws + WS_XN2); bf16_t* GSB = (bf16_t*)(ws + WS_GS);
    int* rowsrc = (int*)(ws + WS_ROWSRC); float* rowscl = (float*)(ws + WS_ROWSCL); float* r1 = (float*)(ws + WS_R1);
    const float* x = P.in[0]; const float* pin = P.in[1]; const float* norm_mix_g = P.in[2]; const float* w_in = P.in[3]; const float* b_f = P.in[4];
    const float* lam_re = P.in[5]; const float* lam_im = P.in[6]; const float* log_dt = P.in[7]; const float* b_re = P.in[8]; const float* b_im = P.in[9];
    const float* c_re = P.in[10]; const float* c_im = P.in[11]; const float* d_skip = P.in[12]; const float* w_glu = P.in[13]; const float* b_glu = P.in[14];
    const float* attn_out_g = P.in[15]; const float* ssm_out_g = P.in[16]; const float* w_out = P.in[17]; const float* norm_ffn_g = P.in[18];
    const float* w_router = P.in[19]; const float* b_router = P.in[20]; const float* w_gu = P.in[21]; const float* b_gu = P.in[22];
    const float* w_dn = P.in[23]; const float* b_dn = P.in[24]; const float* norm_ple_g = P.in[25]; const float* w_ple_gate = P.in[26];
    const float* w_ple_proj = P.in[27]; const float* norm_final_g = P.in[28];

    if (blk == 0 && tid < 128) ctl[tid] = 0;
    if (blk < NG) s5_precompute(blk, lam_re, lam_im, log_dt, b_re, b_im, c_re, c_im, S5H, S5TG, A16, sm);
    {
        PG8_LAS float* scr = (PG8_LAS float*)(ldsl + wave * 16384);
        constexpr int I_IN = 16 * 64, I_GU = NE * 16 * 64, I_DN = NE * 16 * 32, I_GLU = 8 * 16, I_OUT = 16 * 32, I_PG = 16 * 32, I_PP = 4 * 32;
        for (int it = gw; it < I_IN + I_GLU + I_OUT + I_PG + I_PP + I_GU + I_DN; it += ngw) {
            int r = it;
            if (r < I_GLU) { const int kb = r >> 4, nb = r & 15; transpose_item(w_glu, SW, kb * 64, nb * 32, nullptr, Wglu_t, SW, nb * 32, scr, lane); continue; }
            r -= I_GLU;
            if (r < I_OUT) { const int kb = r >> 5, nb = r & 31; transpose_item(w_out, D, kb * 64, nb * 32, kb < 8 ? attn_out_g : ssm_out_g - AW, Wout_t, D, nb * 32, scr, lane); continue; }
            r -= I_OUT;
            if (r < I_PG) { const int kb = r >> 5, nb = r & 31; transpose_item(w_ple_gate, D, kb * 64, nb * 32, norm_ple_g, Wpg_t, D, nb * 32, scr, lane); continue; }
            r -= I_PG;
            if (r < I_PP) { const int kb = r >> 5, nb = r & 31; transpose_item(w_ple_proj, D, kb * 64, nb * 32, nullptr, Wpp_t, PLE, nb * 32, scr, lane); continue; }
            r -= I_PP;
            if (r < I_IN) { const int kb = r >> 6, nb = r & 63, n0 = nb * 32; const int c0 = (n0 < 1536) ? n0 : n0 + 8;
                transpose_item(w_in, INW, kb * 64, c0, norm_mix_g, Win_t, D, n0, scr, lane); continue; }
            r -= I_IN;
            if (r < I_GU) {
                const int e = r >> 10, kb = (r >> 6) & 15, nb = r & 63; const int n0 = nb * 32, pn = n0 >> 8, j0 = n0 & 255;
                const int c0 = (j0 < 128) ? pn * 128 + j0 : DFF + pn * 128 + (j0 - 128);
                transpose_item(w_gu + (size_t)e * D * 2 * DFF, 2 * DFF, kb * 64, c0, norm_ffn_g, Wgu_t + (size_t)e * 2 * DFF * D, D, n0, scr, lane); continue; }
            r -= I_GU;
            { const int e = r >> 9, kb = (r >> 5) & 15, nb = r & 31;
              transpose_item(w_dn + (size_t)e * DFF * D, D, kb * 64, nb * 32, nullptr, Wdn_t + (size_t)e * D * DFF, DFF, nb * 32, scr, lane); }
        }
    }
    for (size_t i = (size_t)(blk * NTHR + tid) * 8; i < (size_t)T * PLE; i += (size_t)nblk * NTHR * 8) {
        const float4 a = *(const float4*)(pin + i), b4 = *(const float4*)(pin + i + 4);
        *(uint4*)(PB + i) = make_uint4(pk2(a.x, a.y), pk2(a.z, a.w), pk2(b4.x, b4.y), pk2(b4.z, b4.w)); }
    {
        float wf[4][4][8];
#pragma unroll
        for (int j = 0; j < 4; ++j)
#pragma unroll
            for (int i = 0; i < 4; ++i) { const int k = 256 * j + 4 * lane + i; const float gk = norm_mix_g[k]; const float4 a = *(const float4*)(w_in + (size_t)k * INW + COL_F), b4 = *(const float4*)(w_in + (size_t)k * INW + COL_F + 4);
                wf[j][i][0] = a.x * gk; wf[j][i][1] = a.y * gk; wf[j][i][2] = a.z * gk; wf[j][i][3] = a.w * gk; wf[j][i][4] = b4.x * gk; wf[j][i][5] = b4.y * gk; wf[j][i][6] = b4.z * gk; wf[j][i][7] = b4.w * gk; }
        for (int r = gw; r < T; r += ngw) {
            const float4* xr = (const float4*)(x + (size_t)r * D) + lane; float4 v[4]; float ss = 0.f;
#pragma unroll
            for (int j = 0; j < 4; ++j) { v[j] = xr[64 * j]; ss += (v[j].x * v[j].x + v[j].y * v[j].y) + (v[j].z * v[j].z + v[j].w * v[j].w); }
            ss = wave_sum(ss); const float rs = rsqrtf(ss * (1.f / D) + EPS);
            float fl[8];
#pragma unroll
            for (int h = 0; h < 8; ++h) fl[h] = 0.f;
            uint2* o8 = (uint2*)(XN + (size_t)r * D) + lane;
#pragma unroll
            for (int j = 0; j < 4; ++j) { const float a0 = v[j].x * rs, a1 = v[j].y * rs, a2 = v[j].z * rs, a3 = v[j].w * rs;
                o8[64 * j] = make_uint2(pk2(a0, a1), pk2(a2, a3));
#pragma unroll
                for (int h = 0; h < 8; ++h) fl[h] += a0 * wf[j][0][h] + a1 * wf[j][1][h] + a2 * wf[j][2][h] + a3 * wf[j][3][h]; }
            float mine = 0.f;
#pragma unroll
            for (int h = 0; h < 8; ++h) { const float sfl = wave_sum(fl[h]); if (lane == h) mine = sfl; }
            if (lane < 8) { const float z = mine + b_f[lane]; logf_[(size_t)r * 8 + lane] = fminf(z, 0.f) - log1pf(__expf(-fabsf(z))); }
        }
    }
    __syncthreads();
    grid.sync(); REFRESH_IDS();

    {
        pg8::Order So; So.init(T / 256, 2048 / 256, nblk, blk, nullptr);
        pg8::EpiQKVU E{QB, (size_t)T * 512, UX};
        pg8::gemm_phase(TID_NOW(), ldsl, (const char*)XN, (const char*)Win_t, 0, D, So, pg8::DenseRows{D}, E);
    }
    grid.sync(); REFRESH_IDS();

    {
        const int pm = (blk % 8) * (nblk / 8) + blk / 8, g = pm >> 3;
        pg8::OneUnit So{pm, g};
        pg8::EpiS5H E1{UX, A16 + g * 128};
        pg8::gemm_phase(TID_NOW(), ldsl, (const char*)UX, (const char*)S5H, (size_t)256 * 256 * 2, 256, So, pg8::DenseRows{UXP}, E1);
        pg8::EpiS5Y E2{UX, d_skip, GB};
        pg8::gemm_phase(TID_NOW(), ldsl, (const char*)UX, (const char*)S5TG, (size_t)256 * UXP * 2, UXP, So, pg8::DenseRows{UXP}, E2);
    }
    {
        const int vcu = (blk % 8) * (nblk / 8) + blk / 8, bh = vcu >> 2, sg = vcu & 3, b = bh >> 3, h = bh & 7;
        attn_body::prep_c(TID_NOW(), b, h, logf_, (char*)lds);
        for (int i = 0; i < 4; ++i) { const int qb = (i == 0) ? sg : (i == 1) ? 7 - sg : (i == 2) ? 8 + sg : 15 - sg;
            attn_body::attn_unit<8>(TID_NOW(), b, h, qb, QB, KB, VB, MIXB, psa, (char*)lds); }
    }
    grid.sync(); REFRESH_IDS();

    {
        pg8::Order So; So.init(T / 256, SW / 256, nblk, blk, nullptr);
        pg8::EpiGlu E{GB, MIXB, b_glu, pss};
        pg8::gemm_phase(TID_NOW(), ldsl, (const char*)GB, (const char*)Wglu_t, 0, SW, So, pg8::DenseRows{SW}, E);
    }
    grid.sync(); REFRESH_IDS();

    {
        pg8::Order So; So.init(T / 256, D / 256, nblk, blk, nullptr);
        pg8::EpiOut E{x, x1, X1B, psa, pss};
        pg8::gemm_phase(TID_NOW(), ldsl, (const char*)MIXB, (const char*)Wout_t, 0, D, So, pg8::DenseRows{D}, E);
    }
    grid.sync(); REFRESH_IDS();

    {
        typedef float f32x16 __attribute__((ext_vector_type(16)));
        float* Wr = sm;
        int* hist = (int*)(lds + 131072);
        for (int i = tid; i < D * NE; i += NTHR) Wr[i] = w_router[i] * norm_ffn_g[i >> 5];
        if (tid < NE) hist[tid] = 0;
        __syncthreads();
        if (wave >= 4) { for (int i = blk * 256 + (tid - 256); i < CAP; i += nblk * 256) { rowtok[i] = -1; rowgate[i] = 0.f; rowsrc[i] = 0; rowscl[i] = 0.f; } }
        else {
            const int r0 = (blk * 4 + wave) * 32, e = lane & 31, h = lane >> 5; const float* xp = x1 + (size_t)(r0 + e) * D + 4 * h;
            f32x16 acc;
#pragma unroll
            for (int r = 0; r < 16; ++r) acc[r] = 0.f;
            float ss = 0.f;
#pragma unroll 4
            for (int j = 0; j < 128; ++j) { const float4 xv = *(const float4*)(xp + 8 * j); const float* wp = Wr + (8 * j + 4 * h) * 32 + e;
                ss += (xv.x * xv.x + xv.y * xv.y) + (xv.z * xv.z + xv.w * xv.w);
                acc = __builtin_amdgcn_mfma_f32_32x32x2f32(xv.x, wp[0], acc, 0, 0, 0); acc = __builtin_amdgcn_mfma_f32_32x32x2f32(xv.y, wp[32], acc, 0, 0, 0);
                acc = __builtin_amdgcn_mfma_f32_32x32x2f32(xv.z, wp[64], acc, 0, 0, 0); acc = __builtin_amdgcn_mfma_f32_32x32x2f32(xv.w, wp[96], acc, 0, 0, 0); }
            ss += __shfl_xor(ss, 32); const float rs = rsqrtf(ss * (1.f / D) + EPS);
            if (h == 0) r1[r0 + e] = rs;
            const float bias = b_router[e];
#pragma unroll
            for (int r = 0; r < 16; ++r) { const int ri = (r & 3) + 8 * (r >> 2) + 4 * h;
                float v = acc[r] * __shfl(rs, ri) + bias; float tv[TOPK]; int ti[TOPK];
#pragma unroll
                for (int k = 0; k < TOPK; ++k) { float m = v;
#pragma unroll
                    for (int o = 1; o < 32; o <<= 1) m = fmaxf(m, __shfl_xor(m, o));
                    const unsigned long long bm = __ballot(v == m); const unsigned half = h ? (unsigned)(bm >> 32) : (unsigned)bm; const int idx = __ffs((int)half) - 1;
                    tv[k] = m; ti[k] = idx; if (e == idx) v = -INFINITY; }
                float es[TOPK], den = 0.f;
#pragma unroll
                for (int k = 0; k < TOPK; ++k) { es[k] = __expf(tv[k] - tv[0]); den += es[k]; }
                if (e < TOPK) { float gsel = es[0]; int isel = ti[0];
#pragma unroll
                    for (int k = 1; k < TOPK; ++k) if (e == k) { gsel = es[k]; isel = ti[k]; }
                    topi[(size_t)(r0 + ri) * TOPK + e] = isel; topg[(size_t)(r0 + ri) * TOPK + e] = gsel / den; atomicAdd(&hist[isel], 1); } }
        }
        __syncthreads();
        if (tid < NE) atomicAdd(&ctl[CT_COUNT + tid], hist[tid]);
    }
    grid.sync(); REFRESH_IDS();

    {
        int* lcnt = ism + 64; int* lbase = ism + 128;
        if (tid < NE) lcnt[tid] = 0;
        if (tid == 0) {
            int run = 0;
            for (int e = 0; e < NE; ++e) { ism[e] = run; const int cnt = ctl[CT_COUNT + e]; run += (cnt + MB - 1) / MB * MB; }
            ism[NE] = run;
            if (blk == 0) {
                for (int e = 0; e <= NE; ++e) ctl[CT_PADSTART + e] = ism[e];
                ctl[CT_NTILES] = run / MB;
                for (int e = 0; e < NE; ++e) for (int tt = ism[e] / MB; tt < ism[e + 1] / MB; ++tt) ctl[CT_TILEEXP + tt] = e;
            }
        }
        __syncthreads();
        const int i = blk * NTHR + tid; const int e = topi[i]; const int rank = atomicAdd(&lcnt[e], 1);
        __syncthreads();
        if (tid < NE) lbase[tid] = atomicAdd(&ctl[CT_CURSOR + tid], lcnt[tid]);
        __syncthreads();
        const int slot = ism[e] + lbase[e] + rank;
        rowtok[slot] = i; rowgate[slot] = topg[i]; rowsrc[slot] = i >> 2; rowscl[slot] = r1[i >> 2];
    }
    grid.sync(); REFRESH_IDS();

    {
        pg8::Order So; So.init(ctl[CT_NTILES], 2 * DFF / 256, nblk, blk, ctl + CT_TILEEXP);
        pg8::EpiSwiglu E{act, b_gu, rowscl};
        pg8::gemm_phase(TID_NOW(), ldsl, (const char*)X1B, (const char*)Wgu_t, (size_t)2 * DFF * D * 2, D, So, pg8::GatherRows{rowsrc, D}, E);
    }
    grid.sync(); REFRESH_IDS();

    {
        pg8::Order So; So.init(ctl[CT_NTILES], D / 256, nblk, blk, ctl + CT_TILEEXP);
        pg8::EpiScatter E{Y, b_dn, rowtok, rowgate};
        pg8::gemm_phase(TID_NOW(), ldsl, (const char*)act, (const char*)Wdn_t, (size_t)D * DFF * 2, DFF, So, pg8::DenseRows{DFF}, E);
    }
    grid.sync(); REFRESH_IDS();

    for (int r = gw; r < T; r += ngw) {
        float4* xr = (float4*)(x1 + (size_t)r * D) + lane; float4 v[4]; float ss = 0.f;
#pragma unroll
        for (int j = 0; j < 4; ++j) { v[j] = xr[64 * j];
#pragma unroll
            for (int k = 0; k < TOPK; ++k) { const uint2 y = *((const uint2*)(Y + ((size_t)r * TOPK + k) * D) + lane + 64 * j);
                v[j].x += __builtin_bit_cast(float, y.x << 16); v[j].y += __builtin_bit_cast(float, y.x & 0xffff0000u); v[j].z += __builtin_bit_cast(float, y.y << 16); v[j].w += __builtin_bit_cast(float, y.y & 0xffff0000u); }
            xr[64 * j] = v[j]; ss += (v[j].x * v[j].x + v[j].y * v[j].y) + (v[j].z * v[j].z + v[j].w * v[j].w); }
        ss = wave_sum(ss); const float rs = rsqrtf(ss * (1.f / D) + EPS);
        uint2* o8 = (uint2*)(XN2 + (size_t)r * D) + lane;
#pragma unroll
        for (int j = 0; j < 4; ++j) o8[64 * j] = make_uint2(pk2(v[j].x * rs, v[j].y * rs), pk2(v[j].z * rs, v[j].w * rs));
    }
    grid.sync(); REFRESH_IDS();

    {
        pg8::Order So; So.init(T / 256, D / 256, nblk, blk, nullptr);
        pg8::EpiGate E1{GSB};
        pg8::gemm_phase(TID_NOW(), ldsl, (const char*)XN2, (const char*)Wpg_t, 0, D, So, pg8::DenseRows{D}, E1);
        pg8::EpiPle E2{GSB, x1};
        pg8::gemm_phase(TID_NOW(), ldsl, (const char*)PB, (const char*)Wpp_t, 0, PLE, So, pg8::DenseRows{PLE}, E2);
    }
    grid.sync(); REFRESH_IDS();

    for (int r = gw; r < T; r += ngw) {
        const float4* xr = (const float4*)(x1 + (size_t)r * D) + lane; float4 v[4]; float ss = 0.f;
#pragma unroll
        for (int j = 0; j < 4; ++j) { v[j] = xr[64 * j]; ss += (v[j].x * v[j].x + v[j].y * v[j].y) + (v[j].z * v[j].z + v[j].w * v[j].w); }
        ss = wave_sum(ss); const float rs = rsqrtf(ss * (1.f / D) + EPS);
        float4* orow = (float4*)(P.out + (size_t)r * D) + lane;
#pragma unroll
        for (int j = 0; j < 4; ++j) { const float4 g4 = ((const float4*)norm_final_g)[lane + 64 * j]; orow[64 * j] = make_float4(v[j].x * rs * g4.x, v[j].y * rs * g4.y, v[j].z * rs * g4.z, v[j].w * rs * g4.w); }
    }
}

extern "C" void kernel_launch(void* const* d_in, const int* in_sizes, int n_in, void* d_out, int out_size, void* d_ws, size_t ws_size, hipStream_t stream) {
    static int grid = 0;
    if (grid == 0) {
        int dev = 0, cus = 0, per_cu = 0;
        (void)hipGetDevice(&dev);
        (void)hipDeviceGetAttribute(&cus, hipDeviceAttributeMultiprocessorCount, dev);
        if (hipFuncSetAttribute((const void*)fwd_naive, hipFuncAttributeMaxDynamicSharedMemorySize, LDS_BYTES) != hipSuccess) fprintf(stderr, "kernel_launch: hipFuncSetAttribute failed\n");
        (void)hipOccupancyMaxActiveBlocksPerMultiprocessor(&per_cu, (const void*)fwd_naive, NTHR, LDS_BYTES);
        if (per_cu < 1) { fprintf(stderr, "kernel_launch: occupancy query says %d blocks per CU\n", per_cu); per_cu = 1; }
        grid = cus;
        if (n_in != 29 || ws_size < WS_END) { fprintf(stderr, "kernel_launch: unexpected n_in %d or ws_size %zu\n", n_in, ws_size); }
    }
    Params p{};
    for (int i = 0; i < 29; ++i) p.in[i] = (const float*)d_in[i];
    p.out = (float*)d_out; p.ws = (unsigned char*)d_ws;
    void* args[] = {&p};
    hipError_t e = hipLaunchCooperativeKernel((const void*)fwd_naive, dim3(grid), dim3(NTHR), args, LDS_BYTES, stream);
    if (e != hipSuccess) fprintf(stderr, "cooperative launch failed: %s (grid %d)\n", hipGetErrorString(e), grid);
}
```

```cpp
#include <hip/hip_runtime.h>
#include <hip/hip_cooperative_groups.h>
#include <cstdio>
#include <cstdint>
namespace cg = cooperative_groups;

constexpr int NB = 8, S = 4096, T = NB * S, D = 1024, NH = 8, HD = 64, AW = 512, SW = 512, INW = 2056;
constexpr int NG = 32, NP = 64, NC = 16, NE = 32, TOPK = 4, DFF = 1024, PLE = 256;
constexpr int COL_K = 512, COL_V = 1024, COL_F = 1536, COL_U = 1544;
constexpr float EPS = 1e-5f;
constexpr int NTHR = 512, NWAVE = 8;
constexpr int MB = 256;
constexpr int CAP = T * TOPK + NE * MB;
constexpr int MAXTILES = CAP / MB;
constexpr int LDS_BYTES = 147456;

typedef unsigned short bf16_t;
template <int M> __device__ __forceinline__ float swz_xor(float v) { return __builtin_bit_cast(float, __builtin_amdgcn_ds_swizzle(__builtin_bit_cast(int, v), (M << 10) | 0x1f)); }
__device__ __forceinline__ float xhalf_sum(float v) { unsigned a = __builtin_bit_cast(unsigned, v), b = a; asm volatile("" : "+v"(b));
    auto rr = __builtin_amdgcn_permlane32_swap(a, b, false, false); unsigned r0 = rr[0], r1 = rr[1]; asm volatile("" : "+v"(r0), "+v"(r1));
    return __builtin_bit_cast(float, r0) + __builtin_bit_cast(float, r1); }
__device__ __forceinline__ float bperm(float v, int srclane) { return __builtin_bit_cast(float, __builtin_amdgcn_ds_bpermute(srclane << 2, __builtin_bit_cast(int, v))); }
__device__ __forceinline__ bf16_t f2bf(float f) { unsigned u = __builtin_bit_cast(unsigned, f); return (bf16_t)((u + 0x7fffu + ((u >> 16) & 1u)) >> 16); }
__device__ __forceinline__ float bf2f(bf16_t b) { return __builtin_bit_cast(float, (unsigned)b << 16); }
__device__ __forceinline__ unsigned pk2(float lo, float hi) { return (unsigned)f2bf(lo) | ((unsigned)f2bf(hi) << 16); }
__device__ __forceinline__ float ldf(const float* p, size_t i) { return p[i]; }
__device__ __forceinline__ float ldf(const bf16_t* p, size_t i) { return bf2f(p[i]); }

constexpr size_t MiB = 1u << 20;
constexpr size_t WS_CTL = 0;
constexpr size_t WS_WIN = 1 * MiB;
constexpr size_t WS_WGLU = 5 * MiB;
constexpr size_t WS_WOUT = 6 * MiB;
constexpr size_t WS_WPG = 8 * MiB;
constexpr size_t WS_WPP = 10 * MiB;
constexpr size_t WS_A16 = 11 * MiB;
constexpr size_t WS_S5H = 12 * MiB;
constexpr size_t WS_S5TG = 16 * MiB;
constexpr size_t WS_WDN = 22 * MiB;
constexpr size_t WS_X1 = 86 * MiB;
constexpr size_t WS_TOPI = 214 * MiB;
constexpr size_t WS_TOPG = 214 * MiB + 512 * 1024;
constexpr size_t WS_ROWTOK = 215 * MiB;
constexpr size_t WS_ROWGATE = 216 * MiB;
constexpr size_t WS_ROWSRC = 217 * MiB;
constexpr size_t WS_ROWSCL = 218 * MiB;
constexpr size_t WS_R1 = 219 * MiB;
constexpr size_t WS_PSA = 220 * MiB;
constexpr size_t WS_PSS = 221 * MiB;
constexpr size_t WS_LOGF = 222 * MiB;
constexpr size_t WS_PB = 223 * MiB;
constexpr size_t WS_A = 239 * MiB;
constexpr size_t WS_XN = WS_A;
constexpr size_t WS_Q = WS_A + 64 * MiB;
constexpr size_t WS_UX = WS_A + 160 * MiB;
constexpr size_t WS_MIXB = WS_A + 212 * MiB;
constexpr size_t WS_GB = WS_A + 276 * MiB;
constexpr size_t WS_ACT = WS_A;
constexpr size_t WS_XN2 = WS_A;
constexpr size_t WS_GS = WS_A + 64 * MiB;
constexpr size_t WS_B = WS_A + 308 * MiB;
constexpr size_t WS_WGU = WS_B;
constexpr size_t WS_X1B = WS_B + 128 * MiB;
constexpr size_t WS_Y = WS_B;
constexpr size_t WS_END = WS_B + 256 * MiB;
static_assert((size_t)CAP * 4 <= MiB && (size_t)CAP * DFF * 2 <= 272 * MiB, "list arrays fit 1 MiB each; ACT fits");
constexpr int UXP = 384;
constexpr int CT_COUNT = 0, CT_CURSOR = 64, CT_PADSTART = 128, CT_NTILES = 192, CT_TILEEXP = 256, CT_BAR = 4096;
constexpr size_t CTL_ZERO_BYTES = 65536;
constexpr int MISC_OFF = 147200;
constexpr float LOG2E = 1.4426950408889634f, C2 = 0.125f * LOG2E;

namespace pg8 {
#define PG8_LAS __attribute__((address_space(3)))
typedef short bf16x8 __attribute__((ext_vector_type(8)));
typedef float f32x4 __attribute__((ext_vector_type(4)));
typedef unsigned u32x4 __attribute__((ext_vector_type(4)));
constexpr int BM = 256, BK = 64, HALF = 128, HTB = HALF * BK * 2, STAGE_BYTES = 8 * HTB, NXCD = 8, WGM = 8;
__device__ __forceinline__ int lds_byte(int r, int c) { const int st = (r >> 4) * 2 + (c >> 5), rr = r & 15, cc = c & 31, ob = rr * 64 + cc * 2; return st * 1024 + (ob ^ (((ob >> 9) & 1) << 5)); }
__device__ __forceinline__ void stage_rc(int b, int& R, int& C) { const int st = b / 1024, sb = b % 1024, swz = sb ^ (((sb >> 9) & 1) << 5); R = (st >> 1) * 16 + swz / 64; C = (st & 1) * 32 + (swz % 64) / 2; }
__device__ __forceinline__ int perm32(int rho) { const int n = rho >> 4, i = rho & 15; return 8 * (i >> 2) + 4 * n + (i & 3); }
struct Unit { int pm, pn, e; };
struct Order {
    int nM, nN, nwg, G, c; const int* texp;
    __device__ void init(int nM_, int nN_, int G_, int c_, const int* texp_) { nM = nM_; nN = nN_; nwg = nM * nN; G = G_; c = c_; texp = texp_; }
    __device__ bool next(int i, Unit& u) const {
        const long L = (long)i * G + c; if (L >= nwg) return false;
        int wgid = (int)L; { const int q = nwg / NXCD, r = nwg % NXCD, xcd = wgid % NXCD, off = wgid / NXCD; wgid = (xcd < r ? xcd * (q + 1) : r * (q + 1) + (xcd - r) * q) + off; }
        const int nig = WGM * nN, gid = wgid / nig, fm = gid * WGM, gsz = (nM - fm) < WGM ? (nM - fm) : WGM;
        u.pm = fm + ((wgid % nig) % gsz); u.pn = (wgid % nig) / gsz; u.e = texp ? __builtin_amdgcn_readfirstlane(texp[u.pm]) : 0; return true;
    }
};
struct DenseRows { int lda; __device__ __forceinline__ unsigned rowoff(const Unit& u, int r) const { return (unsigned)(u.pm * BM + r) * (unsigned)lda; } };
struct GatherRows { const int* src; int lda; __device__ __forceinline__ unsigned rowoff(const Unit& u, int r) const { return (unsigned)src[u.pm * BM + r] * (unsigned)lda; } };
struct OneUnit { int pm, e; __device__ bool next(int i, Unit& u) const { if (i) return false; u.pm = pm; u.pn = 0; u.e = e; return true; } };
typedef float f32x2_t __attribute__((ext_vector_type(2))); typedef __bf16 bf16x2_t __attribute__((ext_vector_type(2)));
__device__ __forceinline__ unsigned cvt_pk_bf16(float lo, float hi) { f32x2_t v = {lo, hi}; bf16x2_t b = __builtin_convertvector(v, bf16x2_t); return __builtin_bit_cast(unsigned, b); }

template <class Epi, class ARow, class Sched>
__device__ __forceinline__ void gemm_phase(int tid0, PG8_LAS unsigned char* lds, const char* Abase, const char* Bbase, size_t b_estride, int K, const Sched& S, const ARow& AR, const Epi& E) {
    int tid = tid0; asm volatile("" : "+v"(tid));
    const int wid = __builtin_amdgcn_readfirstlane(tid >> 6), lane = tid & 63, wr = wid >> 2, wc = wid & 3, fr = lane & 15, fq = lane >> 4;
    const int nt = K / BK;
    int Rr[2], Cc[2]; unsigned voffB[2];
#pragma unroll
    for (int i = 0; i < 2; ++i) { int R, C; stage_rc(tid * 16 + i * 8192, R, C); const int Rb = Epi::PERM ? ((R & ~31) + perm32(R & 31)) : R; Rr[i] = R; Cc[i] = C; voffB[i] = (unsigned)(Rb * K + C) * 2u; }
    const size_t kstep = (size_t)(BK * 2), hstep = (size_t)HALF * K * 2, tstep = 2 * hstep;
    const unsigned ldsw = (unsigned)wid * 1024u;
    const int aoff = lds_byte(wr * 64 + fr, fq * 8), boff = lds_byte(wc * 32 + fr, fq * 8);
#define PG8_SA(b, h) (((b) * 2 + (h)) * HTB)
#define PG8_SB(b, h) ((4 + (b) * 2 + (h)) * HTB)
#define PG8_STAGE(bufoff, gbase, voff) do { _Pragma("unroll") for (int _i = 0; _i < 2; ++_i) \
        __builtin_amdgcn_global_load_lds((const unsigned*)((const char*)(gbase) + (voff)[_i]), (PG8_LAS unsigned*)(lds + (bufoff) + ldsw + _i * 8192), 16, 0, 0); } while (0)
#define PG8_LDA(dst, b, h) do { _Pragma("unroll") for (int m = 0; m < 4; ++m) _Pragma("unroll") for (int k = 0; k < 2; ++k) dst[m][k] = *(const PG8_LAS bf16x8*)(lds + PG8_SA(b, h) + aoff + m * 2048 + k * 1024); } while (0)
#define PG8_LDB(dst, b, h) do { _Pragma("unroll") for (int n = 0; n < 2; ++n) _Pragma("unroll") for (int k = 0; k < 2; ++k) dst[n][k] = *(const PG8_LAS bf16x8*)(lds + PG8_SB(b, h) + boff + n * 2048 + k * 1024); } while (0)
#define PG8_MMA(ai, bj, At, Bt) do { __builtin_amdgcn_s_setprio(1); _Pragma("unroll") for (int m = 0; m < 4; ++m) _Pragma("unroll") for (int n = 0; n < 2; ++n) _Pragma("unroll") for (int k = 0; k < 2; ++k) \
        acc[ai][bj][m][n] = __builtin_amdgcn_mfma_f32_16x16x32_bf16(Bt[n][k], At[m][k], acc[ai][bj][m][n], 0, 0, 0); __builtin_amdgcn_s_setprio(0); } while (0)
#define PG8_WAIT_V(n) asm volatile("s_waitcnt vmcnt(" #n ")" ::: "memory")
#define PG8_WAIT_L(n) asm volatile("s_waitcnt lgkmcnt(" #n ")" ::: "memory")
#define PG8_BAR __builtin_amdgcn_s_barrier()
#define PG8_SCHED __builtin_amdgcn_sched_barrier(0)
#define PG8_VOFF(dst, u) do { _Pragma("unroll") for (int _h = 0; _h < 2; ++_h) _Pragma("unroll") for (int _i = 0; _i < 2; ++_i) dst[_h][_i] = (AR.rowoff(u, _h * HALF + Rr[_i]) + (unsigned)Cc[_i]) * 2u; } while (0)
    Unit cur, nxt; int ui = 0;
    if (!S.next(0, cur)) return;
    f32x4 acc[2][2][4][2];
#pragma unroll
    for (int a = 0; a < 2; ++a)
#pragma unroll
        for (int b = 0; b < 2; ++b)
#pragma unroll
            for (int m = 0; m < 4; ++m)
#pragma unroll
                for (int n = 0; n < 2; ++n) acc[a][b][m][n] = (f32x4){0.f, 0.f, 0.f, 0.f};
    bf16x8 At[4][2], B0[2][2], B1[2][2];
    unsigned cvA[2][2], nvA[2][2];
    PG8_VOFF(cvA, cur);
    const char* cB = Bbase + (size_t)cur.e * b_estride + (size_t)cur.pn * tstep;
    PG8_STAGE(PG8_SB(0, 0), cB, voffB); PG8_STAGE(PG8_SB(0, 1), cB + hstep, voffB); PG8_STAGE(PG8_SA(0, 0), Abase, cvA[0]); PG8_STAGE(PG8_SA(0, 1), Abase, cvA[1]);
    if (wr == 1) PG8_BAR;
    PG8_WAIT_V(2); PG8_BAR;
    PG8_STAGE(PG8_SB(1, 0), cB + kstep, voffB); PG8_STAGE(PG8_SA(1, 0), Abase + kstep, cvA[0]); PG8_STAGE(PG8_SB(1, 1), cB + hstep + kstep, voffB);
    PG8_WAIT_V(6); PG8_BAR;
    for (;;) {
        const bool has_next = S.next(ui + 1, nxt);
        if (has_next) { PG8_VOFF(nvA, nxt); } else {
#pragma unroll
            for (int h = 0; h < 2; ++h)
#pragma unroll
                for (int i = 0; i < 2; ++i) nvA[h][i] = cvA[h][i]; }
        const char* nB = has_next ? Bbase + (size_t)nxt.e * b_estride + (size_t)nxt.pn * tstep : cB;
        for (int t = 0; t < nt; t += 2) {
            const bool last = (t == nt - 2);
            if constexpr (Epi::MID) { if (t == nt / 2) E.mid(acc, cur, wr, wc, fr, fq); }
            const char* a1 = Abase + (size_t)(t + 1) * kstep;
            const char* a2 = last ? Abase : Abase + (size_t)(t + 2) * kstep; const char* b2 = last ? nB : cB + (size_t)(t + 2) * kstep;
            const char* a3 = a2 + kstep; const char* b3 = b2 + kstep;
            unsigned v2[2][2];
#pragma unroll
            for (int h = 0; h < 2; ++h)
#pragma unroll
                for (int i = 0; i < 2; ++i) v2[h][i] = last ? nvA[h][i] : cvA[h][i];
            PG8_LDB(B0, 0, 0); PG8_LDB(B1, 0, 1); PG8_SCHED; PG8_LDA(At, 0, 0); PG8_STAGE(PG8_SA(1, 1), a1, cvA[1]);
            PG8_WAIT_V(8); PG8_WAIT_L(0); PG8_BAR; PG8_MMA(0, 0, At, B0); PG8_MMA(0, 1, At, B1); PG8_BAR; PG8_SCHED;
            PG8_LDA(At, 0, 1); PG8_STAGE(PG8_SB(0, 0), b2, voffB); PG8_STAGE(PG8_SB(0, 1), b2 + hstep, voffB); PG8_STAGE(PG8_SA(0, 0), a2, v2[0]);
            PG8_WAIT_V(8); PG8_WAIT_L(0); PG8_BAR; PG8_MMA(1, 0, At, B0); PG8_MMA(1, 1, At, B1); PG8_BAR; PG8_SCHED;
            PG8_LDB(B0, 1, 0); PG8_LDB(B1, 1, 1); PG8_SCHED; PG8_LDA(At, 1, 0); PG8_STAGE(PG8_SA(0, 1), a2, v2[1]);
            PG8_WAIT_V(8); PG8_WAIT_L(0); PG8_BAR; PG8_MMA(0, 0, At, B0); PG8_MMA(0, 1, At, B1); PG8_BAR; PG8_SCHED;
            PG8_LDA(At, 1, 1); PG8_STAGE(PG8_SB(1, 0), b3, voffB); PG8_STAGE(PG8_SB(1, 1), b3 + hstep, voffB); PG8_STAGE(PG8_SA(1, 0), a3, v2[0]);
            PG8_WAIT_V(8); PG8_WAIT_L(0); PG8_BAR; PG8_MMA(1, 0, At, B0); PG8_MMA(1, 1, At, B1); PG8_BAR; PG8_SCHED;
        }
        if (wr == 0) PG8_BAR;
        if constexpr (!Epi::AFTER) E(acc, cur, wr, wc, fr, fq);
        if (!has_next) break;
#pragma unroll
        for (int a = 0; a < 2; ++a)
#pragma unroll
            for (int b = 0; b < 2; ++b)
#pragma unroll
                for (int m = 0; m < 4; ++m)
#pragma unroll
                    for (int n = 0; n < 2; ++n) acc[a][b][m][n] = (f32x4){0.f, 0.f, 0.f, 0.f};
        cur = nxt; cB = nB; ++ui;
#pragma unroll
        for (int h = 0; h < 2; ++h)
#pragma unroll
            for (int i = 0; i < 2; ++i) cvA[h][i] = nvA[h][i];
        if (wr == 1) PG8_BAR;
    }
    PG8_WAIT_V(0);
    PG8_BAR;
    if constexpr (Epi::AFTER) E.after(acc, cur, wr, wc, fr, fq, lds);
#undef PG8_SA
#undef PG8_SB
#undef PG8_STAGE
#undef PG8_LDA
#undef PG8_LDB
#undef PG8_MMA
#undef PG8_WAIT_V
#undef PG8_WAIT_L
#undef PG8_BAR
#undef PG8_SCHED
#undef PG8_VOFF
}

__device__ __forceinline__ float sigm(float x) { return __builtin_amdgcn_rcpf(1.f + __builtin_amdgcn_exp2f(-1.4426950408889634f * x)); }
struct EpiSwiglu {
    static constexpr bool PERM = true, MID = false, AFTER = false;
    bf16_t* act; const float* b_gu; const float* rowscale;
    __device__ __forceinline__ void operator()(const f32x4 (&acc)[2][2][4][2], const Unit& u, int wr, int wc, int fr, int fq) const {
        const int row0 = u.pm * BM + wr * 64 + fr, col0 = u.pn * HALF + wc * 32 + 8 * fq;
        const float* bias = b_gu + (size_t)u.e * (2 * DFF) + col0;
        f32x4 bg[2], bu[2];
#pragma unroll
        for (int n = 0; n < 2; ++n) { bg[n] = *(const f32x4*)(bias + 4 * n); bu[n] = *(const f32x4*)(bias + DFF + 4 * n); }
#pragma unroll
        for (int ai = 0; ai < 2; ++ai)
#pragma unroll
            for (int m = 0; m < 4; ++m) { const int row = row0 + ai * HALF + m * 16; const float rs = rowscale[row];
                float o[8];
#pragma unroll
                for (int n = 0; n < 2; ++n)
#pragma unroll
                    for (int j = 0; j < 4; ++j) { const float g = fminf(acc[ai][0][m][n][j] * rs + bg[n][j], 7.f); const float up = fminf(fmaxf(acc[ai][1][m][n][j] * rs + bu[n][j], -7.f), 7.f);
                        o[4 * n + j] = g * sigm(1.702f * g) * (up + 1.f); }
                u32x4 w; w.x = cvt_pk_bf16(o[0], o[1]); w.y = cvt_pk_bf16(o[2], o[3]); w.z = cvt_pk_bf16(o[4], o[5]); w.w = cvt_pk_bf16(o[6], o[7]);
                *(u32x4*)(act + (size_t)row * DFF + col0) = w; }
    }
};
struct EpiScatter {
    static constexpr bool PERM = true, MID = false, AFTER = false;
    bf16_t* Y; const float* b_dn; const int* rowtok; const float* rowgate;
    __device__ __forceinline__ void operator()(const f32x4 (&acc)[2][2][4][2], const Unit& u, int wr, int wc, int fr, int fq) const {
        const int row0 = u.pm * BM + wr * 64 + fr, col0 = u.pn * BM + wc * 32 + 8 * fq;
        const float* bias = b_dn + (size_t)u.e * D + col0;
        f32x4 bv[2][2];
#pragma unroll
        for (int bj = 0; bj < 2; ++bj)
#pragma unroll
            for (int n = 0; n < 2; ++n) bv[bj][n] = *(const f32x4*)(bias + bj * HALF + 4 * n);
#pragma unroll
        for (int ai = 0; ai < 2; ++ai)
#pragma unroll
            for (int m = 0; m < 4; ++m) { const int row = row0 + ai * HALF + m * 16; const int id = rowtok[row]; const float gt = rowgate[row];
                if (id >= 0) { bf16_t* yp = Y + (size_t)id * D + col0;
#pragma unroll
                    for (int bj = 0; bj < 2; ++bj) { const f32x4 v0 = (acc[ai][bj][m][0] + bv[bj][0]) * gt, v1 = (acc[ai][bj][m][1] + bv[bj][1]) * gt;
                        u32x4 w; w.x = cvt_pk_bf16(v0[0], v0[1]); w.y = cvt_pk_bf16(v0[2], v0[3]); w.z = cvt_pk_bf16(v1[0], v1[1]); w.w = cvt_pk_bf16(v1[2], v1[3]);
                        *(u32x4*)(yp + bj * HALF) = w; } } }
    }
};
struct EpiQKVU {
    static constexpr bool PERM = true, MID = false, AFTER = false;
    bf16_t* O; size_t stride; bf16_t* ux;
    __device__ __forceinline__ void operator()(const f32x4 (&acc)[2][2][4][2], const Unit& u, int wr, int wc, int fr, int fq) const {
        const int row0 = u.pm * BM + wr * 64 + fr, t = u.pn >> 1; const float sc = (t == 0) ? C2 : 1.f;
        const int colt = (u.pn & 1) * BM + wc * 32 + 8 * fq;
        bf16_t* base = O + (size_t)t * stride + colt;
#pragma unroll
        for (int ai = 0; ai < 2; ++ai)
#pragma unroll
            for (int m = 0; m < 4; ++m) { const int row = row0 + ai * HALF + m * 16;
#pragma unroll
                for (int bj = 0; bj < 2; ++bj) { const f32x4 v0 = acc[ai][bj][m][0] * sc, v1 = acc[ai][bj][m][1] * sc;
                    u32x4 w; w.x = cvt_pk_bf16(v0[0], v0[1]); w.y = cvt_pk_bf16(v0[2], v0[3]); w.z = cvt_pk_bf16(v1[0], v1[1]); w.w = cvt_pk_bf16(v1[2], v1[3]);
                    if (t < 3) *(u32x4*)(base + (size_t)row * 512 + bj * HALF) = w;
                    else { const int col = colt + bj * HALF, g = col >> 4, b = row >> 12, tt = row & (S - 1);
                        *(u32x4*)(ux + ((size_t)((g * NB + b) * 256 + (tt >> 4))) * UXP + (tt & 15) * 16 + (col & 15)) = w; } } }
    }
};
struct EpiS5H {
    static constexpr bool PERM = false, MID = false, AFTER = true;
    bf16_t* ux; const float* a16;
    __device__ __forceinline__ void operator()(const f32x4 (&)[2][2][4][2], const Unit&, int, int, int, int) const {}
    __device__ __forceinline__ void after(const f32x4 (&acc)[2][2][4][2], const Unit& u, int wr, int wc, int fr, int fq, PG8_LAS unsigned char* lds) const {
        PG8_LAS float* Sx = (PG8_LAS float*)lds;
        const int row0 = wr * 64 + fr, col0 = wc * 32 + 4 * fq;
#pragma unroll
        for (int ai = 0; ai < 2; ++ai)
#pragma unroll
            for (int m = 0; m < 4; ++m)
#pragma unroll
                for (int n = 0; n < 2; ++n) *(PG8_LAS f32x4*)(Sx + (row0 + ai * HALF + m * 16) * 128 + col0 + n * 16) = acc[ai][0][m][n];
        asm volatile("s_waitcnt lgkmcnt(0)" ::: "memory"); __builtin_amdgcn_s_barrier(); asm volatile("" ::: "memory");
        int tq = (wr * 4 + wc) * 64 + fq * 16 + fr; asm volatile("" : "+v"(tq));
        if (tq < 64) {
            const int p = tq; const float ar = a16[2 * p], ai_ = a16[2 * p + 1]; float xr = 0.f, xi = 0.f;
            bf16_t* urow = ux + (size_t)u.pm * 256 * UXP + 256;
            urow[p] = 0; urow[64 + p] = 0;
#pragma unroll 8
            for (int c = 0; c < 255; ++c) { const float sr = Sx[c * 128 + p], si = Sx[c * 128 + 64 + p];
                const float nxr = ar * xr - ai_ * xi + sr, nxi = ar * xi + ai_ * xr + si; xr = nxr; xi = nxi;
                urow[(size_t)(c + 1) * UXP + p] = f2bf(xr); urow[(size_t)(c + 1) * UXP + 64 + p] = f2bf(xi); }
            asm volatile("s_waitcnt vmcnt(0)" ::: "memory");
        }
        asm volatile("s_waitcnt lgkmcnt(0)" ::: "memory"); __builtin_amdgcn_s_barrier(); asm volatile("" ::: "memory");
    }
};
struct EpiS5Y {
    static constexpr bool PERM = true, MID = false, AFTER = false;
    const bf16_t* ux; const float* d_skip; bf16_t* G;
    __device__ __forceinline__ void operator()(const f32x4 (&acc)[2][2][4][2], const Unit& u, int wr, int wc, int fr, int fq) const {
        const int row0 = wr * 64 + fr, g = u.e, b = u.pm & 7, co0 = 8 * (fq & 1);
        const f32x4 d0 = *(const f32x4*)(d_skip + g * 16 + co0), d1 = *(const f32x4*)(d_skip + g * 16 + co0 + 4);
#pragma unroll
        for (int ai = 0; ai < 2; ++ai)
#pragma unroll
            for (int m = 0; m < 4; ++m) { const int c = row0 + ai * HALF + m * 16;
#pragma unroll
                for (int bj = 0; bj < 2; ++bj) { const int ncol = bj * HALF + wc * 32 + 8 * fq, i = ncol >> 4;
                    const u32x4 uv = *(const u32x4*)(ux + ((size_t)u.pm * 256 + c) * UXP + ncol); float o[8];
#pragma unroll
                    for (int n = 0; n < 2; ++n)
#pragma unroll
                        for (int j = 0; j < 4; ++j) { const unsigned w = uv[2 * n + (j >> 1)]; const float uu = __builtin_bit_cast(float, (j & 1) ? (w & 0xffff0000u) : (w << 16));
                            const float y = acc[ai][bj][m][n][j] + (n ? d1[j] : d0[j]) * uu; o[4 * n + j] = y * sigm(1.5957691216057308f * (y + 0.044715f * y * y * y)); }
                    u32x4 w; w.x = cvt_pk_bf16(o[0], o[1]); w.y = cvt_pk_bf16(o[2], o[3]); w.z = cvt_pk_bf16(o[4], o[5]); w.w = cvt_pk_bf16(o[6], o[7]);
                    *(u32x4*)(G + ((size_t)b * S + c * 16 + i) * SW + g * 16 + co0) = w; } }
    }
};
struct EpiGlu {
    static constexpr bool PERM = true, MID = false, AFTER = false;
    const bf16_t* G; bf16_t* mixb; const float* b_glu; float* pss;
    __device__ __forceinline__ void operator()(const f32x4 (&acc)[2][2][4][2], const Unit& u, int wr, int wc, int fr, int fq) const {
        const int row0 = u.pm * BM + wr * 64 + fr, col0 = u.pn * BM + wc * 32 + 8 * fq;
        f32x4 bv[2][2];
#pragma unroll
        for (int bj = 0; bj < 2; ++bj)
#pragma unroll
            for (int n = 0; n < 2; ++n) bv[bj][n] = *(const f32x4*)(b_glu + col0 + bj * HALF + 4 * n);
#pragma unroll
        for (int ai = 0; ai < 2; ++ai)
#pragma unroll
            for (int m = 0; m < 4; ++m) { const int row = row0 + ai * HALF + m * 16; float ss = 0.f;
#pragma unroll
                for (int bj = 0; bj < 2; ++bj) { const u32x4 gv = *(const u32x4*)(G + (size_t)row * SW + col0 + bj * HALF); float o[8];
#pragma unroll
                    for (int n = 0; n < 2; ++n)
#pragma unroll
                        for (int j = 0; j < 4; ++j) { const unsigned w = gv[2 * n + (j >> 1)]; const float g = __builtin_bit_cast(float, (j & 1) ? (w & 0xffff0000u) : (w << 16));
                            const float v = g * sigm(acc[ai][bj][m][n][j] + bv[bj][n][j]); o[4 * n + j] = v; ss += v * v; }
                    u32x4 w; w.x = cvt_pk_bf16(o[0], o[1]); w.y = cvt_pk_bf16(o[2], o[3]); w.z = cvt_pk_bf16(o[4], o[5]); w.w = cvt_pk_bf16(o[6], o[7]);
                    *(u32x4*)(mixb + (size_t)row * D + AW + col0 + bj * HALF) = w; }
                ss += swz_xor<16>(ss); ss = xhalf_sum(ss);
                if (fq == 0) pss[(size_t)row * 8 + u.pn * 4 + wc] = ss; }
    }
};
struct EpiOut {
    static constexpr bool PERM = false, MID = true, AFTER = false;
    const float* x; float* x1; bf16_t* x1b; const float* psa; const float* pss;
    __device__ __forceinline__ float rsum8(const float* p) const { const f32x4 a = *(const f32x4*)p, b = *(const f32x4*)(p + 4); return ((a[0] + a[1]) + (a[2] + a[3])) + ((b[0] + b[1]) + (b[2] + b[3])); }
    __device__ __forceinline__ void mid(f32x4 (&acc)[2][2][4][2], const Unit& u, int wr, int wc, int fr, int fq) const {
        int row0 = u.pm * BM + wr * 64 + fr; asm volatile("" : "+v"(row0));
#pragma unroll
        for (int ai = 0; ai < 2; ++ai)
#pragma unroll
            for (int m = 0; m < 4; ++m) { const int row = row0 + ai * HALF + m * 16;
                const float ra = rsqrtf(rsum8(psa + (size_t)row * 8) * (1.f / AW) + EPS), rs = rsqrtf(rsum8(pss + (size_t)row * 8) * (1.f / SW) + EPS); const float f = ra / rs;
#pragma unroll
                for (int bj = 0; bj < 2; ++bj)
#pragma unroll
                    for (int n = 0; n < 2; ++n) acc[ai][bj][m][n] *= f;
                asm volatile("" ::: "memory"); }
    }
    __device__ __forceinline__ void operator()(const f32x4 (&acc)[2][2][4][2], const Unit& u, int wr, int wc, int fr, int fq) const {
        int row0 = u.pm * BM + wr * 64 + fr; asm volatile("" : "+v"(row0)); const int col0 = u.pn * BM + wc * 32 + 4 * fq;
#pragma unroll
        for (int ai = 0; ai < 2; ++ai)
#pragma unroll
            for (int m = 0; m < 4; ++m) { const int row = row0 + ai * HALF + m * 16; const float rs = rsqrtf(rsum8(pss + (size_t)row * 8) * (1.f / SW) + EPS); const size_t off = (size_t)row * D + col0;
#pragma unroll
                for (int bj = 0; bj < 2; ++bj)
#pragma unroll
                    for (int n = 0; n < 2; ++n) { const size_t o2 = off + bj * HALF + n * 16; const f32x4 v = *(const f32x4*)(x + o2) + acc[ai][bj][m][n] * rs;
                        *(f32x4*)(x1 + o2) = v; uint2 w; w.x = cvt_pk_bf16(v[0], v[1]); w.y = cvt_pk_bf16(v[2], v[3]); *(uint2*)(x1b + o2) = w; }
                asm volatile("" ::: "memory"); }
    }
};
struct EpiGate {
    static constexpr bool PERM = false, MID = false, AFTER = false;
    bf16_t* gs;
    __device__ __forceinline__ void operator()(const f32x4 (&acc)[2][2][4][2], const Unit& u, int wr, int wc, int fr, int fq) const {
        const int row0 = u.pm * BM + wr * 64 + fr, col0 = u.pn * BM + wc * 32 + 4 * fq;
#pragma unroll
        for (int ai = 0; ai < 2; ++ai)
#pragma unroll
            for (int m = 0; m < 4; ++m) { const size_t off = (size_t)(row0 + ai * HALF + m * 16) * D + col0;
#pragma unroll
                for (int bj = 0; bj < 2; ++bj)
#pragma unroll
                    for (int n = 0; n < 2; ++n) { const f32x4 a = acc[ai][bj][m][n]; uint2 w; w.x = cvt_pk_bf16(sigm(a[0]), sigm(a[1])); w.y = cvt_pk_bf16(sigm(a[2]), sigm(a[3])); *(uint2*)(gs + off + bj * HALF + n * 16) = w; } }
    }
};
struct EpiPle {
    static constexpr bool PERM = false, MID = false, AFTER = false;
    const bf16_t* gs; float* x2;
    __device__ __forceinline__ void operator()(const f32x4 (&acc)[2][2][4][2], const Unit& u, int wr, int wc, int fr, int fq) const {
        const int row0 = u.pm * BM + wr * 64 + fr, col0 = u.pn * BM + wc * 32 + 4 * fq;
#pragma unroll
        for (int ai = 0; ai < 2; ++ai)
#pragma unroll
            for (int m = 0; m < 4; ++m) { const size_t off = (size_t)(row0 + ai * HALF + m * 16) * D + col0;
#pragma unroll
                for (int bj = 0; bj < 2; ++bj)
#pragma unroll
                    for (int n = 0; n < 2; ++n) { const size_t o2 = off + bj * HALF + n * 16;
                        const unsigned long long gw_ = __hip_atomic_load((const unsigned long long*)(gs + o2), __ATOMIC_RELAXED, __HIP_MEMORY_SCOPE_AGENT);
                        const unsigned lo = (unsigned)gw_, hi = (unsigned)(gw_ >> 32);
                        f32x4 g; g[0] = __builtin_bit_cast(float, lo << 16); g[1] = __builtin_bit_cast(float, lo & 0xffff0000u); g[2] = __builtin_bit_cast(float, hi << 16); g[3] = __builtin_bit_cast(float, hi & 0xffff0000u);
                        *(f32x4*)(x2 + o2) = *(const f32x4*)(x2 + o2) + g * acc[ai][bj][m][n]; } }
    }
};
}

__device__ __forceinline__ void transpose_item(const float* W, int ldw, int k0, int c0, const float* kscale, bf16_t* WT, int K, int r0, __attribute__((address_space(3))) float* scr, int lane) {
#pragma unroll 8
    for (int i = 0; i < 32; ++i) { const int kk = 2 * i + (lane >> 5); float v = W[(size_t)(k0 + kk) * ldw + c0 + (lane & 31)]; if (kscale) v *= kscale[k0 + kk]; scr[kk * 33 + (lane & 31)] = v; }
    __builtin_amdgcn_s_waitcnt(0xC07F); asm volatile("" ::: "memory");
    const int c = lane & 7;
#pragma unroll
    for (int j = 0; j < 4; ++j) { const int n = (lane >> 3) + 8 * j; const __attribute__((address_space(3))) float* s = scr + (8 * c) * 33 + n;
        uint4 o; o.x = pk2(s[0 * 33], s[1 * 33]); o.y = pk2(s[2 * 33], s[3 * 33]); o.z = pk2(s[4 * 33], s[5 * 33]); o.w = pk2(s[6 * 33], s[7 * 33]);
        *(uint4*)(WT + (size_t)(r0 + n) * K + k0 + 8 * c) = o; }
    __builtin_amdgcn_s_waitcnt(0xC07F); asm volatile("" ::: "memory");
}


namespace attn_body {
using bf16x8=__attribute__((ext_vector_type(8)))short;
using s16x4=__attribute__((ext_vector_type(4)))short;
using f32x16=__attribute__((ext_vector_type(16)))float;
using f32x4=__attribute__((ext_vector_type(4)))float;
using u32x4=__attribute__((ext_vector_type(4)))unsigned;
constexpr int SEQ=S,DH=64,DM=NH*DH,OPITCH=D;
constexpr int NW=8,QBLK=32,QB=QBLK*NW,KVBLK=64,NQB=SEQ/QB;
__device__ __forceinline__ int crow(int r,int hi){return (r&3)+8*(r>>2)+4*hi;}
#define SBAR() __builtin_amdgcn_sched_barrier(0)
__device__ __forceinline__ void cmask(f32x16&p0,f32x16&p1,int jb,int qrel,int hi){
  const float NEG=-INFINITY; int kb=64*jb+4*hi;
  #pragma unroll
  for(int r=0;r<16;++r){int kv=kb+(r&3)+8*(r>>2); if(kv>qrel)p0[r]=NEG; if(kv+32>qrel)p1[r]=NEG;}
}
constexpr int NSLOT=3, SLOTB=8192;
constexpr int LDS_K=0, LDS_V=NSLOT*SLOTB, LDS_WS=2*NSLOT*SLOTB, LDS_OST=LDS_WS+NW*64*4, LDS_C=LDS_OST+NW*4096, ATT_LDS_BYTES=LDS_C+(SEQ+64)*4;
__device__ __forceinline__ void glds16(const void*gsrc,unsigned lds_dst){unsigned keep;
  asm volatile("s_mov_b32 %0, m0\n\ts_mov_b32 m0, %2\n\ts_nop 0\n\tglobal_load_lds_dwordx4 %1, off\n\ts_mov_b32 m0, %0":"=&s"(keep):"v"(gsrc),"s"(lds_dst):"memory");}
__device__ __forceinline__ float max3f(float a,float b,float c){float r;asm("v_max3_f32 %0, %1, %2, %3":"=v"(r):"v"(a),"v"(b),"v"(c));return r;}
__device__ __forceinline__ float max2f(float a,float b){float r;asm("v_max_f32_e32 %0, %1, %2":"=v"(r):"v"(a),"v"(b));return r;}
__device__ __forceinline__ float fadd_s(float a,float b){float r;asm("v_add_f32_e32 %0, %1, %2":"=v"(r):"v"(a),"v"(b));return r;}
__device__ __forceinline__ float fsub_s(float a,float b){float r;asm("v_sub_f32_e32 %0, %1, %2":"=v"(r):"v"(a),"v"(b));return r;}
typedef float f32x2_t __attribute__((ext_vector_type(2))); typedef __bf16 bf16x2_t __attribute__((ext_vector_type(2)));
__device__ __forceinline__ unsigned cvtpk_s(float lo,float hi){f32x2_t v={lo,hi};bf16x2_t b=__builtin_convertvector(v,bf16x2_t);return __builtin_bit_cast(unsigned,b);}
#define WAIT_BAR(N) asm volatile("s_waitcnt vmcnt(" #N ") lgkmcnt(0)\n\ts_barrier":::"memory")
typedef __attribute__((address_space(3))) const char* lds_cptr;
typedef __attribute__((address_space(3))) const float* lds_fptr;
typedef short v4i16_t __attribute__((ext_vector_type(4)));
__device__ __forceinline__ void qkt(f32x16&p0,f32x16&p1,const char*Kslot,const bf16x8*qr,int r32,int hi){
  const char*kb=Kslot+hi*1024+r32*16;
  #pragma unroll
  for(int d0=0;d0<4;++d0){
    const bf16x8 b0=*reinterpret_cast<const bf16x8*>(kb+d0*2048);
    const bf16x8 b1=*reinterpret_cast<const bf16x8*>(kb+d0*2048+512);
    p0=__builtin_amdgcn_mfma_f32_32x32x16_bf16(b0,qr[d0],p0,0,0,0);p1=__builtin_amdgcn_mfma_f32_32x32x16_bf16(b1,qr[d0],p1,0,0,0);}
}
__device__ __forceinline__ void kload8(bf16x8*kf,lds_cptr kp){
  kf[0]=*(const __attribute__((address_space(3))) bf16x8*)(kp);      kf[1]=*(const __attribute__((address_space(3))) bf16x8*)(kp+512);
  kf[2]=*(const __attribute__((address_space(3))) bf16x8*)(kp+2048); kf[3]=*(const __attribute__((address_space(3))) bf16x8*)(kp+2560);
  kf[4]=*(const __attribute__((address_space(3))) bf16x8*)(kp+4096); kf[5]=*(const __attribute__((address_space(3))) bf16x8*)(kp+4608);
  kf[6]=*(const __attribute__((address_space(3))) bf16x8*)(kp+6144); kf[7]=*(const __attribute__((address_space(3))) bf16x8*)(kp+6656);
}
__device__ __forceinline__ void kload2(bf16x8*kf,lds_cptr kp,int j){ kf[2*j]=*(const __attribute__((address_space(3))) bf16x8*)(kp+j*2048); kf[2*j+1]=*(const __attribute__((address_space(3))) bf16x8*)(kp+j*2048+512); }
__device__ __forceinline__ s16x4 vtr(lds_cptr p){ return __builtin_bit_cast(s16x4,__builtin_amdgcn_ds_read_tr16_b64_v4i16((__attribute__((address_space(3))) v4i16_t*)p)); }
__device__ __forceinline__ float rowmax(const f32x16&p0,const f32x16&p1){
  float a=max3f(p0[0],p0[1],p1[0]),b=max3f(p0[2],p0[3],p1[1]);a=max3f(a,p1[2],p1[3]);
  #pragma unroll
  for(int r=4;r<16;r+=4){a=max3f(a,p0[r],p0[r+1]);b=max3f(b,p0[r+2],p0[r+3]);a=max3f(a,p1[r],p1[r+1]);b=max3f(b,p1[r+2],p1[r+3]);}
  const float m=max2f(a,b);
  auto rr=__builtin_amdgcn_permlane32_swap(__float_as_uint(m),__float_as_uint(m),false,false);
  return max2f(__uint_as_float(rr[0]),__uint_as_float(rr[1]));
}
__device__ __forceinline__ void pv(f32x16*o,int vb,bf16x8 pa0,bf16x8 pa1,bf16x8 pa2,bf16x8 pa3){
  #pragma unroll
  for(int d0=0;d0<2;++d0){s16x4 lo[4],hi[4];
    #pragma unroll
    for(int ks=0;ks<4;++ks){
      asm volatile("ds_read_b64_tr_b16 %0,%1 offset:%c2":"=&v"(lo[ks]):"v"(vb),"i"(d0*4096+ks*1024):"memory");
      asm volatile("ds_read_b64_tr_b16 %0,%1 offset:%c2":"=&v"(hi[ks]):"v"(vb),"i"(d0*4096+ks*1024+512):"memory");}
    asm volatile("s_waitcnt lgkmcnt(0)":::"memory");SBAR();
    #define PK(k) (bf16x8){lo[k][0],lo[k][1],lo[k][2],lo[k][3],hi[k][0],hi[k][1],hi[k][2],hi[k][3]}
    o[d0]=__builtin_amdgcn_mfma_f32_32x32x16_bf16(pa0,PK(0),o[d0],0,0,0);
    o[d0]=__builtin_amdgcn_mfma_f32_32x32x16_bf16(pa1,PK(1),o[d0],0,0,0);
    o[d0]=__builtin_amdgcn_mfma_f32_32x32x16_bf16(pa2,PK(2),o[d0],0,0,0);
    o[d0]=__builtin_amdgcn_mfma_f32_32x32x16_bf16(pa3,PK(3),o[d0],0,0,0);
    #undef PK
  }
}
__device__ __forceinline__ void prep_c(int tid0,int b,int h,const float*logf,char*shm){
  int tid=tid0; asm volatile("":"+v"(tid)); const int lane=tid&63,wid=tid>>6;
  float*cl=(float*)(shm+LDS_C); float*wtot=(float*)(shm+LDS_WS);
  float v[8]; float tot=0.f;
  #pragma unroll
  for(int i=0;i<8;++i){ v[i]=logf[((size_t)b*SEQ+tid*8+i)*8+h]; tot+=v[i]; }
  float incl=tot;
  #pragma unroll
  for(int o=1;o<64;o<<=1){ const float n=bperm(incl,(lane-o)&63); if(lane>=o)incl+=n; }
  if(lane==63)wtot[wid]=incl;
  __syncthreads();
  float pre=incl-tot;
  #pragma unroll
  for(int w=0;w<8;++w) if(w<wid)pre+=wtot[w];
  #pragma unroll
  for(int i=0;i<8;++i){ pre+=v[i]; cl[tid*8+i]=pre*LOG2E; }
  if(tid<64)cl[SEQ+tid]=0.f;
  __syncthreads();
}
template<int THRL> __device__ __forceinline__ void attn_unit(int tid0,int b,int h,int qb,const bf16_t*Q,const bf16_t*__restrict__ K,const bf16_t*__restrict__ V,bf16_t*O,float*psa,char*shm){
  int tid=tid0; asm volatile("":"+v"(tid)); const int lane=tid&63,r32=lane&31,hi=lane>>5; const int wid=__builtin_amdgcn_readfirstlane(tid>>6);
  const long rowbase=(long)b*SEQ; const int q0=qb*QB;
  const bf16_t*Qw=Q+(rowbase+q0+wid*QBLK)*DM+h*DH;
  const bf16_t*Kh=K+rowbase*DM+h*DH,*Vh=V+rowbase*DM+h*DH;
  const unsigned lds0=(unsigned)(uintptr_t)shm;
  float*wsf=(float*)(shm+LDS_WS)+wid*64;
  const bf16_t*ksrc=Kh+(long)lane*DM+wid*8;
  const bf16_t*vsrc=Vh+(long)(16*(wid&3)+(lane>>2))*DM+(wid>>2)*32+(lane&3)*8;
  const unsigned kdst=lds0+LDS_K+wid*1024, vdst=lds0+LDS_V+wid*1024;
  #define DMA_K(t,slot) glds16(ksrc+(long)(t)*KVBLK*DM,(unsigned)__builtin_amdgcn_readfirstlane(kdst+(slot)))
  #define DMA_V(t,slot) glds16(vsrc+(long)(t)*KVBLK*DM,(unsigned)__builtin_amdgcn_readfirstlane(vdst+(slot)))
  const int vb0=(int)(lds0+LDS_V)+((lane>>4)&1)*32+(lane&3)*8+(4*hi+((lane&15)>>2))*64;
  const char*Kbase=shm+LDS_K; bf16x8 kf[8];
  const lds_cptr shm3=(lds_cptr)shm; const lds_cptr kp0=shm3+LDS_K+hi*1024+r32*16; const lds_cptr vp0=shm3+LDS_V+((lane>>4)&1)*32+(lane&3)*8+(4*hi+((lane&15)>>2))*64;
  const lds_fptr clh=(lds_fptr)(shm3+LDS_C)+4*hi;
  const int NT=(q0+QB)/KVBLK;
  DMA_K(0,0);DMA_V(0,0);DMA_K(1,SLOTB);
  bf16x8 qr[4];
  #pragma unroll
  for(int d0=0;d0<4;++d0)qr[d0]=*reinterpret_cast<const bf16x8*>(&Qw[(long)r32*DM+d0*16+hi*8]);
  float mhat=0.f,l_reg=0.f;f32x16 o[2];o[0]=f32x16{};o[1]=f32x16{};
  const int qrel=wid*QBLK+r32;
  const float cq2=((lds_fptr)(shm3+LDS_C))[q0+qrel];
  #define CMASK(P0,P1,t) do{int jb_=(t)-(NT-4); if(jb_>=0)cmask(P0,P1,jb_,qrel,hi);}while(0)
  #define CINIT(P0,P1,tt,basev_) do{ _Pragma("unroll") for(int g_=0;g_<4;++g_){ const f32x4 a_=*(const __attribute__((address_space(3))) f32x4*)(clh+64*(tt)+8*g_); const f32x4 b_=*(const __attribute__((address_space(3))) f32x4*)(clh+64*(tt)+32+8*g_); \
      _Pragma("unroll") for(int j_=0;j_<4;++j_){ P0[4*g_+j_]=(basev_)-a_[j_]; P1[4*g_+j_]=(basev_)-b_[j_]; } } }while(0)
  bool resc=false;
  #define START(P0,P1) do{ const float rm=rowmax(P0,P1); resc=false; \
    { const float dl=rm; mhat=fadd_s(mhat,dl); \
      _Pragma("unroll") for(int r=0;r<16;++r){P0[r]=fsub_s(P0[r],dl);P1[r]=fsub_s(P1[r],dl);} } \
    _Pragma("unroll") for(int r=0;r<16;++r)P0[r]=__builtin_amdgcn_exp2f(P0[r]); }while(0)
  #define RESC() do{ if(resc){ asm volatile("s_waitcnt lgkmcnt(0)":::"memory"); \
      _Pragma("unroll") for(int d_=0;d_<2;++d_) _Pragma("unroll") for(int r=0;r<16;++r)o[d_][r]*=wsf[crow(r,hi)]; } }while(0)
  f32x16 pA0,pA1,pB0,pB1;
  int sl_prev=0,sl_cur=0,sl_next=SLOTB;
  #define ROT() do{sl_prev=sl_cur;sl_cur=sl_next;sl_next=(sl_next==(NSLOT-1)*SLOTB)?0:sl_next+SLOTB;}while(0)
  DMA_K(2,2*SLOTB);
  CINIT(pA0,pA1,0,cq2);
  WAIT_BAR(3);
  qkt(pA0,pA1,Kbase,qr,r32,hi);asm volatile("s_nop 15\n\ts_nop 7":"+v"(pA0),"+v"(pA1));CMASK(pA0,pA1,0);
  START(pA0,pA1);
  _Pragma("unroll") for(int r=0;r<16;++r)pA1[r]=__builtin_amdgcn_exp2f(pA1[r]);
  { const float bv0=cq2-mhat; CINIT(pB0,pB1,1,bv0); }
  WAIT_BAR(0);
  DMA_K(3,0);DMA_V(1,SLOTB);
  ROT();
  kload8(kf,kp0+sl_cur);
  WAIT_BAR(2);
  s16x4 vlo[8],vhi[8]; u32x4 pw0,pw1,pw2,pw3;
  #define PKW(P,B) cvtpk_s(P[B],P[B+1])
  #define PAF(k) __builtin_bit_cast(bf16x8,pw##k)
  #define VFR(i) (bf16x8){vlo[i][0],vlo[i][1],vlo[i][2],vlo[i][3],vhi[i][0],vhi[i][1],vhi[i][2],vhi[i][3]}
  #define PIN(x) asm volatile("":"+v"(x))
  #define MX3(a,b,c) __builtin_fmaxf(__builtin_fmaxf((a),(b)),(c))
  #define GAPA(MF,A0,A1,A2,A3,W0,W1,PW) do{ MF; sacc+=A0; sacc+=A1; sacc+=A2; sacc+=A3; PIN(sacc); W0; W1; PIN(PW); SBAR(); }while(0)
  #define EX(v) __builtin_amdgcn_exp2f(v)
  #define CKRD(i) (*(const __attribute__((address_space(3))) f32x4*)(clt_+(((i)>>2)*32+((i)&3)*8)))
  #define GAPB(MF,X,B,PN,G,IROW) do{ const f32x4 ck_=CKRD(IROW); MF; X[B]=EX(X[B]); X[B+1]=EX(X[B+1]); X[B+2]=EX(X[B+2]); X[B+3]=EX(X[B+3]); PIN(X); \
      PN[4*(G)]=basev-ck_[0]; PN[4*(G)+1]=basev-ck_[1]; PN[4*(G)+2]=basev-ck_[2]; PN[4*(G)+3]=basev-ck_[3]; PIN(PN); SBAR(); }while(0)
  #define VRD(i) do{ vlo[i]=vtr(vp_+(((i)>>2)*4096+((i)&3)*1024)); vhi[i]=vtr(vp_+(((i)>>2)*4096+((i)&3)*1024+512)); }while(0)
  #define KRD(G,j) do{ if(G){ kload2(kf,kp0+sl_next,j); SBAR(); } }while(0)
  #define STEP(C0,C1,P0,P1,t,GK,GV,GL) do{ SBAR(); \
    const lds_cptr vp_=vp0+sl_prev; const lds_fptr clt_=clh+64*((t)+1); \
    VRD(0); SBAR(); float sacc=(P0[0]+P0[1]); \
    GAPA(C0=__builtin_amdgcn_mfma_f32_32x32x16_bf16(kf[0],qr[0],C0,0,0,0), P0[2],P0[3],P0[4],P0[5],     pw0[0]=PKW(P0,0), pw0[1]=PKW(P0,2), pw0); \
    VRD(4); SBAR(); GAPA(C1=__builtin_amdgcn_mfma_f32_32x32x16_bf16(kf[1],qr[0],C1,0,0,0), P0[6],P0[7],P0[8],P0[9],     pw0[2]=PKW(P0,4), pw0[3]=PKW(P0,6), pw0); \
    VRD(1); SBAR(); GAPA(C0=__builtin_amdgcn_mfma_f32_32x32x16_bf16(kf[2],qr[1],C0,0,0,0),   P0[10],P0[11],P0[12],P0[13], pw1[0]=PKW(P0,8), pw1[1]=PKW(P0,10), pw1); \
    VRD(5); SBAR(); GAPA(C1=__builtin_amdgcn_mfma_f32_32x32x16_bf16(kf[3],qr[1],C1,0,0,0),   P0[14],P0[15],P1[0],P1[1],   pw1[2]=PKW(P0,12),pw1[3]=PKW(P0,14), pw1); \
    VRD(2); SBAR(); GAPA(C0=__builtin_amdgcn_mfma_f32_32x32x16_bf16(kf[4],qr[2],C0,0,0,0),   P1[2],P1[3],P1[4],P1[5],     pw2[0]=PKW(P1,0), pw2[1]=PKW(P1,2), pw2); \
    VRD(6); SBAR(); GAPA(C1=__builtin_amdgcn_mfma_f32_32x32x16_bf16(kf[5],qr[2],C1,0,0,0),   P1[6],P1[7],P1[8],P1[9],     pw2[2]=PKW(P1,4), pw2[3]=PKW(P1,6), pw2); \
    VRD(3); SBAR(); GAPA(C0=__builtin_amdgcn_mfma_f32_32x32x16_bf16(kf[6],qr[3],C0,0,0,0),   P1[10],P1[11],P1[12],P1[13], pw3[0]=PKW(P1,8), pw3[1]=PKW(P1,10), pw3); \
    VRD(7); SBAR(); GAPA(C1=__builtin_amdgcn_mfma_f32_32x32x16_bf16(kf[7],qr[3],C1,0,0,0),   P1[14],P1[15],0.f,0.f,       pw3[2]=PKW(P1,12),pw3[3]=PKW(P1,14), pw3); \
    l_reg+=sacc; \
    if(GK){DMA_K((t)+3,sl_cur);} if(GV){DMA_V((t)+1,sl_next);} \
    CMASK(C0,C1,t); \
    { float a=MX3(C0[0],C0[1],C1[0]),b=MX3(C0[2],C0[3],C1[1]); a=MX3(a,C1[2],C1[3]); \
      _Pragma("unroll") for(int r=4;r<16;r+=4){a=MX3(a,C0[r],C0[r+1]);b=MX3(b,C0[r+2],C0[r+3]);a=MX3(a,C1[r],C1[r+1]);b=MX3(b,C1[r+2],C1[r+3]);} \
      float rm=__builtin_fmaxf(a,b); { auto rr=__builtin_amdgcn_permlane32_swap(__float_as_uint(rm),__float_as_uint(rm),false,false); rm=__builtin_fmaxf(__uint_as_float(rr[0]),__uint_as_float(rr[1])); } \
      resc=false; \
      if(__builtin_expect(__any(rm>(float)THRL),0)){ const float dl=__builtin_fmaxf(rm,0.f); mhat+=dl; \
        _Pragma("unroll") for(int r=0;r<16;++r){C0[r]-=dl;C1[r]-=dl;} \
        const float f=__builtin_amdgcn_exp2f(-dl); l_reg*=f; if(hi==0)wsf[r32]=f; resc=true; } } \
    const float basev=cq2-mhat; \
    SBAR(); \
    GAPB(o[0]=__builtin_amdgcn_mfma_f32_32x32x16_bf16(PAF(0),VFR(0),o[0],0,0,0), C0,0,  P0,0,0); \
    GAPB(o[1]=__builtin_amdgcn_mfma_f32_32x32x16_bf16(PAF(0),VFR(4),o[1],0,0,0), C0,4,  P0,1,1); \
    KRD(GL,0); GAPB(o[0]=__builtin_amdgcn_mfma_f32_32x32x16_bf16(PAF(1),VFR(1),o[0],0,0,0), C0,8,  P0,2,2); \
    KRD(GL,1); GAPB(o[1]=__builtin_amdgcn_mfma_f32_32x32x16_bf16(PAF(1),VFR(5),o[1],0,0,0), C0,12, P0,3,3); \
    KRD(GL,2); GAPB(o[0]=__builtin_amdgcn_mfma_f32_32x32x16_bf16(PAF(2),VFR(2),o[0],0,0,0), C1,0,  P1,0,4); \
    KRD(GL,3); GAPB(o[1]=__builtin_amdgcn_mfma_f32_32x32x16_bf16(PAF(2),VFR(6),o[1],0,0,0), C1,4,  P1,1,5); \
    GAPB(o[0]=__builtin_amdgcn_mfma_f32_32x32x16_bf16(PAF(3),VFR(3),o[0],0,0,0), C1,8,  P1,2,6); \
    GAPB(o[1]=__builtin_amdgcn_mfma_f32_32x32x16_bf16(PAF(3),VFR(7),o[1],0,0,0), C1,12, P1,3,7); \
    }while(0)
  int t=1;
  #undef CMASK
  #define CMASK(P0,P1,t) do{}while(0)
  for(;t+5<NT;t+=2){
    STEP(pB0,pB1,pA0,pA1,t,true,true,true);     WAIT_BAR(2); RESC(); ROT();
    STEP(pA0,pA1,pB0,pB1,t+1,true,true,true);   WAIT_BAR(2); RESC(); ROT();
  }
  #undef CMASK
  #define CMASK(P0,P1,t) do{int jb_=(t)-(NT-4); if(jb_>=0)cmask(P0,P1,jb_,qrel,hi);}while(0)
  #define ENDW(tt) do{ if((tt)+3<NT){WAIT_BAR(2);} else if((tt)+2<NT){WAIT_BAR(1);} else {WAIT_BAR(0);} }while(0)
  for(;t+1<NT;t+=2){
    STEP(pB0,pB1,pA0,pA1,t,(t+3<NT),(t+1<NT),(t+1<NT));       ENDW(t);   RESC(); ROT();
    STEP(pA0,pA1,pB0,pB1,t+1,(t+4<NT),(t+2<NT),(t+2<NT));     ENDW(t+1); RESC(); ROT();
  }
  STEP(pB0,pB1,pA0,pA1,NT-1,false,false,false); RESC();
  { float sacc=pB0[0]+pB0[1]; _Pragma("unroll") for(int r=2;r<16;++r)sacc+=pB0[r]; _Pragma("unroll") for(int r=0;r<16;++r)sacc+=pB1[r]; l_reg+=sacc;
    pw0=(u32x4){PKW(pB0,0),PKW(pB0,2),PKW(pB0,4),PKW(pB0,6)};pw1=(u32x4){PKW(pB0,8),PKW(pB0,10),PKW(pB0,12),PKW(pB0,14)};pw2=(u32x4){PKW(pB1,0),PKW(pB1,2),PKW(pB1,4),PKW(pB1,6)};pw3=(u32x4){PKW(pB1,8),PKW(pB1,10),PKW(pB1,12),PKW(pB1,14)};
    SBAR(); pv(o,vb0+sl_cur,PAF(0),PAF(1),PAF(2),PAF(3)); }
  #undef PKW
  #undef PAF
  #undef VFR
  #undef PIN
  #undef MX3
  #undef GAPA
  #undef GAPB
  #undef CKRD
  #undef EX
  #undef VRD
  #undef KRD
  #undef STEP
  #undef ENDW
  {auto rr=__builtin_amdgcn_permlane32_swap(__float_as_uint(l_reg),__float_as_uint(l_reg),false,false);l_reg=__uint_as_float(rr[0])+__uint_as_float(rr[1]);}
  if(hi==0)wsf[32+r32]=l_reg;asm volatile("s_waitcnt lgkmcnt(0)":::"memory");
  float rli[16];
  #pragma unroll
  for(int r=0;r<16;++r)rli[r]=__builtin_amdgcn_rcpf(wsf[32+crow(r,hi)]);
  bf16_t*Ow=O+(rowbase+q0+wid*QBLK)*OPITCH+h*DH;
  { bf16_t*stg=(bf16_t*)(shm+LDS_OST)+wid*2048;
    #pragma unroll
    for(int r=0;r<16;++r){const int orow=crow(r,hi);
      #pragma unroll
      for(int d0=0;d0<2;++d0)stg[orow*64+d0*32+r32]=f2bf(o[d0][r]*rli[r]);}
    asm volatile("s_waitcnt lgkmcnt(0)":::"memory");
    #pragma unroll
    for(int i=0;i<4;++i){const int row=i*8+(lane>>3),ch=lane&7; const u32x4 v=*(const u32x4*)(stg+row*64+ch*8); *(u32x4*)(Ow+(long)row*OPITCH+ch*8)=v;
      float ss=0.f;
      #pragma unroll
      for(int j=0;j<4;++j){ const float lo_=__builtin_bit_cast(float,v[j]<<16), hi_=__builtin_bit_cast(float,v[j]&0xffff0000u); ss+=lo_*lo_+hi_*hi_; }
      ss+=swz_xor<1>(ss); ss+=swz_xor<2>(ss); ss+=swz_xor<4>(ss);
      if(ch==0)psa[(rowbase+q0+wid*QBLK+row)*8+h]=ss; } }
  asm volatile("s_waitcnt lgkmcnt(0)\n\ts_barrier":::"memory");
  #undef DMA_K
  #undef DMA_V
  #undef CMASK
  #undef CINIT
  #undef START
  #undef RESC
  #undef ROT
}
#undef SBAR
#undef WAIT_BAR
}

__device__ void s5_precompute(int g, const float* lam_re, const float* lam_im, const float* log_dt, const float* b_re, const float* b_im, const float* c_re, const float* c_im,
                              bf16_t* bth, bf16_t* bttg, float* a16, float* sm) {
    float* apr = sm; float* api = apr + 17 * 64; float* bbr = api + 17 * 64; float* bbi = bbr + 1024; float* cr = bbi + 1024; float* ci = cr + 1024; float* Kt = ci + 1024;
    const int tid = threadIdx.x;
    if (tid < 64) { const int p = tid; const float dt = __expf(log_dt[g]); const float lr = lam_re[g * NP + p], li = lam_im[g * NP + p];
        for (int tau = 0; tau <= 16; ++tau) { const float mag = __expf(lr * dt * (float)tau), ang = li * dt * (float)tau; apr[tau * 64 + p] = mag * cosf(ang); api[tau * 64 + p] = mag * sinf(ang); }
        const float abr = apr[64 + p], abi = api[64 + p], den = lr * lr + li * li, nr = abr - 1.f; const float zr = (nr * lr + abi * li) / den, zi = (abi * lr - nr * li) / den;
        for (int c = 0; c < NC; ++c) { const float br = b_re[(size_t)(g * NP + p) * NC + c], bi = b_im[(size_t)(g * NP + p) * NC + c]; bbr[p * 16 + c] = zr * br - zi * bi; bbi[p * 16 + c] = zr * bi + zi * br; }
        a16[(g * 64 + p) * 2] = apr[16 * 64 + p]; a16[(g * 64 + p) * 2 + 1] = api[16 * 64 + p]; }
    for (int i = tid; i < 1024; i += NTHR) { cr[i] = c_re[(size_t)g * 1024 + i]; ci[i] = c_im[(size_t)g * 1024 + i]; }
    __syncthreads();
    for (int idx = tid; idx < 4096; idx += NTHR) { const int tau = idx >> 8, co = (idx >> 4) & 15, cin = idx & 15; float sacc = 0.f;
        for (int p = 0; p < 64; ++p) { const float c_r = cr[co * 64 + p], c_i = ci[co * 64 + p], a_r = apr[tau * 64 + p], a_i = api[tau * 64 + p]; const float wr_ = c_r * a_r - c_i * a_i, wi_ = c_r * a_i + c_i * a_r;
            sacc += wr_ * bbr[p * 16 + cin] - wi_ * bbi[p * 16 + cin]; }
        Kt[idx] = sacc; }
    __syncthreads();
    bf16_t* tg = bttg + (size_t)g * 256 * UXP; bf16_t* hh = bth + (size_t)g * 256 * 256;
    for (int idx = tid; idx < 256 * UXP; idx += NTHR) { const int n = idx / UXP, k = idx - n * UXP, i = n >> 4, co = n & 15; float v;
        if (k < 256) { const int j = k >> 4, cin = k & 15; v = (j <= i) ? Kt[((i - j) << 8) + (co << 4) + cin] : 0.f; }
        else if (k < 320) { const int p = k - 256; v = cr[co * 64 + p] * apr[(i + 1) * 64 + p] - ci[co * 64 + p] * api[(i + 1) * 64 + p]; }
        else { const int p = k - 320; v = -(cr[co * 64 + p] * api[(i + 1) * 64 + p] + ci[co * 64 + p] * apr[(i + 1) * 64 + p]); }
        tg[idx] = f2bf(v); }
    for (int idx = tid; idx < 256 * 256; idx += NTHR) { const int n = idx >> 8, k = idx & 255, j = k >> 4, cin = k & 15; float v = 0.f;
        if (n < 64) v = apr[(15 - j) * 64 + n] * bbr[n * 16 + cin] - api[(15 - j) * 64 + n] * bbi[n * 16 + cin];
        else if (n < 128) { const int p = n - 64; v = apr[(15 - j) * 64 + p] * bbi[p * 16 + cin] + api[(15 - j) * 64 + p] * bbr[p * 16 + cin]; }
        hh[idx] = f2bf(v); }
    __syncthreads();
}


#define XB_TMO      128
#define XB_XCNT(j)  (256  + 64 * (j))
#define XB_XSUB(j)  (1280 + 64 * (j))
#define XB_XGEN(j)  (2304 + 64 * (j))
#define XB_TOP      3328
#define XB_TOPGEN   3392
#define XCD_BAR_WORDS 3456
#define XB_SPIN_CAP (1u << 22)
__device__ __forceinline__ unsigned xb_ld(unsigned* p)              { return __hip_atomic_load(p, __ATOMIC_RELAXED, __HIP_MEMORY_SCOPE_AGENT); }
__device__ __forceinline__ unsigned xb_add(unsigned* p, unsigned v) { return __hip_atomic_fetch_add(p, v, __ATOMIC_RELAXED, __HIP_MEMORY_SCOPE_AGENT); }
__device__ __forceinline__ unsigned xb_xcc_id() { return (unsigned)__builtin_amdgcn_s_getreg((3 << 11) | 20) & 0xFu; }
#define XB_SPIN(cond, bar) do { unsigned _sp = 0; while (cond) { __builtin_amdgcn_s_sleep(1); \
    if ((++_sp & 255u) == 0u) { if (xb_ld(&(bar)[XB_TMO])) break; if (_sp > XB_SPIN_CAP) { atomicAdd(&(bar)[XB_TMO], 1u); break; } } } } while (0)
struct XcdBarrier { unsigned* bar; unsigned x; volatile __attribute__((address_space(3))) unsigned* st; };
__device__ __forceinline__ XcdBarrier xcd_barrier_post(unsigned* bar, volatile __attribute__((address_space(3))) unsigned* st, bool leader) {
    XcdBarrier b; b.bar = bar; b.x = xb_xcc_id(); b.st = st;
    if (leader) (void)xb_add(&bar[XB_XCNT(b.x)], 1u);
    return b;
}
__device__ __forceinline__ void xcd_barrier_complete(unsigned* bar, unsigned x, unsigned G, unsigned& nloc, unsigned& nx) {
    unsigned sum, cnt, mine, sp = 0u;
    for (;;) {
        sum = 0u; cnt = 0u; mine = 0u;
#pragma unroll
        for (unsigned j = 0; j < 16; ++j) { const unsigned c = xb_ld(&bar[XB_XCNT(j)]); sum += c; cnt += (c > 0u) ? 1u : 0u; mine = (j == x) ? c : mine; }
        if (sum == G) break;
        __builtin_amdgcn_s_sleep(1);
        if ((++sp & 255u) == 0u) { if (xb_ld(&bar[XB_TMO])) break; if (sp > XB_SPIN_CAP) { atomicAdd(&bar[XB_TMO], 1u); break; } }
    }
    nloc = mine > 0u ? mine : 1u; nx = cnt > 0u ? cnt : 1u;
}
__device__ __forceinline__ void xcd_barrier(const XcdBarrier& b, bool leader, unsigned G) {
    asm volatile("s_waitcnt vmcnt(0)" ::: "memory");
    __syncthreads();
    if (leader) {
        unsigned* bar = b.bar;
        __builtin_amdgcn_s_waitcnt(0);
        unsigned nloc = b.st[0], nx = b.st[1];
        if (nloc == 0u) { xcd_barrier_complete(bar, b.x, G, nloc, nx); b.st[0] = nloc; b.st[1] = nx; }
        const unsigned old = xb_add(&bar[XB_XSUB(b.x)], 1u);
        const unsigned gen = old / nloc;
        if (old + 1u == (gen + 1u) * nloc) {
            __builtin_amdgcn_fence(__ATOMIC_RELEASE, "agent");
            asm volatile("s_waitcnt vmcnt(0)" ::: "memory");
            const unsigned og = xb_add(&bar[XB_TOP], 1u);
            const unsigned tg = og / nx;
            if (og + 1u == (tg + 1u) * nx) xb_add(&bar[XB_TOPGEN], 1u);
            else XB_SPIN(xb_ld(&bar[XB_TOPGEN]) == tg, bar);
            __builtin_amdgcn_fence(__ATOMIC_ACQUIRE, "agent");
            xb_add(&bar[XB_XGEN(b.x)], 1u);
            asm volatile("s_waitcnt vmcnt(0)" ::: "memory");
        } else {
            XB_SPIN(xb_ld(&bar[XB_XGEN(b.x)]) == gen, bar);
            __builtin_amdgcn_fence(__ATOMIC_ACQUIRE, "agent");
            asm volatile("s_waitcnt vmcnt(0)" ::: "memory");
        }
    }
    __syncthreads();
}

__device__ __forceinline__ int lane_now() { int l; asm volatile("v_mbcnt_lo_u32_b32 %0, -1, 0\n\tv_mbcnt_hi_u32_b32 %0, -1, %0" : "=v"(l)); return l; }

struct Params {
    const float* in[29];
    float* out;
    unsigned char* ws;
};

__device__ __forceinline__ float wave_sum(float v) {
    v += swz_xor<1>(v); v += swz_xor<2>(v); v += swz_xor<4>(v); v += swz_xor<8>(v); v += swz_xor<16>(v);
    return xhalf_sum(v);
}

template <class AT> __device__ void rms_rows(const AT* in, int ldi, const float* g, float* out, int ldo, int ncols, int nrows, int gw, int ngw, int lane) {
    for (int r = gw; r < nrows; r += ngw) {
        const AT* row = in + (size_t)r * ldi; float ss = 0.f;
        for (int c = lane; c < ncols; c += 64) { const float v = ldf(row, c); ss += v * v; }
        ss = wave_sum(ss);
        const float rs = rsqrtf(ss / (float)ncols + EPS);
        float* orow = out + (size_t)r * ldo;
        for (int c = lane; c < ncols; c += 64) orow[c] = ldf(row, c) * rs * g[c];
    }
}

template <class AT, bool DUAL, class RowFn, class Epi>
__device__ void gemm_tile(const AT* A, int lda, RowFn arow, const float* B, int ldb, int K, int m0, int n0, int n1, int Nmax, float* sm, Epi epi) {
    float* As = sm;
    float* Bs = sm + 16 * 132;
    float* Bs2 = Bs + 16 * 128;
    const int tid = threadIdx.x, ty = tid >> 4, tx = tid & 15;
    float acc[4][8], acc2[4][8];
#pragma unroll
    for (int i = 0; i < 4; ++i)
#pragma unroll
        for (int j = 0; j < 8; ++j) { acc[i][j] = 0.f; acc2[i][j] = 0.f; }
    const int ar = tid >> 2, ak = (tid & 3) * 4;
    const int srow = arow(m0 + ar);
    const int bk = tid >> 5, bn = (tid & 31) * 4;
    for (int k0 = 0; k0 < K; k0 += 16) {
        float a4[4];
#pragma unroll
        for (int j = 0; j < 4; ++j) a4[j] = (srow >= 0) ? ldf(A, (size_t)srow * lda + k0 + ak + j) : 0.f;
        float b4[4], c4[4];
#pragma unroll
        for (int j = 0; j < 4; ++j) { const int col = n0 + bn + j; b4[j] = (col < Nmax) ? B[(size_t)(k0 + bk) * ldb + col] : 0.f; }
        if (DUAL) {
#pragma unroll
            for (int j = 0; j < 4; ++j) c4[j] = B[(size_t)(k0 + bk) * ldb + n1 + bn + j];
        }
        __syncthreads();
#pragma unroll
        for (int j = 0; j < 4; ++j) As[(ak + j) * 132 + ar] = a4[j];
#pragma unroll
        for (int j = 0; j < 4; ++j) Bs[bk * 128 + bn + j] = b4[j];
        if (DUAL) {
#pragma unroll
            for (int j = 0; j < 4; ++j) Bs2[bk * 128 + bn + j] = c4[j];
        }
        __syncthreads();
#pragma unroll 2
        for (int kk = 0; kk < 16; ++kk) {
            float a[4], b[8];
#pragma unroll
            for (int i = 0; i < 4; ++i) a[i] = As[kk * 132 + ty * 4 + i];
#pragma unroll
            for (int j = 0; j < 8; ++j) b[j] = Bs[kk * 128 + tx * 8 + j];
#pragma unroll
            for (int i = 0; i < 4; ++i)
#pragma unroll
                for (int j = 0; j < 8; ++j) acc[i][j] += a[i] * b[j];
            if (DUAL) {
#pragma unroll
                for (int j = 0; j < 8; ++j) b[j] = Bs2[kk * 128 + tx * 8 + j];
#pragma unroll
                for (int i = 0; i < 4; ++i)
#pragma unroll
                    for (int j = 0; j < 8; ++j) acc2[i][j] += a[i] * b[j];
            }
        }
    }
    __syncthreads();
#pragma unroll
    for (int i = 0; i < 4; ++i)
#pragma unroll
        for (int j = 0; j < 8; ++j) epi(m0 + ty * 4 + i, tx * 8 + j, acc[i][j], acc2[i][j]);
}

struct RowId { __device__ int operator()(int r) const { return r; } };
struct RowTok { const int* rowtok; __device__ int operator()(int r) const { const int id = rowtok[r]; return id < 0 ? -1 : (id >> 2); } };
struct RowSlot { const int* rowtok; __device__ int operator()(int r) const { return rowtok[r] < 0 ? -1 : r; } };

__device__ __forceinline__ float sigmoidf_(float x) { return 1.f / (1.f + __expf(-x)); }

__global__ void __launch_bounds__(NTHR) fwd_naive(Params P) {
    cg::grid_group grid = cg::this_grid();
    extern __shared__ __attribute__((aligned(16))) unsigned char lds[];
    float* sm = (float*)lds;
    int* ism = (int*)(lds + 57600);
    PG8_LAS unsigned char* ldsl = (PG8_LAS unsigned char*)lds;
    const int wave_s = __builtin_amdgcn_readfirstlane((int)threadIdx.x >> 6);
#define TID_NOW() (wave_s * 64 + lane_now())
    int tid = TID_NOW(), lane = tid & 63, wave = tid >> 6;
    const int nblk = gridDim.x, blk = blockIdx.x;
    int gw = blk * NWAVE + wave; const int ngw = nblk * NWAVE;
#define REFRESH_IDS() do { tid = TID_NOW(); asm volatile("" : "+v"(tid)); lane = tid & 63; wave = tid >> 6; gw = blk * NWAVE + wave; } while (0)
    unsigned char* ws = P.ws;
    int* ctl = (int*)(ws + WS_CTL);
    volatile __attribute__((address_space(3))) unsigned* MISC = (volatile __attribute__((address_space(3))) unsigned*)(ldsl + MISC_OFF);
    if (tid < 2) MISC[tid] = 0u;
    __syncthreads();
    const XcdBarrier xbar = xcd_barrier_post((unsigned*)ctl + CT_BAR, MISC, tid == 0);
#define GSYNC() do { xcd_barrier(xbar, TID_NOW() == 0, (unsigned)nblk); REFRESH_IDS(); } while (0)
    float* logf_ = (float*)(ws + WS_LOGF);
    float* x1 = (float*)(ws + WS_X1);
    int* topi = (int*)(ws + WS_TOPI); float* topg = (float*)(ws + WS_TOPG);
    int* rowtok = (int*)(ws + WS_ROWTOK); float* rowgate = (float*)(ws + WS_ROWGATE);
    bf16_t* act = (bf16_t*)(ws + WS_ACT); bf16_t* Y = (bf16_t*)(ws + WS_Y);
    float* Gs = (float*)(ws + WS_GS);
    bf16_t* Win_t = (bf16_t*)(ws + WS_WIN); bf16_t* XN = (bf16_t*)(ws + WS_XN); bf16_t* QB = (bf16_t*)(ws + WS_Q);
    bf16_t* KB = QB + (size_t)T * 512; bf16_t* VB = KB + (size_t)T * 512; bf16_t* UX = (bf16_t*)(ws + WS_UX);
    bf16_t* S5H = (bf16_t*)(ws + WS_S5H); bf16_t* S5TG = (bf16_t*)(ws + WS_S5TG); float* A16 = (float*)(ws + WS_A16);
    bf16_t* Wgu_t = (bf16_t*)(ws + WS_WGU); bf16_t* Wdn_t = (bf16_t*)(ws + WS_WDN); bf16_t* X1B = (bf16_t*)(ws + WS_X1B);
    bf16_t* MIXB = (bf16_t*)(ws + WS_MIXB); float* psa = (float*)(ws + WS_PSA); float* pss = (float*)(ws + WS_PSS);
    bf16_t* GB = (bf16_t*)(ws + WS_GB); bf16_t* Wglu_t = (bf16_t*)(ws + WS_WGLU); bf16_t* Wout_t = (bf16_t*)(ws + WS_WOUT); bf16_t* Wpg_t = (bf16_t*)(ws + WS_WPG); bf16_t* Wpp_t = (bf16_t*)(ws + WS_WPP);
    bf16_t* PB = (bf16_t*)(ws + WS_PB); bf16_t* XN2 = (bf16_t*)(ws + WS_XN2); bf16_t* GSB = (bf16_t*)(ws + WS_GS);
    int* rowsrc = (int*)(ws + WS_ROWSRC); float* rowscl = (float*)(ws + WS_ROWSCL); float* r1 = (float*)(ws + WS_R1);
    const float* x = P.in[0]; const float* pin = P.in[1]; const float* norm_mix_g = P.in[2]; const float* w_in = P.in[3]; const float* b_f = P.in[4];
    const float* lam_re = P.in[5]; const float* lam_im = P.in[6]; const float* log_dt = P.in[7]; const float* b_re = P.in[8]; const float* b_im = P.in[9];
    const float* c_re = P.in[10]; const float* c_im = P.in[11]; const float* d_skip = P.in[12]; const float* w_glu = P.in[13]; const float* b_glu = P.in[14];
    const float* attn_out_g = P.in[15]; const float* ssm_out_g = P.in[16]; const float* w_out = P.in[17]; const float* norm_ffn_g = P.in[18];
    const float* w_router = P.in[19]; const float* b_router = P.in[20]; const float* w_gu = P.in[21]; const float* b_gu = P.in[22];
    const float* w_dn = P.in[23]; const float* b_dn = P.in[24]; const float* norm_ple_g = P.in[25]; const float* w_ple_gate = P.in[26];
    const float* w_ple_proj = P.in[27]; const float* norm_final_g = P.in[28];

    if (blk == 0 && tid < 128) ctl[tid] = 0;
    if (blk < NG) s5_precompute(blk, lam_re, lam_im, log_dt, b_re, b_im, c_re, c_im, S5H, S5TG, A16, sm);
    {
        PG8_LAS float* scr = (PG8_LAS float*)(ldsl + wave * 16384);
        constexpr int I_IN = 16 * 64, I_GU = NE * 16 * 64, I_DN = NE * 16 * 32, I_GLU = 8 * 16, I_OUT = 16 * 32, I_PG = 16 * 32, I_PP = 4 * 32;
        for (int it = gw; it < I_IN + I_GLU + I_OUT + I_PG + I_PP + I_GU + I_DN; it += ngw) {
            int r = it;
            if (r < I_GLU) { const int kb = r >> 4, nb = r & 15; transpose_item(w_glu, SW, kb * 64, nb * 32, nullptr, Wglu_t, SW, nb * 32, scr, lane); continue; }
            r -= I_GLU;
            if (r < I_OUT) { const int kb = r >> 5, nb = r & 31; transpose_item(w_out, D, kb * 64, nb * 32, kb < 8 ? attn_out_g : ssm_out_g - AW, Wout_t, D, nb * 32, scr, lane); continue; }
            r -= I_OUT;
            if (r < I_PG) { const int kb = r >> 5, nb = r & 31; transpose_item(w_ple_gate, D, kb * 64, nb * 32, norm_ple_g, Wpg_t, D, nb * 32, scr, lane); continue; }
            r -= I_PG;
            if (r < I_PP) { const int kb = r >> 5, nb = r & 31; transpose_item(w_ple_proj, D, kb * 64, nb * 32, nullptr, Wpp_t, PLE, nb * 32, scr, lane); continue; }
            r -= I_PP;
            if (r < I_IN) { const int kb = r >> 6, nb = r & 63, n0 = nb * 32; const int c0 = (n0 < 1536) ? n0 : n0 + 8;
                transpose_item(w_in, INW, kb * 64, c0, norm_mix_g, Win_t, D, n0, scr, lane); continue; }
            r -= I_IN;
            if (r < I_GU) {
                const int e = r >> 10, kb = (r >> 6) & 15, nb = r & 63; const int n0 = nb * 32, pn = n0 >> 8, j0 = n0 & 255;
                const int c0 = (j0 < 128) ? pn * 128 + j0 : DFF + pn * 128 + (j0 - 128);
                transpose_item(w_gu + (size_t)e * D * 2 * DFF, 2 * DFF, kb * 64, c0, norm_ffn_g, Wgu_t + (size_t)e * 2 * DFF * D, D, n0, scr, lane); continue; }
            r -= I_GU;
            { const int e = r >> 9, kb = (r >> 5) & 15, nb = r & 31;
              transpose_item(w_dn + (size_t)e * DFF * D, D, kb * 64, nb * 32, nullptr, Wdn_t + (size_t)e * D * DFF, DFF, nb * 32, scr, lane); }
        }
    }
    for (size_t i = (size_t)(blk * NTHR + tid) * 8; i < (size_t)T * PLE; i += (size_t)nblk * NTHR * 8) {
        const float4 a = *(const float4*)(pin + i), b4 = *(const float4*)(pin + i + 4);
        *(uint4*)(PB + i) = make_uint4(pk2(a.x, a.y), pk2(a.z, a.w), pk2(b4.x, b4.y), pk2(b4.z, b4.w)); }
    {
        float wf[4][4][8];
#pragma unroll
        for (int j = 0; j < 4; ++j)
#pragma unroll
            for (int i = 0; i < 4; ++i) { const int k = 256 * j + 4 * lane + i; const float gk = norm_mix_g[k]; const float4 a = *(const float4*)(w_in + (size_t)k * INW + COL_F), b4 = *(const float4*)(w_in + (size_t)k * INW + COL_F + 4);
                wf[j][i][0] = a.x * gk; wf[j][i][1] = a.y * gk; wf[j][i][2] = a.z * gk; wf[j][i][3] = a.w * gk; wf[j][i][4] = b4.x * gk; wf[j][i][5] = b4.y * gk; wf[j][i][6] = b4.z * gk; wf[j][i][7] = b4.w * gk; }
        for (int r = gw; r < T; r += ngw) {
            const float4* xr = (const float4*)(x + (size_t)r * D) + lane; float4 v[4]; float ss = 0.f;
#pragma unroll
            for (int j = 0; j < 4; ++j) { v[j] = xr[64 * j]; ss += (v[j].x * v[j].x + v[j].y * v[j].y) + (v[j].z * v[j].z + v[j].w * v[j].w); }
            ss = wave_sum(ss); const float rs = rsqrtf(ss * (1.f / D) + EPS);
            float fl[8];
#pragma unroll
            for (int h = 0; h < 8; ++h) fl[h] = 0.f;
            uint2* o8 = (uint2*)(XN + (size_t)r * D) + lane;
#pragma unroll
            for (int j = 0; j < 4; ++j) { const float a0 = v[j].x * rs, a1 = v[j].y * rs, a2 = v[j].z * rs, a3 = v[j].w * rs;
                o8[64 * j] = make_uint2(pk2(a0, a1), pk2(a2, a3));
#pragma unroll
                for (int h = 0; h < 8; ++h) fl[h] += a0 * wf[j][0][h] + a1 * wf[j][1][h] + a2 * wf[j][2][h] + a3 * wf[j][3][h]; }
            float mine = 0.f;
#pragma unroll
            for (int h = 0; h < 8; ++h) { const float sfl = wave_sum(fl[h]); if (lane == h) mine = sfl; }
            if (lane < 8) { const float z = mine + b_f[lane]; logf_[(size_t)r * 8 + lane] = fminf(z, 0.f) - log1pf(__expf(-fabsf(z))); }
        }
    }
    __syncthreads();
    grid.sync(); REFRESH_IDS();

    {
        pg8::Order So; So.init(T / 256, 2048 / 256, nblk, blk, nullptr);
        pg8::EpiQKVU E{QB, (size_t)T * 512, UX};
        pg8::gemm_phase(TID_NOW(), ldsl, (const char*)XN, (const char*)Win_t, 0, D, So, pg8::DenseRows{D}, E);
    }
    GSYNC();

    {
        const int pm = (blk % 8) * (nblk / 8) + blk / 8, g = pm >> 3;
        pg8::OneUnit So{pm, g};
        pg8::EpiS5H E1{UX, A16 + g * 128};
        pg8::gemm_phase(TID_NOW(), ldsl, (const char*)UX, (const char*)S5H, (size_t)256 * 256 * 2, 256, So, pg8::DenseRows{UXP}, E1);
        pg8::EpiS5Y E2{UX, d_skip, GB};
        pg8::gemm_phase(TID_NOW(), ldsl, (const char*)UX, (const char*)S5TG, (size_t)256 * UXP * 2, UXP, So, pg8::DenseRows{UXP}, E2);
    }
    {
        const int vcu = (blk % 8) * (nblk / 8) + blk / 8, bh = vcu >> 2, sg = vcu & 3, b = bh >> 3, h = bh & 7;
        attn_body::prep_c(TID_NOW(), b, h, logf_, (char*)lds);
        for (int i = 0; i < 4; ++i) { const int qb = (i == 0) ? sg : (i == 1) ? 7 - sg : (i == 2) ? 8 + sg : 15 - sg;
            attn_body::attn_unit<8>(TID_NOW(), b, h, qb, QB, KB, VB, MIXB, psa, (char*)lds); }
    }
    GSYNC();

    {
        pg8::Order So; So.init(T / 256, SW / 256, nblk, blk, nullptr);
        pg8::EpiGlu E{GB, MIXB, b_glu, pss};
        pg8::gemm_phase(TID_NOW(), ldsl, (const char*)GB, (const char*)Wglu_t, 0, SW, So, pg8::DenseRows{SW}, E);
    }
    GSYNC();

    {
        pg8::Order So; So.init(T / 256, D / 256, nblk, blk, nullptr);
        pg8::EpiOut E{x, x1, X1B, psa, pss};
        pg8::gemm_phase(TID_NOW(), ldsl, (const char*)MIXB, (const char*)Wout_t, 0, D, So, pg8::DenseRows{D}, E);
    }
    GSYNC();

    {
        typedef float f32x16 __attribute__((ext_vector_type(16)));
        float* Wr = sm;
        int* hist = (int*)(lds + 131072);
        for (int i = tid; i < D * NE; i += NTHR) Wr[i] = w_router[i] * norm_ffn_g[i >> 5];
        if (tid < NE) hist[tid] = 0;
        __syncthreads();
        if (wave >= 4) { for (int i = blk * 256 + (tid - 256); i < CAP; i += nblk * 256) { rowtok[i] = -1; rowgate[i] = 0.f; rowsrc[i] = 0; rowscl[i] = 0.f; } }
        else {
            const int r0 = (blk * 4 + wave) * 32, e = lane & 31, h = lane >> 5; const float* xp = x1 + (size_t)(r0 + e) * D + 4 * h;
            f32x16 acc;
#pragma unroll
            for (int r = 0; r < 16; ++r) acc[r] = 0.f;
            float ss = 0.f;
#pragma unroll 4
            for (int j = 0; j < 128; ++j) { const float4 xv = *(const float4*)(xp + 8 * j); const float* wp = Wr + (8 * j + 4 * h) * 32 + e;
                ss += (xv.x * xv.x + xv.y * xv.y) + (xv.z * xv.z + xv.w * xv.w);
                acc = __builtin_amdgcn_mfma_f32_32x32x2f32(xv.x, wp[0], acc, 0, 0, 0); acc = __builtin_amdgcn_mfma_f32_32x32x2f32(xv.y, wp[32], acc, 0, 0, 0);
                acc = __builtin_amdgcn_mfma_f32_32x32x2f32(xv.z, wp[64], acc, 0, 0, 0); acc = __builtin_amdgcn_mfma_f32_32x32x2f32(xv.w, wp[96], acc, 0, 0, 0); }
            ss = xhalf_sum(ss); const float rs = rsqrtf(ss * (1.f / D) + EPS);
            if (h == 0) r1[r0 + e] = rs;
            const float bias = b_router[e];
#pragma unroll
            for (int r = 0; r < 16; ++r) { const int ri = (r & 3) + 8 * (r >> 2) + 4 * h;
                float v = acc[r] * bperm(rs, ri) + bias; float tv[TOPK]; int ti[TOPK];
#pragma unroll
                for (int k = 0; k < TOPK; ++k) { float m = v;
                    m = fmaxf(m, swz_xor<1>(m)); m = fmaxf(m, swz_xor<2>(m)); m = fmaxf(m, swz_xor<4>(m)); m = fmaxf(m, swz_xor<8>(m)); m = fmaxf(m, swz_xor<16>(m));
                    const unsigned long long bm = __ballot(v == m); const unsigned half = h ? (unsigned)(bm >> 32) : (unsigned)bm; const int idx = __ffs((int)half) - 1;
                    tv[k] = m; ti[k] = idx; if (e == idx) v = -INFINITY; }
                float es[TOPK], den = 0.f;
#pragma unroll
                for (int k = 0; k < TOPK; ++k) { es[k] = __expf(tv[k] - tv[0]); den += es[k]; }
                if (e < TOPK) { float gsel = es[0]; int isel = ti[0];
#pragma unroll
                    for (int k = 1; k < TOPK; ++k) if (e == k) { gsel = es[k]; isel = ti[k]; }
                    topi[(size_t)(r0 + ri) * TOPK + e] = isel; topg[(size_t)(r0 + ri) * TOPK + e] = gsel / den; atomicAdd(&hist[isel], 1); } }
        }
        __syncthreads();
        if (tid < NE) atomicAdd(&ctl[CT_COUNT + tid], hist[tid]);
    }
    GSYNC();

    {
        int* lcnt = ism + 64; int* lbase = ism + 128;
        if (tid < NE) lcnt[tid] = 0;
        if (tid == 0) {
            int run = 0;
            for (int e = 0; e < NE; ++e) { ism[e] = run; const int cnt = ctl[CT_COUNT + e]; run += (cnt + MB - 1) / MB * MB; }
            ism[NE] = run;
            if (blk == 0) {
                for (int e = 0; e <= NE; ++e) ctl[CT_PADSTART + e] = ism[e];
                ctl[CT_NTILES] = run / MB;
                for (int e = 0; e < NE; ++e) for (int tt = ism[e] / MB; tt < ism[e + 1] / MB; ++tt) ctl[CT_TILEEXP + tt] = e;
            }
        }
        __syncthreads();
        const int i = blk * NTHR + tid; const int e = topi[i]; const int rank = atomicAdd(&lcnt[e], 1);
        __syncthreads();
        if (tid < NE) lbase[tid] = atomicAdd(&ctl[CT_CURSOR + tid], lcnt[tid]);
        __syncthreads();
        const int slot = ism[e] + lbase[e] + rank;
        rowtok[slot] = i; rowgate[slot] = topg[i]; rowsrc[slot] = i >> 2; rowscl[slot] = r1[i >> 2];
    }
    GSYNC();

    {
        pg8::Order So; So.init(ctl[CT_NTILES], 2 * DFF / 256, nblk, blk, ctl + CT_TILEEXP);
        pg8::EpiSwiglu E{act, b_gu, rowscl};
        pg8::gemm_phase(TID_NOW(), ldsl, (const char*)X1B, (const char*)Wgu_t, (size_t)2 * DFF * D * 2, D, So, pg8::GatherRows{rowsrc, D}, E);
    }
    GSYNC();

    {
        pg8::Order So; So.init(ctl[CT_NTILES], D / 256, nblk, blk, ctl + CT_TILEEXP);
        pg8::EpiScatter E{Y, b_dn, rowtok, rowgate};
        pg8::gemm_phase(TID_NOW(), ldsl, (const char*)act, (const char*)Wdn_t, (size_t)D * DFF * 2, DFF, So, pg8::DenseRows{DFF}, E);
    }
    GSYNC();

    for (int r = gw; r < T; r += ngw) {
        float4* xr = (float4*)(x1 + (size_t)r * D) + lane; float4 v[4]; float ss = 0.f;
#pragma unroll
        for (int j = 0; j < 4; ++j) { v[j] = xr[64 * j];
#pragma unroll
            for (int k = 0; k < TOPK; ++k) { const uint2 y = *((const uint2*)(Y + ((size_t)r * TOPK + k) * D) + lane + 64 * j);
                v[j].x += __builtin_bit_cast(float, y.x << 16); v[j].y += __builtin_bit_cast(float, y.x & 0xffff0000u); v[j].z += __builtin_bit_cast(float, y.y << 16); v[j].w += __builtin_bit_cast(float, y.y & 0xffff0000u); }
            xr[64 * j] = v[j]; ss += (v[j].x * v[j].x + v[j].y * v[j].y) + (v[j].z * v[j].z + v[j].w * v[j].w); }
        ss = wave_sum(ss); const float rs = rsqrtf(ss * (1.f / D) + EPS);
        uint2* o8 = (uint2*)(XN2 + (size_t)r * D) + lane;
#pragma unroll
        for (int j = 0; j < 4; ++j) o8[64 * j] = make_uint2(pk2(v[j].x * rs, v[j].y * rs), pk2(v[j].z * rs, v[j].w * rs));
    }
    GSYNC();

    {
        pg8::Order So; So.init(T / 256, D / 256, nblk, blk, nullptr);
        pg8::EpiGate E1{GSB};
        pg8::gemm_phase(TID_NOW(), ldsl, (const char*)XN2, (const char*)Wpg_t, 0, D, So, pg8::DenseRows{D}, E1);
        pg8::EpiPle E2{GSB, x1};
        pg8::gemm_phase(TID_NOW(), ldsl, (const char*)PB, (const char*)Wpp_t, 0, PLE, So, pg8::DenseRows{PLE}, E2);
    }
    GSYNC();

    for (int r = gw; r < T; r += ngw) {
        const float4* xr = (const float4*)(x1 + (size_t)r * D) + lane; float4 v[4]; float ss = 0.f;
#pragma unroll
        for (int j = 0; j < 4; ++j) { v[j] = xr[64 * j]; ss += (v[j].x * v[j].x + v[j].y * v[j].y) + (v[j].z * v[j].z + v[j].w * v[j].w); }
        ss = wave_sum(ss); const float rs = rsqrtf(ss * (1.f / D) + EPS);
        float4* orow = (float4*)(P.out + (size_t)r * D) + lane;
#pragma unroll
        for (int j = 0; j < 4; ++j) { const float4 g4 = ((const float4*)norm_final_g)[lane + 64 * j]; orow[64 * j] = make_float4(v[j].x * rs * g4.x, v[j].y * rs * g4.y, v[j].z * rs * g4.z, v[j].w * rs * g4.w); }
    }
}

extern "C" void kernel_launch(void* const* d_in, const int* in_sizes, int n_in, void* d_out, int out_size, void* d_ws, size_t ws_size, hipStream_t stream) {
    static int grid = 0;
    if (grid == 0) {
        int dev = 0, cus = 0, per_cu = 0;
        (void)hipGetDevice(&dev);
        (void)hipDeviceGetAttribute(&cus, hipDeviceAttributeMultiprocessorCount, dev);
        if (hipFuncSetAttribute((const void*)fwd_naive, hipFuncAttributeMaxDynamicSharedMemorySize, LDS_BYTES) != hipSuccess) fprintf(stderr, "kernel_launch: hipFuncSetAttribute failed\n");
        (void)hipOccupancyMaxActiveBlocksPerMultiprocessor(&per_cu, (const void*)fwd_naive, NTHR, LDS_BYTES);
        if (per_cu < 1) { fprintf(stderr, "kernel_launch: occupancy query says %d blocks per CU\n", per_cu); per_cu = 1; }
        grid = cus;
        if (n_in != 29 || ws_size < WS_END) { fprintf(stderr, "kernel_launch: unexpected n_in %d or ws_size %zu\n", n_in, ws_size); }
    }
    (void)hipMemsetAsync((char*)d_ws + WS_CTL, 0, CTL_ZERO_BYTES, stream);
    Params p{};
    for (int i = 0; i < 29; ++i) p.in[i] = (const float*)d_in[i];
    p.out = (float*)d_out; p.ws = (unsigned char*)d_ws;
    void* args[] = {&p};
    hipError_t e = hipLaunchCooperativeKernel((const void*)fwd_naive, dim3(grid), dim3(NTHR), args, LDS_BYTES, stream);
    if (e != hipSuccess) fprintf(stderr, "cooperative launch failed: %s (grid %d)\n", hipGetErrorString(e), grid);
}
```

```cpp
#include <hip/hip_runtime.h>
#include <hip/hip_cooperative_groups.h>
#include <cstdio>
#include <cstdint>
namespace cg = cooperative_groups;

constexpr int NB = 8, S = 4096, T = NB * S, D = 1024, NH = 8, HD = 64, AW = 512, SW = 512, INW = 2056;
constexpr int NG = 32, NP = 64, NC = 16, NE = 32, TOPK = 4, DFF = 1024, PLE = 256;
constexpr int COL_K = 512, COL_V = 1024, COL_F = 1536, COL_U = 1544;
constexpr float EPS = 1e-5f;
constexpr int NTHR = 512, NWAVE = 8;
#ifndef PROBE_DUP
#define PROBE_DUP 0
#endif
#define REP(k) for (int rep_ = 0; rep_ < ((PROBE_DUP == (k)) ? 2 : 1); ++rep_)
constexpr int MB = 256;
constexpr int CAP = T * TOPK + NE * MB;
constexpr int MAXTILES = CAP / MB;
constexpr int LDS_BYTES = 147456;

typedef unsigned short bf16_t;
template <int M> __device__ __forceinline__ float swz_xor(float v) { return __builtin_bit_cast(float, __builtin_amdgcn_ds_swizzle(__builtin_bit_cast(int, v), (M << 10) | 0x1f)); }
__device__ __forceinline__ float xhalf_sum(float v) { unsigned a = __builtin_bit_cast(unsigned, v), b = a; asm volatile("" : "+v"(b));
    auto rr = __builtin_amdgcn_permlane32_swap(a, b, false, false); unsigned r0 = rr[0], r1 = rr[1]; asm volatile("" : "+v"(r0), "+v"(r1));
    return __builtin_bit_cast(float, r0) + __builtin_bit_cast(float, r1); }
__device__ __forceinline__ float bperm(float v, int srclane) { return __builtin_bit_cast(float, __builtin_amdgcn_ds_bpermute(srclane << 2, __builtin_bit_cast(int, v))); }
__device__ __forceinline__ bf16_t f2bf(float f) { unsigned u = __builtin_bit_cast(unsigned, f); return (bf16_t)((u + 0x7fffu + ((u >> 16) & 1u)) >> 16); }
__device__ __forceinline__ float bf2f(bf16_t b) { return __builtin_bit_cast(float, (unsigned)b << 16); }
__device__ __forceinline__ unsigned pk2(float lo, float hi) { return (unsigned)f2bf(lo) | ((unsigned)f2bf(hi) << 16); }
__device__ __forceinline__ float ldf(const float* p, size_t i) { return p[i]; }
__device__ __forceinline__ float ldf(const bf16_t* p, size_t i) { return bf2f(p[i]); }

constexpr size_t MiB = 1u << 20;
constexpr size_t WS_CTL = 0;
constexpr size_t WS_WIN = 1 * MiB;
constexpr size_t WS_WGLU = 5 * MiB;
constexpr size_t WS_WOUT = 6 * MiB;
constexpr size_t WS_WPG = 8 * MiB;
constexpr size_t WS_WPP = 10 * MiB;
constexpr size_t WS_A16 = 11 * MiB;
constexpr size_t WS_S5H = 12 * MiB;
constexpr size_t WS_S5TG = 16 * MiB;
constexpr size_t WS_WDN = 22 * MiB;
constexpr size_t WS_X1 = 86 * MiB;
constexpr size_t WS_TOPI = 214 * MiB;
constexpr size_t WS_TOPG = 214 * MiB + 512 * 1024;
constexpr size_t WS_ROWTOK = 215 * MiB;
constexpr size_t WS_ROWGATE = 216 * MiB;
constexpr size_t WS_ROWSRC = 217 * MiB;
constexpr size_t WS_ROWSCL = 218 * MiB;
constexpr size_t WS_R1 = 219 * MiB;
constexpr size_t WS_PSA = 220 * MiB;
constexpr size_t WS_PSS = 221 * MiB;
constexpr size_t WS_LOGF = 222 * MiB;
constexpr size_t WS_PB = 223 * MiB;
constexpr size_t WS_A = 239 * MiB;
constexpr size_t WS_XN = WS_A;
constexpr size_t WS_Q = WS_A + 64 * MiB;
constexpr size_t WS_UX = WS_A + 160 * MiB;
constexpr size_t WS_MIXB = WS_A + 212 * MiB;
constexpr size_t WS_GB = WS_A + 276 * MiB;
constexpr size_t WS_ACT = WS_A;
constexpr size_t WS_XN2 = WS_A;
constexpr size_t WS_GS = WS_A + 64 * MiB;
constexpr size_t WS_B = WS_A + 308 * MiB;
constexpr size_t WS_WGU = WS_B;
constexpr size_t WS_X1B = WS_B + 128 * MiB;
constexpr size_t WS_Y = WS_B;
constexpr size_t WS_END = WS_B + 256 * MiB;
static_assert((size_t)CAP * 4 <= MiB && (size_t)CAP * DFF * 2 <= 272 * MiB, "list arrays fit 1 MiB each; ACT fits");
constexpr int UXP = 384;
constexpr int CT_COUNT = 0, CT_CURSOR = 64, CT_PADSTART = 128, CT_NTILES = 192, CT_TILEEXP = 256, CT_BAR = 4096;
constexpr size_t CTL_ZERO_BYTES = 65536;
constexpr int MISC_OFF = 147200;
constexpr float LOG2E = 1.4426950408889634f, C2 = 0.125f * LOG2E;

namespace pg8 {
#define PG8_LAS __attribute__((address_space(3)))
typedef short bf16x8 __attribute__((ext_vector_type(8)));
typedef float f32x4 __attribute__((ext_vector_type(4)));
typedef unsigned u32x4 __attribute__((ext_vector_type(4)));
constexpr int BM = 256, BK = 64, HALF = 128, HTB = HALF * BK * 2, STAGE_BYTES = 8 * HTB, NXCD = 8, WGM = 8;
__device__ __forceinline__ int lds_byte(int r, int c) { const int st = (r >> 4) * 2 + (c >> 5), rr = r & 15, cc = c & 31, ob = rr * 64 + cc * 2; return st * 1024 + (ob ^ (((ob >> 9) & 1) << 5)); }
__device__ __forceinline__ void stage_rc(int b, int& R, int& C) { const int st = b / 1024, sb = b % 1024, swz = sb ^ (((sb >> 9) & 1) << 5); R = (st >> 1) * 16 + swz / 64; C = (st & 1) * 32 + (swz % 64) / 2; }
__device__ __forceinline__ int perm32(int rho) { const int n = rho >> 4, i = rho & 15; return 8 * (i >> 2) + 4 * n + (i & 3); }
struct Unit { int pm, pn, e; };
struct Order {
    int nM, nN, nwg, G, c; const int* texp;
    __device__ void init(int nM_, int nN_, int G_, int c_, const int* texp_) { nM = nM_; nN = nN_; nwg = nM * nN; G = G_; c = c_; texp = texp_; }
    __device__ bool next(int i, Unit& u) const {
        const long L = (long)i * G + c; if (L >= nwg) return false;
        int wgid = (int)L; { const int q = nwg / NXCD, r = nwg % NXCD, xcd = wgid % NXCD, off = wgid / NXCD; wgid = (xcd < r ? xcd * (q + 1) : r * (q + 1) + (xcd - r) * q) + off; }
        const int nig = WGM * nN, gid = wgid / nig, fm = gid * WGM, gsz = (nM - fm) < WGM ? (nM - fm) : WGM;
        u.pm = fm + ((wgid % nig) % gsz); u.pn = (wgid % nig) / gsz; u.e = texp ? __builtin_amdgcn_readfirstlane(texp[u.pm]) : 0; return true;
    }
};
struct DenseRows { int lda; __device__ __forceinline__ unsigned rowoff(const Unit& u, int r) const { return (unsigned)(u.pm * BM + r) * (unsigned)lda; } };
struct GatherRows { const int* src; int lda; __device__ __forceinline__ unsigned rowoff(const Unit& u, int r) const { return (unsigned)src[u.pm * BM + r] * (unsigned)lda; } };
struct OneUnit { int pm, e; __device__ bool next(int i, Unit& u) const { if (i) return false; u.pm = pm; u.pn = 0; u.e = e; return true; } };
typedef float f32x2_t __attribute__((ext_vector_type(2))); typedef __bf16 bf16x2_t __attribute__((ext_vector_type(2)));
__device__ __forceinline__ unsigned cvt_pk_bf16(float lo, float hi) { f32x2_t v = {lo, hi}; bf16x2_t b = __builtin_convertvector(v, bf16x2_t); return __builtin_bit_cast(unsigned, b); }

template <class Epi, class ARow, class Sched>
__device__ __forceinline__ void gemm_phase(int tid0, PG8_LAS unsigned char* lds, const char* Abase, const char* Bbase, size_t b_estride, int K, const Sched& S, const ARow& AR, const Epi& E) {
    int tid = tid0; asm volatile("" : "+v"(tid));
    const int wid = __builtin_amdgcn_readfirstlane(tid >> 6), lane = tid & 63, wr = wid >> 2, wc = wid & 3, fr = lane & 15, fq = lane >> 4;
    const int nt = K / BK;
    int Rr[2], Cc[2]; unsigned voffB[2];
#pragma unroll
    for (int i = 0; i < 2; ++i) { int R, C; stage_rc(tid * 16 + i * 8192, R, C); const int Rb = Epi::PERM ? ((R & ~31) + perm32(R & 31)) : R; Rr[i] = R; Cc[i] = C; voffB[i] = (unsigned)(Rb * K + C) * 2u; }
    const size_t kstep = (size_t)(BK * 2), hstep = (size_t)HALF * K * 2, tstep = 2 * hstep;
    const unsigned ldsw = (unsigned)wid * 1024u;
    const int aoff = lds_byte(wr * 64 + fr, fq * 8), boff = lds_byte(wc * 32 + fr, fq * 8);
#define PG8_SA(b, h) (((b) * 2 + (h)) * HTB)
#define PG8_SB(b, h) ((4 + (b) * 2 + (h)) * HTB)
#define PG8_STAGE(bufoff, gbase, voff) do { _Pragma("unroll") for (int _i = 0; _i < 2; ++_i) \
        __builtin_amdgcn_global_load_lds((const unsigned*)((const char*)(gbase) + (voff)[_i]), (PG8_LAS unsigned*)(lds + (bufoff) + ldsw + _i * 8192), 16, 0, 0); } while (0)
#define PG8_LDA(dst, b, h) do { _Pragma("unroll") for (int m = 0; m < 4; ++m) _Pragma("unroll") for (int k = 0; k < 2; ++k) dst[m][k] = *(const PG8_LAS bf16x8*)(lds + PG8_SA(b, h) + aoff + m * 2048 + k * 1024); } while (0)
#define PG8_LDB(dst, b, h) do { _Pragma("unroll") for (int n = 0; n < 2; ++n) _Pragma("unroll") for (int k = 0; k < 2; ++k) dst[n][k] = *(const PG8_LAS bf16x8*)(lds + PG8_SB(b, h) + boff + n * 2048 + k * 1024); } while (0)
#define PG8_MMA(ai, bj, At, Bt) do { __builtin_amdgcn_s_setprio(1); _Pragma("unroll") for (int m = 0; m < 4; ++m) _Pragma("unroll") for (int n = 0; n < 2; ++n) _Pragma("unroll") for (int k = 0; k < 2; ++k) \
        acc[ai][bj][m][n] = __builtin_amdgcn_mfma_f32_16x16x32_bf16(Bt[n][k], At[m][k], acc[ai][bj][m][n], 0, 0, 0); __builtin_amdgcn_s_setprio(0); } while (0)
#define PG8_WAIT_V(n) asm volatile("s_waitcnt vmcnt(" #n ")" ::: "memory")
#define PG8_WAIT_L(n) asm volatile("s_waitcnt lgkmcnt(" #n ")" ::: "memory")
#define PG8_BAR __builtin_amdgcn_s_barrier()
#define PG8_SCHED __builtin_amdgcn_sched_barrier(0)
#define PG8_VOFF(dst, u) do { _Pragma("unroll") for (int _h = 0; _h < 2; ++_h) _Pragma("unroll") for (int _i = 0; _i < 2; ++_i) dst[_h][_i] = (AR.rowoff(u, _h * HALF + Rr[_i]) + (unsigned)Cc[_i]) * 2u; } while (0)
    Unit cur, nxt; int ui = 0;
    if (!S.next(0, cur)) return;
    f32x4 acc[2][2][4][2];
#pragma unroll
    for (int a = 0; a < 2; ++a)
#pragma unroll
        for (int b = 0; b < 2; ++b)
#pragma unroll
            for (int m = 0; m < 4; ++m)
#pragma unroll
                for (int n = 0; n < 2; ++n) acc[a][b][m][n] = (f32x4){0.f, 0.f, 0.f, 0.f};
    bf16x8 At[4][2], B0[2][2], B1[2][2];
    unsigned cvA[2][2], nvA[2][2];
    PG8_VOFF(cvA, cur);
    const char* cB = Bbase + (size_t)cur.e * b_estride + (size_t)cur.pn * tstep;
    PG8_STAGE(PG8_SB(0, 0), cB, voffB); PG8_STAGE(PG8_SB(0, 1), cB + hstep, voffB); PG8_STAGE(PG8_SA(0, 0), Abase, cvA[0]); PG8_STAGE(PG8_SA(0, 1), Abase, cvA[1]);
    if (wr == 1) PG8_BAR;
    PG8_WAIT_V(2); PG8_BAR;
    PG8_STAGE(PG8_SB(1, 0), cB + kstep, voffB); PG8_STAGE(PG8_SA(1, 0), Abase + kstep, cvA[0]); PG8_STAGE(PG8_SB(1, 1), cB + hstep + kstep, voffB);
    PG8_WAIT_V(6); PG8_BAR;
    for (;;) {
        const bool has_next = S.next(ui + 1, nxt);
        if (has_next) { PG8_VOFF(nvA, nxt); } else {
#pragma unroll
            for (int h = 0; h < 2; ++h)
#pragma unroll
                for (int i = 0; i < 2; ++i) nvA[h][i] = cvA[h][i]; }
        const char* nB = has_next ? Bbase + (size_t)nxt.e * b_estride + (size_t)nxt.pn * tstep : cB;
        for (int t = 0; t < nt; t += 2) {
            const bool last = (t == nt - 2);
            if constexpr (Epi::MID) { if (t == nt / 2) E.mid(acc, cur, wr, wc, fr, fq); }
            const char* a1 = Abase + (size_t)(t + 1) * kstep;
            const char* a2 = last ? Abase : Abase + (size_t)(t + 2) * kstep; const char* b2 = last ? nB : cB + (size_t)(t + 2) * kstep;
            const char* a3 = a2 + kstep; const char* b3 = b2 + kstep;
            unsigned v2[2][2];
#pragma unroll
            for (int h = 0; h < 2; ++h)
#pragma unroll
                for (int i = 0; i < 2; ++i) v2[h][i] = last ? nvA[h][i] : cvA[h][i];
            PG8_LDB(B0, 0, 0); PG8_LDB(B1, 0, 1); PG8_SCHED; PG8_LDA(At, 0, 0); PG8_STAGE(PG8_SA(1, 1), a1, cvA[1]);
            PG8_WAIT_V(8); PG8_WAIT_L(0); PG8_BAR; PG8_MMA(0, 0, At, B0); PG8_MMA(0, 1, At, B1); PG8_BAR; PG8_SCHED;
            PG8_LDA(At, 0, 1); PG8_STAGE(PG8_SB(0, 0), b2, voffB); PG8_STAGE(PG8_SB(0, 1), b2 + hstep, voffB); PG8_STAGE(PG8_SA(0, 0), a2, v2[0]);
            PG8_WAIT_V(8); PG8_WAIT_L(0); PG8_BAR; PG8_MMA(1, 0, At, B0); PG8_MMA(1, 1, At, B1); PG8_BAR; PG8_SCHED;
            PG8_LDB(B0, 1, 0); PG8_LDB(B1, 1, 1); PG8_SCHED; PG8_LDA(At, 1, 0); PG8_STAGE(PG8_SA(0, 1), a2, v2[1]);
            PG8_WAIT_V(8); PG8_WAIT_L(0); PG8_BAR; PG8_MMA(0, 0, At, B0); PG8_MMA(0, 1, At, B1); PG8_BAR; PG8_SCHED;
            PG8_LDA(At, 1, 1); PG8_STAGE(PG8_SB(1, 0), b3, voffB); PG8_STAGE(PG8_SB(1, 1), b3 + hstep, voffB); PG8_STAGE(PG8_SA(1, 0), a3, v2[0]);
            PG8_WAIT_V(8); PG8_WAIT_L(0); PG8_BAR; PG8_MMA(1, 0, At, B0); PG8_MMA(1, 1, At, B1); PG8_BAR; PG8_SCHED;
        }
        if (wr == 0) PG8_BAR;
        if constexpr (!Epi::AFTER) E(acc, cur, wr, wc, fr, fq);
        if (!has_next) break;
#pragma unroll
        for (int a = 0; a < 2; ++a)
#pragma unroll
            for (int b = 0; b < 2; ++b)
#pragma unroll
                for (int m = 0; m < 4; ++m)
#pragma unroll
                    for (int n = 0; n < 2; ++n) acc[a][b][m][n] = (f32x4){0.f, 0.f, 0.f, 0.f};
        cur = nxt; cB = nB; ++ui;
#pragma unroll
        for (int h = 0; h < 2; ++h)
#pragma unroll
            for (int i = 0; i < 2; ++i) cvA[h][i] = nvA[h][i];
        if (wr == 1) PG8_BAR;
    }
    PG8_WAIT_V(0);
    PG8_BAR;
    if constexpr (Epi::AFTER) E.after(acc, cur, wr, wc, fr, fq, lds);
#undef PG8_SA
#undef PG8_SB
#undef PG8_STAGE
#undef PG8_LDA
#undef PG8_LDB
#undef PG8_MMA
#undef PG8_WAIT_V
#undef PG8_WAIT_L
#undef PG8_BAR
#undef PG8_SCHED
#undef PG8_VOFF
}

__device__ __forceinline__ float sigm(float x) { return __builtin_amdgcn_rcpf(1.f + __builtin_amdgcn_exp2f(-1.4426950408889634f * x)); }
struct EpiSwiglu {
    static constexpr bool PERM = true, MID = false, AFTER = false;
    bf16_t* act; const float* b_gu; const float* rowscale;
    __device__ __forceinline__ void operator()(const f32x4 (&acc)[2][2][4][2], const Unit& u, int wr, int wc, int fr, int fq) const {
        const int row0 = u.pm * BM + wr * 64 + fr, col0 = u.pn * HALF + wc * 32 + 8 * fq;
        const float* bias = b_gu + (size_t)u.e * (2 * DFF) + col0;
        f32x4 bg[2], bu[2];
#pragma unroll
        for (int n = 0; n < 2; ++n) { bg[n] = *(const f32x4*)(bias + 4 * n); bu[n] = *(const f32x4*)(bias + DFF + 4 * n); }
#pragma unroll
        for (int ai = 0; ai < 2; ++ai)
#pragma unroll
            for (int m = 0; m < 4; ++m) { const int row = row0 + ai * HALF + m * 16; const float rs = rowscale[row];
                float o[8];
#pragma unroll
                for (int n = 0; n < 2; ++n)
#pragma unroll
                    for (int j = 0; j < 4; ++j) { const float g = fminf(acc[ai][0][m][n][j] * rs + bg[n][j], 7.f); const float up = fminf(fmaxf(acc[ai][1][m][n][j] * rs + bu[n][j], -7.f), 7.f);
                        o[4 * n + j] = g * sigm(1.702f * g) * (up + 1.f); }
                u32x4 w; w.x = cvt_pk_bf16(o[0], o[1]); w.y = cvt_pk_bf16(o[2], o[3]); w.z = cvt_pk_bf16(o[4], o[5]); w.w = cvt_pk_bf16(o[6], o[7]);
                *(u32x4*)(act + (size_t)row * DFF + col0) = w; }
    }
};
struct EpiScatter {
    static constexpr bool PERM = true, MID = false, AFTER = false;
    bf16_t* Y; const float* b_dn; const int* rowtok; const float* rowgate;
    __device__ __forceinline__ void operator()(const f32x4 (&acc)[2][2][4][2], const Unit& u, int wr, int wc, int fr, int fq) const {
        const int row0 = u.pm * BM + wr * 64 + fr, col0 = u.pn * BM + wc * 32 + 8 * fq;
        const float* bias = b_dn + (size_t)u.e * D + col0;
        f32x4 bv[2][2];
#pragma unroll
        for (int bj = 0; bj < 2; ++bj)
#pragma unroll
            for (int n = 0; n < 2; ++n) bv[bj][n] = *(const f32x4*)(bias + bj * HALF + 4 * n);
#pragma unroll
        for (int ai = 0; ai < 2; ++ai)
#pragma unroll
            for (int m = 0; m < 4; ++m) { const int row = row0 + ai * HALF + m * 16; const int id = rowtok[row]; const float gt = rowgate[row];
                if (id >= 0) { bf16_t* yp = Y + (size_t)id * D + col0;
#pragma unroll
                    for (int bj = 0; bj < 2; ++bj) { const f32x4 v0 = (acc[ai][bj][m][0] + bv[bj][0]) * gt, v1 = (acc[ai][bj][m][1] + bv[bj][1]) * gt;
                        u32x4 w; w.x = cvt_pk_bf16(v0[0], v0[1]); w.y = cvt_pk_bf16(v0[2], v0[3]); w.z = cvt_pk_bf16(v1[0], v1[1]); w.w = cvt_pk_bf16(v1[2], v1[3]);
                        *(u32x4*)(yp + bj * HALF) = w; } } }
    }
};
struct EpiQKVU {
    static constexpr bool PERM = true, MID = false, AFTER = false;
    bf16_t* O; size_t stride; bf16_t* ux;
    __device__ __forceinline__ void operator()(const f32x4 (&acc)[2][2][4][2], const Unit& u, int wr, int wc, int fr, int fq) const {
        const int row0 = u.pm * BM + wr * 64 + fr, t = u.pn >> 1; const float sc = (t == 0) ? C2 : 1.f;
        const int colt = (u.pn & 1) * BM + wc * 32 + 8 * fq;
        bf16_t* base = O + (size_t)t * stride + colt;
#pragma unroll
        for (int ai = 0; ai < 2; ++ai)
#pragma unroll
            for (int m = 0; m < 4; ++m) { const int row = row0 + ai * HALF + m * 16;
#pragma unroll
                for (int bj = 0; bj < 2; ++bj) { const f32x4 v0 = acc[ai][bj][m][0] * sc, v1 = acc[ai][bj][m][1] * sc;
                    u32x4 w; w.x = cvt_pk_bf16(v0[0], v0[1]); w.y = cvt_pk_bf16(v0[2], v0[3]); w.z = cvt_pk_bf16(v1[0], v1[1]); w.w = cvt_pk_bf16(v1[2], v1[3]);
                    if (t < 3) *(u32x4*)(base + (size_t)row * 512 + bj * HALF) = w;
                    else { const int col = colt + bj * HALF, g = col >> 4, b = row >> 12, tt = row & (S - 1);
                        *(u32x4*)(ux + ((size_t)((g * NB + b) * 256 + (tt >> 4))) * UXP + (tt & 15) * 16 + (col & 15)) = w; } } }
    }
};
struct EpiS5H {
    static constexpr bool PERM = false, MID = false, AFTER = true;
    bf16_t* ux; const float* a16;
    __device__ __forceinline__ void operator()(const f32x4 (&)[2][2][4][2], const Unit&, int, int, int, int) const {}
    __device__ __forceinline__ void after(const f32x4 (&acc)[2][2][4][2], const Unit& u, int wr, int wc, int fr, int fq, PG8_LAS unsigned char* lds) const {
        PG8_LAS float* Sx = (PG8_LAS float*)lds;
        const int row0 = wr * 64 + fr, col0 = wc * 32 + 4 * fq;
#pragma unroll
        for (int ai = 0; ai < 2; ++ai)
#pragma unroll
            for (int m = 0; m < 4; ++m)
#pragma unroll
                for (int n = 0; n < 2; ++n) *(PG8_LAS f32x4*)(Sx + (row0 + ai * HALF + m * 16) * 128 + col0 + n * 16) = acc[ai][0][m][n];
        asm volatile("s_waitcnt lgkmcnt(0)" ::: "memory"); __builtin_amdgcn_s_barrier(); asm volatile("" ::: "memory");
        int tq = (wr * 4 + wc) * 64 + fq * 16 + fr; asm volatile("" : "+v"(tq));
        if (tq < 64) {
            const int p = tq; const float ar = a16[2 * p], ai_ = a16[2 * p + 1]; float xr = 0.f, xi = 0.f;
            bf16_t* urow = ux + (size_t)u.pm * 256 * UXP + 256;
            urow[p] = 0; urow[64 + p] = 0;
#pragma unroll 8
            for (int c = 0; c < 255; ++c) { const float sr = Sx[c * 128 + p], si = Sx[c * 128 + 64 + p];
                const float nxr = ar * xr - ai_ * xi + sr, nxi = ar * xi + ai_ * xr + si; xr = nxr; xi = nxi;
                urow[(size_t)(c + 1) * UXP + p] = f2bf(xr); urow[(size_t)(c + 1) * UXP + 64 + p] = f2bf(xi); }
            asm volatile("s_waitcnt vmcnt(0)" ::: "memory");
        }
        asm volatile("s_waitcnt lgkmcnt(0)" ::: "memory"); __builtin_amdgcn_s_barrier(); asm volatile("" ::: "memory");
    }
};
struct EpiS5Y {
    static constexpr bool PERM = true, MID = false, AFTER = false;
    const bf16_t* ux; const float* d_skip; bf16_t* G;
    __device__ __forceinline__ void operator()(const f32x4 (&acc)[2][2][4][2], const Unit& u, int wr, int wc, int fr, int fq) const {
        const int row0 = wr * 64 + fr, g = u.e, b = u.pm & 7, co0 = 8 * (fq & 1);
        const f32x4 d0 = *(const f32x4*)(d_skip + g * 16 + co0), d1 = *(const f32x4*)(d_skip + g * 16 + co0 + 4);
#pragma unroll
        for (int ai = 0; ai < 2; ++ai)
#pragma unroll
            for (int m = 0; m < 4; ++m) { const int c = row0 + ai * HALF + m * 16;
#pragma unroll
                for (int bj = 0; bj < 2; ++bj) { const int ncol = bj * HALF + wc * 32 + 8 * fq, i = ncol >> 4;
                    const u32x4 uv = *(const u32x4*)(ux + ((size_t)u.pm * 256 + c) * UXP + ncol); float o[8];
#pragma unroll
                    for (int n = 0; n < 2; ++n)
#pragma unroll
                        for (int j = 0; j < 4; ++j) { const unsigned w = uv[2 * n + (j >> 1)]; const float uu = __builtin_bit_cast(float, (j & 1) ? (w & 0xffff0000u) : (w << 16));
                            const float y = acc[ai][bj][m][n][j] + (n ? d1[j] : d0[j]) * uu; o[4 * n + j] = y * sigm(1.5957691216057308f * (y + 0.044715f * y * y * y)); }
                    u32x4 w; w.x = cvt_pk_bf16(o[0], o[1]); w.y = cvt_pk_bf16(o[2], o[3]); w.z = cvt_pk_bf16(o[4], o[5]); w.w = cvt_pk_bf16(o[6], o[7]);
                    *(u32x4*)(G + ((size_t)b * S + c * 16 + i) * SW + g * 16 + co0) = w; } }
    }
};
struct EpiGlu {
    static constexpr bool PERM = true, MID = false, AFTER = false;
    const bf16_t* G; bf16_t* mixb; const float* b_glu; float* pss;
    __device__ __forceinline__ void operator()(const f32x4 (&acc)[2][2][4][2], const Unit& u, int wr, int wc, int fr, int fq) const {
        const int row0 = u.pm * BM + wr * 64 + fr, col0 = u.pn * BM + wc * 32 + 8 * fq;
        f32x4 bv[2][2];
#pragma unroll
        for (int bj = 0; bj < 2; ++bj)
#pragma unroll
            for (int n = 0; n < 2; ++n) bv[bj][n] = *(const f32x4*)(b_glu + col0 + bj * HALF + 4 * n);
#pragma unroll
        for (int ai = 0; ai < 2; ++ai)
#pragma unroll
            for (int m = 0; m < 4; ++m) { const int row = row0 + ai * HALF + m * 16; float ss = 0.f;
#pragma unroll
                for (int bj = 0; bj < 2; ++bj) { const u32x4 gv = *(const u32x4*)(G + (size_t)row * SW + col0 + bj * HALF); float o[8];
#pragma unroll
                    for (int n = 0; n < 2; ++n)
#pragma unroll
                        for (int j = 0; j < 4; ++j) { const unsigned w = gv[2 * n + (j >> 1)]; const float g = __builtin_bit_cast(float, (j & 1) ? (w & 0xffff0000u) : (w << 16));
                            const float v = g * sigm(acc[ai][bj][m][n][j] + bv[bj][n][j]); o[4 * n + j] = v; ss += v * v; }
                    u32x4 w; w.x = cvt_pk_bf16(o[0], o[1]); w.y = cvt_pk_bf16(o[2], o[3]); w.z = cvt_pk_bf16(o[4], o[5]); w.w = cvt_pk_bf16(o[6], o[7]);
                    *(u32x4*)(mixb + (size_t)row * D + AW + col0 + bj * HALF) = w; }
                ss += swz_xor<16>(ss); ss = xhalf_sum(ss);
                if (fq == 0) pss[(size_t)row * 8 + u.pn * 4 + wc] = ss; }
    }
};
struct EpiOut {
    static constexpr bool PERM = false, MID = true, AFTER = false;
    const float* x; float* x1; bf16_t* x1b; const float* psa; const float* pss;
    __device__ __forceinline__ float rsum8(const float* p) const { const f32x4 a = *(const f32x4*)p, b = *(const f32x4*)(p + 4); return ((a[0] + a[1]) + (a[2] + a[3])) + ((b[0] + b[1]) + (b[2] + b[3])); }
    __device__ __forceinline__ void mid(f32x4 (&acc)[2][2][4][2], const Unit& u, int wr, int wc, int fr, int fq) const {
        int row0 = u.pm * BM + wr * 64 + fr; asm volatile("" : "+v"(row0));
#pragma unroll
        for (int ai = 0; ai < 2; ++ai)
#pragma unroll
            for (int m = 0; m < 4; ++m) { const int row = row0 + ai * HALF + m * 16;
                const float ra = rsqrtf(rsum8(psa + (size_t)row * 8) * (1.f / AW) + EPS), rs = rsqrtf(rsum8(pss + (size_t)row * 8) * (1.f / SW) + EPS); const float f = ra / rs;
#pragma unroll
                for (int bj = 0; bj < 2; ++bj)
#pragma unroll
                    for (int n = 0; n < 2; ++n) acc[ai][bj][m][n] *= f;
                asm volatile("" ::: "memory"); }
    }
    __device__ __forceinline__ void operator()(const f32x4 (&acc)[2][2][4][2], const Unit& u, int wr, int wc, int fr, int fq) const {
        int row0 = u.pm * BM + wr * 64 + fr; asm volatile("" : "+v"(row0)); const int col0 = u.pn * BM + wc * 32 + 4 * fq;
#pragma unroll
        for (int ai = 0; ai < 2; ++ai)
#pragma unroll
            for (int m = 0; m < 4; ++m) { const int row = row0 + ai * HALF + m * 16; const float rs = rsqrtf(rsum8(pss + (size_t)row * 8) * (1.f / SW) + EPS); const size_t off = (size_t)row * D + col0;
#pragma unroll
                for (int bj = 0; bj < 2; ++bj)
#pragma unroll
                    for (int n = 0; n < 2; ++n) { const size_t o2 = off + bj * HALF + n * 16; const f32x4 v = *(const f32x4*)(x + o2) + acc[ai][bj][m][n] * rs;
                        *(f32x4*)(x1 + o2) = v; uint2 w; w.x = cvt_pk_bf16(v[0], v[1]); w.y = cvt_pk_bf16(v[2], v[3]); *(uint2*)(x1b + o2) = w; }
                asm volatile("" ::: "memory"); }
    }
};
struct EpiGate {
    static constexpr bool PERM = false, MID = false, AFTER = false;
    bf16_t* gs;
    __device__ __forceinline__ void operator()(const f32x4 (&acc)[2][2][4][2], const Unit& u, int wr, int wc, int fr, int fq) const {
        const int row0 = u.pm * BM + wr * 64 + fr, col0 = u.pn * BM + wc * 32 + 4 * fq;
#pragma unroll
        for (int ai = 0; ai < 2; ++ai)
#pragma unroll
            for (int m = 0; m < 4; ++m) { const size_t off = (size_t)(row0 + ai * HALF + m * 16) * D + col0;
#pragma unroll
                for (int bj = 0; bj < 2; ++bj)
#pragma unroll
                    for (int n = 0; n < 2; ++n) { const f32x4 a = acc[ai][bj][m][n]; uint2 w; w.x = cvt_pk_bf16(sigm(a[0]), sigm(a[1])); w.y = cvt_pk_bf16(sigm(a[2]), sigm(a[3])); *(uint2*)(gs + off + bj * HALF + n * 16) = w; } }
    }
};
struct EpiPle {
    static constexpr bool PERM = false, MID = false, AFTER = false;
    const bf16_t* gs; float* x2;
    __device__ __forceinline__ void operator()(const f32x4 (&acc)[2][2][4][2], const Unit& u, int wr, int wc, int fr, int fq) const {
        const int row0 = u.pm * BM + wr * 64 + fr, col0 = u.pn * BM + wc * 32 + 4 * fq;
#pragma unroll
        for (int ai = 0; ai < 2; ++ai)
#pragma unroll
            for (int m = 0; m < 4; ++m) { const size_t off = (size_t)(row0 + ai * HALF + m * 16) * D + col0;
#pragma unroll
                for (int bj = 0; bj < 2; ++bj)
#pragma unroll
                    for (int n = 0; n < 2; ++n) { const size_t o2 = off + bj * HALF + n * 16;
                        const unsigned long long gw_ = __hip_atomic_load((const unsigned long long*)(gs + o2), __ATOMIC_RELAXED, __HIP_MEMORY_SCOPE_AGENT);
                        const unsigned lo = (unsigned)gw_, hi = (unsigned)(gw_ >> 32);
                        f32x4 g; g[0] = __builtin_bit_cast(float, lo << 16); g[1] = __builtin_bit_cast(float, lo & 0xffff0000u); g[2] = __builtin_bit_cast(float, hi << 16); g[3] = __builtin_bit_cast(float, hi & 0xffff0000u);
                        *(f32x4*)(x2 + o2) = *(const f32x4*)(x2 + o2) + g * acc[ai][bj][m][n]; } }
    }
};
}

struct TrItem { const float* W; const float* kscale; bf16_t* WT; int ldw, k0, c0, K, r0; };
__device__ __forceinline__ void tr_load(const TrItem& d, float (&v)[32], int lane) {
    const float* p = d.W + (size_t)(d.k0 + (lane >> 5)) * d.ldw + d.c0 + (lane & 31);
#pragma unroll
    for (int i = 0; i < 32; ++i) v[i] = p[(size_t)(2 * i) * d.ldw];
}
__device__ __forceinline__ void tr_store(const TrItem& d, const float (&v)[32], __attribute__((address_space(3))) float* scr, int lane) {
    const int c = lane & 7;
    float ks[8];
#pragma unroll
    for (int j = 0; j < 8; ++j) ks[j] = d.kscale ? d.kscale[d.k0 + 8 * c + j] : 1.f;
#pragma unroll
    for (int i = 0; i < 32; ++i) scr[(2 * i + (lane >> 5)) * 33 + (lane & 31)] = v[i];
    __builtin_amdgcn_s_waitcnt(0xC07F); asm volatile("" ::: "memory");
#pragma unroll
    for (int j = 0; j < 4; ++j) { const int n = (lane >> 3) + 8 * j; const __attribute__((address_space(3))) float* s = scr + (8 * c) * 33 + n;
        uint4 o; o.x = pk2(s[0 * 33] * ks[0], s[1 * 33] * ks[1]); o.y = pk2(s[2 * 33] * ks[2], s[3 * 33] * ks[3]); o.z = pk2(s[4 * 33] * ks[4], s[5 * 33] * ks[5]); o.w = pk2(s[6 * 33] * ks[6], s[7 * 33] * ks[7]);
        *(uint4*)(d.WT + (size_t)(d.r0 + n) * d.K + d.k0 + 8 * c) = o; }
    __builtin_amdgcn_s_waitcnt(0xC07F); asm volatile("" ::: "memory");
}

namespace attn_body {
using bf16x8=__attribute__((ext_vector_type(8)))short;
using s16x4=__attribute__((ext_vector_type(4)))short;
using f32x16=__attribute__((ext_vector_type(16)))float;
using f32x4=__attribute__((ext_vector_type(4)))float;
using u32x4=__attribute__((ext_vector_type(4)))unsigned;
constexpr int SEQ=S,DH=64,DM=NH*DH,OPITCH=D;
constexpr int NW=8,QBLK=32,QB=QBLK*NW,KVBLK=64,NQB=SEQ/QB;
__device__ __forceinline__ int crow(int r,int hi){return (r&3)+8*(r>>2)+4*hi;}
#define SBAR() __builtin_amdgcn_sched_barrier(0)
__device__ __forceinline__ void cmask(f32x16&p0,f32x16&p1,int jb,int qrel,int hi){
  const float NEG=-INFINITY; int kb=64*jb+4*hi;
  #pragma unroll
  for(int r=0;r<16;++r){int kv=kb+(r&3)+8*(r>>2); if(kv>qrel)p0[r]=NEG; if(kv+32>qrel)p1[r]=NEG;}
}
constexpr int NSLOT=3, SLOTB=8192;
constexpr int LDS_K=0, LDS_V=NSLOT*SLOTB, LDS_WS=2*NSLOT*SLOTB, LDS_OST=LDS_WS+NW*64*4, LDS_C=LDS_OST+NW*4096, ATT_LDS_BYTES=LDS_C+(SEQ+64)*4;
__device__ __forceinline__ void glds16(const void*gsrc,unsigned lds_dst){unsigned keep;
  asm volatile("s_mov_b32 %0, m0\n\ts_mov_b32 m0, %2\n\ts_nop 0\n\tglobal_load_lds_dwordx4 %1, off\n\ts_mov_b32 m0, %0":"=&s"(keep):"v"(gsrc),"s"(lds_dst):"memory");}
__device__ __forceinline__ float max3f(float a,float b,float c){float r;asm("v_max3_f32 %0, %1, %2, %3":"=v"(r):"v"(a),"v"(b),"v"(c));return r;}
__device__ __forceinline__ float max2f(float a,float b){float r;asm("v_max_f32_e32 %0, %1, %2":"=v"(r):"v"(a),"v"(b));return r;}
__device__ __forceinline__ float fadd_s(float a,float b){float r;asm("v_add_f32_e32 %0, %1, %2":"=v"(r):"v"(a),"v"(b));return r;}
__device__ __forceinline__ float fsub_s(float a,float b){float r;asm("v_sub_f32_e32 %0, %1, %2":"=v"(r):"v"(a),"v"(b));return r;}
typedef float f32x2_t __attribute__((ext_vector_type(2))); typedef __bf16 bf16x2_t __attribute__((ext_vector_type(2)));
__device__ __forceinline__ unsigned cvtpk_s(float lo,float hi){f32x2_t v={lo,hi};bf16x2_t b=__builtin_convertvector(v,bf16x2_t);return __builtin_bit_cast(unsigned,b);}
#define WAIT_BAR(N) asm volatile("s_waitcnt vmcnt(" #N ") lgkmcnt(0)\n\ts_barrier":::"memory")
typedef __attribute__((address_space(3))) const char* lds_cptr;
typedef __attribute__((address_space(3))) const float* lds_fptr;
typedef short v4i16_t __attribute__((ext_vector_type(4)));
__device__ __forceinline__ void qkt(f32x16&p0,f32x16&p1,const char*Kslot,const bf16x8*qr,int r32,int hi){
  const char*kb=Kslot+hi*1024+r32*16;
  #pragma unroll
  for(int d0=0;d0<4;++d0){
    const bf16x8 b0=*reinterpret_cast<const bf16x8*>(kb+d0*2048);
    const bf16x8 b1=*reinterpret_cast<const bf16x8*>(kb+d0*2048+512);
    p0=__builtin_amdgcn_mfma_f32_32x32x16_bf16(b0,qr[d0],p0,0,0,0);p1=__builtin_amdgcn_mfma_f32_32x32x16_bf16(b1,qr[d0],p1,0,0,0);}
}
__device__ __forceinline__ void kload8(bf16x8*kf,lds_cptr kp){
  kf[0]=*(const __attribute__((address_space(3))) bf16x8*)(kp);      kf[1]=*(const __attribute__((address_space(3))) bf16x8*)(kp+512);
  kf[2]=*(const __attribute__((address_space(3))) bf16x8*)(kp+2048); kf[3]=*(const __attribute__((address_space(3))) bf16x8*)(kp+2560);
  kf[4]=*(const __attribute__((address_space(3))) bf16x8*)(kp+4096); kf[5]=*(const __attribute__((address_space(3))) bf16x8*)(kp+4608);
  kf[6]=*(const __attribute__((address_space(3))) bf16x8*)(kp+6144); kf[7]=*(const __attribute__((address_space(3))) bf16x8*)(kp+6656);
}
__device__ __forceinline__ void kload2(bf16x8*kf,lds_cptr kp,int j){ kf[2*j]=*(const __attribute__((address_space(3))) bf16x8*)(kp+j*2048); kf[2*j+1]=*(const __attribute__((address_space(3))) bf16x8*)(kp+j*2048+512); }
__device__ __forceinline__ s16x4 vtr(lds_cptr p){ return __builtin_bit_cast(s16x4,__builtin_amdgcn_ds_read_tr16_b64_v4i16((__attribute__((address_space(3))) v4i16_t*)p)); }
__device__ __forceinline__ float rowmax(const f32x16&p0,const f32x16&p1){
  float a=max3f(p0[0],p0[1],p1[0]),b=max3f(p0[2],p0[3],p1[1]);a=max3f(a,p1[2],p1[3]);
  #pragma unroll
  for(int r=4;r<16;r+=4){a=max3f(a,p0[r],p0[r+1]);b=max3f(b,p0[r+2],p0[r+3]);a=max3f(a,p1[r],p1[r+1]);b=max3f(b,p1[r+2],p1[r+3]);}
  const float m=max2f(a,b);
  auto rr=__builtin_amdgcn_permlane32_swap(__float_as_uint(m),__float_as_uint(m),false,false);
  return max2f(__uint_as_float(rr[0]),__uint_as_float(rr[1]));
}
__device__ __forceinline__ void pv(f32x16*o,int vb,bf16x8 pa0,bf16x8 pa1,bf16x8 pa2,bf16x8 pa3){
  #pragma unroll
  for(int d0=0;d0<2;++d0){s16x4 lo[4],hi[4];
    #pragma unroll
    for(int ks=0;ks<4;++ks){
      asm volatile("ds_read_b64_tr_b16 %0,%1 offset:%c2":"=&v"(lo[ks]):"v"(vb),"i"(d0*4096+ks*1024):"memory");
      asm volatile("ds_read_b64_tr_b16 %0,%1 offset:%c2":"=&v"(hi[ks]):"v"(vb),"i"(d0*4096+ks*1024+512):"memory");}
    asm volatile("s_waitcnt lgkmcnt(0)":::"memory");SBAR();
    #define PK(k) (bf16x8){lo[k][0],lo[k][1],lo[k][2],lo[k][3],hi[k][0],hi[k][1],hi[k][2],hi[k][3]}
    o[d0]=__builtin_amdgcn_mfma_f32_32x32x16_bf16(pa0,PK(0),o[d0],0,0,0);
    o[d0]=__builtin_amdgcn_mfma_f32_32x32x16_bf16(pa1,PK(1),o[d0],0,0,0);
    o[d0]=__builtin_amdgcn_mfma_f32_32x32x16_bf16(pa2,PK(2),o[d0],0,0,0);
    o[d0]=__builtin_amdgcn_mfma_f32_32x32x16_bf16(pa3,PK(3),o[d0],0,0,0);
    #undef PK
  }
}
__device__ __forceinline__ void prep_c(int tid0,int b,int h,const float*logf,char*shm){
  int tid=tid0; asm volatile("":"+v"(tid)); const int lane=tid&63,wid=tid>>6;
  float*cl=(float*)(shm+LDS_C); float*wtot=(float*)(shm+LDS_WS);
  float v[8]; float tot=0.f;
  #pragma unroll
  for(int i=0;i<8;++i){ v[i]=logf[((size_t)b*SEQ+tid*8+i)*8+h]; tot+=v[i]; }
  float incl=tot;
  #pragma unroll
  for(int o=1;o<64;o<<=1){ const float n=bperm(incl,(lane-o)&63); if(lane>=o)incl+=n; }
  if(lane==63)wtot[wid]=incl;
  __syncthreads();
  float pre=incl-tot;
  #pragma unroll
  for(int w=0;w<8;++w) if(w<wid)pre+=wtot[w];
  #pragma unroll
  for(int i=0;i<8;++i){ pre+=v[i]; cl[tid*8+i]=pre*LOG2E; }
  if(tid<64)cl[SEQ+tid]=0.f;
  __syncthreads();
}
template<int THRL> __device__ __forceinline__ void attn_unit(int tid0,int b,int h,int qb,const bf16_t*Q,const bf16_t*__restrict__ K,const bf16_t*__restrict__ V,bf16_t*O,float*psa,char*shm){
  int tid=tid0; asm volatile("":"+v"(tid)); const int lane=tid&63,r32=lane&31,hi=lane>>5; const int wid=__builtin_amdgcn_readfirstlane(tid>>6);
  const long rowbase=(long)b*SEQ; const int q0=qb*QB;
  const bf16_t*Qw=Q+(rowbase+q0+wid*QBLK)*DM+h*DH;
  const bf16_t*Kh=K+rowbase*DM+h*DH,*Vh=V+rowbase*DM+h*DH;
  const unsigned lds0=(unsigned)(uintptr_t)shm;
  float*wsf=(float*)(shm+LDS_WS)+wid*64;
  const bf16_t*ksrc=Kh+(long)lane*DM+wid*8;
  const bf16_t*vsrc=Vh+(long)(16*(wid&3)+(lane>>2))*DM+(wid>>2)*32+(lane&3)*8;
  const unsigned kdst=lds0+LDS_K+wid*1024, vdst=lds0+LDS_V+wid*1024;
  #define DMA_K(t,slot) glds16(ksrc+(long)(t)*KVBLK*DM,(unsigned)__builtin_amdgcn_readfirstlane(kdst+(slot)))
  #define DMA_V(t,slot) glds16(vsrc+(long)(t)*KVBLK*DM,(unsigned)__builtin_amdgcn_readfirstlane(vdst+(slot)))
  const int vb0=(int)(lds0+LDS_V)+((lane>>4)&1)*32+(lane&3)*8+(4*hi+((lane&15)>>2))*64;
  const char*Kbase=shm+LDS_K; bf16x8 kf[8];
  const lds_cptr shm3=(lds_cptr)shm; const lds_cptr kp0=shm3+LDS_K+hi*1024+r32*16; const lds_cptr vp0=shm3+LDS_V+((lane>>4)&1)*32+(lane&3)*8+(4*hi+((lane&15)>>2))*64;
  const lds_fptr clh=(lds_fptr)(shm3+LDS_C)+4*hi;
  const int NT=(q0+QB)/KVBLK;
  DMA_K(0,0);DMA_V(0,0);DMA_K(1,SLOTB);
  bf16x8 qr[4];
  #pragma unroll
  for(int d0=0;d0<4;++d0)qr[d0]=*reinterpret_cast<const bf16x8*>(&Qw[(long)r32*DM+d0*16+hi*8]);
  float mhat=0.f,l_reg=0.f;f32x16 o[2];o[0]=f32x16{};o[1]=f32x16{};
  const int qrel=wid*QBLK+r32;
  const float cq2=((lds_fptr)(shm3+LDS_C))[q0+qrel];
  #define CMASK(P0,P1,t) do{int jb_=(t)-(NT-4); if(jb_>=0)cmask(P0,P1,jb_,qrel,hi);}while(0)
  #define CINIT(P0,P1,tt,basev_) do{ _Pragma("unroll") for(int g_=0;g_<4;++g_){ const f32x4 a_=*(const __attribute__((address_space(3))) f32x4*)(clh+64*(tt)+8*g_); const f32x4 b_=*(const __attribute__((address_space(3))) f32x4*)(clh+64*(tt)+32+8*g_); \
      _Pragma("unroll") for(int j_=0;j_<4;++j_){ P0[4*g_+j_]=(basev_)-a_[j_]; P1[4*g_+j_]=(basev_)-b_[j_]; } } }while(0)
  bool resc=false;
  #define START(P0,P1) do{ const float rm=rowmax(P0,P1); resc=false; \
    { const float dl=rm; mhat=fadd_s(mhat,dl); \
      _Pragma("unroll") for(int r=0;r<16;++r){P0[r]=fsub_s(P0[r],dl);P1[r]=fsub_s(P1[r],dl);} } \
    _Pragma("unroll") for(int r=0;r<16;++r)P0[r]=__builtin_amdgcn_exp2f(P0[r]); }while(0)
  #define RESC() do{ if(resc){ asm volatile("s_waitcnt lgkmcnt(0)":::"memory"); \
      _Pragma("unroll") for(int d_=0;d_<2;++d_) _Pragma("unroll") for(int r=0;r<16;++r)o[d_][r]*=wsf[crow(r,hi)]; } }while(0)
  f32x16 pA0,pA1,pB0,pB1;
  int sl_prev=0,sl_cur=0,sl_next=SLOTB;
  #define ROT() do{sl_prev=sl_cur;sl_cur=sl_next;sl_next=(sl_next==(NSLOT-1)*SLOTB)?0:sl_next+SLOTB;}while(0)
  DMA_K(2,2*SLOTB);
  CINIT(pA0,pA1,0,cq2);
  WAIT_BAR(3);
  qkt(pA0,pA1,Kbase,qr,r32,hi);asm volatile("s_nop 15\n\ts_nop 7":"+v"(pA0),"+v"(pA1));CMASK(pA0,pA1,0);
  START(pA0,pA1);
  _Pragma("unroll") for(int r=0;r<16;++r)pA1[r]=__builtin_amdgcn_exp2f(pA1[r]);
  { const float bv0=cq2-mhat; CINIT(pB0,pB1,1,bv0); }
  WAIT_BAR(0);
  DMA_K(3,0);DMA_V(1,SLOTB);
  ROT();
  kload8(kf,kp0+sl_cur);
  WAIT_BAR(2);
  s16x4 vlo[8],vhi[8]; u32x4 pw0,pw1,pw2,pw3;
  #define PKW(P,B) cvtpk_s(P[B],P[B+1])
  #define PAF(k) __builtin_bit_cast(bf16x8,pw##k)
  #define VFR(i) (bf16x8){vlo[i][0],vlo[i][1],vlo[i][2],vlo[i][3],vhi[i][0],vhi[i][1],vhi[i][2],vhi[i][3]}
  #define PIN(x) asm volatile("":"+v"(x))
  #define MX3(a,b,c) __builtin_fmaxf(__builtin_fmaxf((a),(b)),(c))
  #define GAPA(MF,A0,A1,A2,A3,W0,W1,PW) do{ MF; sacc+=A0; sacc+=A1; sacc+=A2; sacc+=A3; PIN(sacc); W0; W1; PIN(PW); SBAR(); }while(0)
  #define EX(v) __builtin_amdgcn_exp2f(v)
  #define CKRD(i) (*(const __attribute__((address_space(3))) f32x4*)(clt_+(((i)>>2)*32+((i)&3)*8)))
  #define GAPB(MF,X,B,PN,G,IROW) do{ const f32x4 ck_=CKRD(IROW); MF; X[B]=EX(X[B]); X[B+1]=EX(X[B+1]); X[B+2]=EX(X[B+2]); X[B+3]=EX(X[B+3]); PIN(X); \
      PN[4*(G)]=basev-ck_[0]; PN[4*(G)+1]=basev-ck_[1]; PN[4*(G)+2]=basev-ck_[2]; PN[4*(G)+3]=basev-ck_[3]; PIN(PN); SBAR(); }while(0)
  #define VRD(i) do{ vlo[i]=vtr(vp_+(((i)>>2)*4096+((i)&3)*1024)); vhi[i]=vtr(vp_+(((i)>>2)*4096+((i)&3)*1024+512)); }while(0)
  #define KRD(G,j) do{ if(G){ kload2(kf,kp0+sl_next,j); SBAR(); } }while(0)
  #define STEP(C0,C1,P0,P1,t,GK,GV,GL) do{ SBAR(); \
    const lds_cptr vp_=vp0+sl_prev; const lds_fptr clt_=clh+64*((t)+1); \
    VRD(0); SBAR(); float sacc=(P0[0]+P0[1]); \
    GAPA(C0=__builtin_amdgcn_mfma_f32_32x32x16_bf16(kf[0],qr[0],C0,0,0,0), P0[2],P0[3],P0[4],P0[5],     pw0[0]=PKW(P0,0), pw0[1]=PKW(P0,2), pw0); \
    VRD(4); SBAR(); GAPA(C1=__builtin_amdgcn_mfma_f32_32x32x16_bf16(kf[1],qr[0],C1,0,0,0), P0[6],P0[7],P0[8],P0[9],     pw0[2]=PKW(P0,4), pw0[3]=PKW(P0,6), pw0); \
    VRD(1); SBAR(); GAPA(C0=__builtin_amdgcn_mfma_f32_32x32x16_bf16(kf[2],qr[1],C0,0,0,0),   P0[10],P0[11],P0[12],P0[13], pw1[0]=PKW(P0,8), pw1[1]=PKW(P0,10), pw1); \
    VRD(5); SBAR(); GAPA(C1=__builtin_amdgcn_mfma_f32_32x32x16_bf16(kf[3],qr[1],C1,0,0,0),   P0[14],P0[15],P1[0],P1[1],   pw1[2]=PKW(P0,12),pw1[3]=PKW(P0,14), pw1); \
    VRD(2); SBAR(); GAPA(C0=__builtin_amdgcn_mfma_f32_32x32x16_bf16(kf[4],qr[2],C0,0,0,0),   P1[2],P1[3],P1[4],P1[5],     pw2[0]=PKW(P1,0), pw2[1]=PKW(P1,2), pw2); \
    VRD(6); SBAR(); GAPA(C1=__builtin_amdgcn_mfma_f32_32x32x16_bf16(kf[5],qr[2],C1,0,0,0),   P1[6],P1[7],P1[8],P1[9],     pw2[2]=PKW(P1,4), pw2[3]=PKW(P1,6), pw2); \
    VRD(3); SBAR(); GAPA(C0=__builtin_amdgcn_mfma_f32_32x32x16_bf16(kf[6],qr[3],C0,0,0,0),   P1[10],P1[11],P1[12],P1[13], pw3[0]=PKW(P1,8), pw3[1]=PKW(P1,10), pw3); \
    VRD(7); SBAR(); GAPA(C1=__builtin_amdgcn_mfma_f32_32x32x16_bf16(kf[7],qr[3],C1,0,0,0),   P1[14],P1[15],0.f,0.f,       pw3[2]=PKW(P1,12),pw3[3]=PKW(P1,14), pw3); \
    l_reg+=sacc; \
    if(GK){DMA_K((t)+3,sl_cur);} if(GV){DMA_V((t)+1,sl_next);} \
    CMASK(C0,C1,t); \
    { float a=MX3(C0[0],C0[1],C1[0]),b=MX3(C0[2],C0[3],C1[1]); a=MX3(a,C1[2],C1[3]); \
      _Pragma("unroll") for(int r=4;r<16;r+=4){a=MX3(a,C0[r],C0[r+1]);b=MX3(b,C0[r+2],C0[r+3]);a=MX3(a,C1[r],C1[r+1]);b=MX3(b,C1[r+2],C1[r+3]);} \
      float rm=__builtin_fmaxf(a,b); { auto rr=__builtin_amdgcn_permlane32_swap(__float_as_uint(rm),__float_as_uint(rm),false,false); rm=__builtin_fmaxf(__uint_as_float(rr[0]),__uint_as_float(rr[1])); } \
      resc=false; \
      if(__builtin_expect(__any(rm>(float)THRL),0)){ const float dl=__builtin_fmaxf(rm,0.f); mhat+=dl; \
        _Pragma("unroll") for(int r=0;r<16;++r){C0[r]-=dl;C1[r]-=dl;} \
        const float f=__builtin_amdgcn_exp2f(-dl); l_reg*=f; if(hi==0)wsf[r32]=f; resc=true; } } \
    const float basev=cq2-mhat; \
    SBAR(); \
    GAPB(o[0]=__builtin_amdgcn_mfma_f32_32x32x16_bf16(PAF(0),VFR(0),o[0],0,0,0), C0,0,  P0,0,0); \
    GAPB(o[1]=__builtin_amdgcn_mfma_f32_32x32x16_bf16(PAF(0),VFR(4),o[1],0,0,0), C0,4,  P0,1,1); \
    KRD(GL,0); GAPB(o[0]=__builtin_amdgcn_mfma_f32_32x32x16_bf16(PAF(1),VFR(1),o[0],0,0,0), C0,8,  P0,2,2); \
    KRD(GL,1); GAPB(o[1]=__builtin_amdgcn_mfma_f32_32x32x16_bf16(PAF(1),VFR(5),o[1],0,0,0), C0,12, P0,3,3); \
    KRD(GL,2); GAPB(o[0]=__builtin_amdgcn_mfma_f32_32x32x16_bf16(PAF(2),VFR(2),o[0],0,0,0), C1,0,  P1,0,4); \
    KRD(GL,3); GAPB(o[1]=__builtin_amdgcn_mfma_f32_32x32x16_bf16(PAF(2),VFR(6),o[1],0,0,0), C1,4,  P1,1,5); \
    GAPB(o[0]=__builtin_amdgcn_mfma_f32_32x32x16_bf16(PAF(3),VFR(3),o[0],0,0,0), C1,8,  P1,2,6); \
    GAPB(o[1]=__builtin_amdgcn_mfma_f32_32x32x16_bf16(PAF(3),VFR(7),o[1],0,0,0), C1,12, P1,3,7); \
    }while(0)
  int t=1;
  #undef CMASK
  #define CMASK(P0,P1,t) do{}while(0)
  for(;t+5<NT;t+=2){
    STEP(pB0,pB1,pA0,pA1,t,true,true,true);     WAIT_BAR(2); RESC(); ROT();
    STEP(pA0,pA1,pB0,pB1,t+1,true,true,true);   WAIT_BAR(2); RESC(); ROT();
  }
  #undef CMASK
  #define CMASK(P0,P1,t) do{int jb_=(t)-(NT-4); if(jb_>=0)cmask(P0,P1,jb_,qrel,hi);}while(0)
  #define ENDW(tt) do{ if((tt)+3<NT){WAIT_BAR(2);} else if((tt)+2<NT){WAIT_BAR(1);} else {WAIT_BAR(0);} }while(0)
  for(;t+1<NT;t+=2){
    STEP(pB0,pB1,pA0,pA1,t,(t+3<NT),(t+1<NT),(t+1<NT));       ENDW(t);   RESC(); ROT();
    STEP(pA0,pA1,pB0,pB1,t+1,(t+4<NT),(t+2<NT),(t+2<NT));     ENDW(t+1); RESC(); ROT();
  }
  STEP(pB0,pB1,pA0,pA1,NT-1,false,false,false); RESC();
  { float sacc=pB0[0]+pB0[1]; _Pragma("unroll") for(int r=2;r<16;++r)sacc+=pB0[r]; _Pragma("unroll") for(int r=0;r<16;++r)sacc+=pB1[r]; l_reg+=sacc;
    pw0=(u32x4){PKW(pB0,0),PKW(pB0,2),PKW(pB0,4),PKW(pB0,6)};pw1=(u32x4){PKW(pB0,8),PKW(pB0,10),PKW(pB0,12),PKW(pB0,14)};pw2=(u32x4){PKW(pB1,0),PKW(pB1,2),PKW(pB1,4),PKW(pB1,6)};pw3=(u32x4){PKW(pB1,8),PKW(pB1,10),PKW(pB1,12),PKW(pB1,14)};
    SBAR(); pv(o,vb0+sl_cur,PAF(0),PAF(1),PAF(2),PAF(3)); }
  #undef PKW
  #undef PAF
  #undef VFR
  #undef PIN
  #undef MX3
  #undef GAPA
  #undef GAPB
  #undef CKRD
  #undef EX
  #undef VRD
  #undef KRD
  #undef STEP
  #undef ENDW
  {auto rr=__builtin_amdgcn_permlane32_swap(__float_as_uint(l_reg),__float_as_uint(l_reg),false,false);l_reg=__uint_as_float(rr[0])+__uint_as_float(rr[1]);}
  if(hi==0)wsf[32+r32]=l_reg;asm volatile("s_waitcnt lgkmcnt(0)":::"memory");
  float rli[16];
  #pragma unroll
  for(int r=0;r<16;++r)rli[r]=__builtin_amdgcn_rcpf(wsf[32+crow(r,hi)]);
  bf16_t*Ow=O+(rowbase+q0+wid*QBLK)*OPITCH+h*DH;
  { bf16_t*stg=(bf16_t*)(shm+LDS_OST)+wid*2048;
    #pragma unroll
    for(int r=0;r<16;++r){const int orow=crow(r,hi);
      #pragma unroll
      for(int d0=0;d0<2;++d0)stg[orow*64+d0*32+r32]=f2bf(o[d0][r]*rli[r]);}
    asm volatile("s_waitcnt lgkmcnt(0)":::"memory");
    #pragma unroll
    for(int i=0;i<4;++i){const int row=i*8+(lane>>3),ch=lane&7; const u32x4 v=*(const u32x4*)(stg+row*64+ch*8); *(u32x4*)(Ow+(long)row*OPITCH+ch*8)=v;
      float ss=0.f;
      #pragma unroll
      for(int j=0;j<4;++j){ const float lo_=__builtin_bit_cast(float,v[j]<<16), hi_=__builtin_bit_cast(float,v[j]&0xffff0000u); ss+=lo_*lo_+hi_*hi_; }
      ss+=swz_xor<1>(ss); ss+=swz_xor<2>(ss); ss+=swz_xor<4>(ss);
      if(ch==0)psa[(rowbase+q0+wid*QBLK+row)*8+h]=ss; } }
  asm volatile("s_waitcnt lgkmcnt(0)\n\ts_barrier":::"memory");
  #undef DMA_K
  #undef DMA_V
  #undef CMASK
  #undef CINIT
  #undef START
  #undef RESC
  #undef ROT
}
#undef SBAR
#undef WAIT_BAR
}

__device__ void s5_precompute(int g, const float* lam_re, const float* lam_im, const float* log_dt, const float* b_re, const float* b_im, const float* c_re, const float* c_im,
                              bf16_t* bth, bf16_t* bttg, float* a16, float* sm) {
    float* apr = sm; float* api = apr + 17 * 64; float* bbr = api + 17 * 64; float* bbi = bbr + 1024; float* cr = bbi + 1024; float* ci = cr + 1024; float* Kt = ci + 1024;
    const int tid = threadIdx.x;
    if (tid < 64) { const int p = tid; const float dt = __expf(log_dt[g]); const float lr = lam_re[g * NP + p], li = lam_im[g * NP + p];
        for (int tau = 0; tau <= 16; ++tau) { const float mag = __expf(lr * dt * (float)tau), ang = li * dt * (float)tau; apr[tau * 64 + p] = mag * cosf(ang); api[tau * 64 + p] = mag * sinf(ang); }
        const float abr = apr[64 + p], abi = api[64 + p], den = lr * lr + li * li, nr = abr - 1.f; const float zr = (nr * lr + abi * li) / den, zi = (abi * lr - nr * li) / den;
        for (int c = 0; c < NC; ++c) { const float br = b_re[(size_t)(g * NP + p) * NC + c], bi = b_im[(size_t)(g * NP + p) * NC + c]; bbr[p * 16 + c] = zr * br - zi * bi; bbi[p * 16 + c] = zr * bi + zi * br; }
        a16[(g * 64 + p) * 2] = apr[16 * 64 + p]; a16[(g * 64 + p) * 2 + 1] = api[16 * 64 + p]; }
    for (int i = tid; i < 1024; i += NTHR) { cr[i] = c_re[(size_t)g * 1024 + i]; ci[i] = c_im[(size_t)g * 1024 + i]; }
    __syncthreads();
    for (int idx = tid; idx < 4096; idx += NTHR) { const int tau = idx >> 8, co = (idx >> 4) & 15, cin = idx & 15; float sacc = 0.f;
        for (int p = 0; p < 64; ++p) { const float c_r = cr[co * 64 + p], c_i = ci[co * 64 + p], a_r = apr[tau * 64 + p], a_i = api[tau * 64 + p]; const float wr_ = c_r * a_r - c_i * a_i, wi_ = c_r * a_i + c_i * a_r;
            sacc += wr_ * bbr[p * 16 + cin] - wi_ * bbi[p * 16 + cin]; }
        Kt[idx] = sacc; }
    __syncthreads();
    bf16_t* tg = bttg + (size_t)g * 256 * UXP; bf16_t* hh = bth + (size_t)g * 256 * 256;
    for (int idx = tid; idx < 256 * UXP; idx += NTHR) { const int n = idx / UXP, k = idx - n * UXP, i = n >> 4, co = n & 15; float v;
        if (k < 256) { const int j = k >> 4, cin = k & 15; v = (j <= i) ? Kt[((i - j) << 8) + (co << 4) + cin] : 0.f; }
        else if (k < 320) { const int p = k - 256; v = cr[co * 64 + p] * apr[(i + 1) * 64 + p] - ci[co * 64 + p] * api[(i + 1) * 64 + p]; }
        else { const int p = k - 320; v = -(cr[co * 64 + p] * api[(i + 1) * 64 + p] + ci[co * 64 + p] * apr[(i + 1) * 64 + p]); }
        tg[idx] = f2bf(v); }
    for (int idx = tid; idx < 256 * 256; idx += NTHR) { const int n = idx >> 8, k = idx & 255, j = k >> 4, cin = k & 15; float v = 0.f;
        if (n < 64) v = apr[(15 - j) * 64 + n] * bbr[n * 16 + cin] - api[(15 - j) * 64 + n] * bbi[n * 16 + cin];
        else if (n < 128) { const int p = n - 64; v = apr[(15 - j) * 64 + p] * bbi[p * 16 + cin] + api[(15 - j) * 64 + p] * bbr[p * 16 + cin]; }
        hh[idx] = f2bf(v); }
    __syncthreads();
}


#define XB_TMO      128
#define XB_XCNT(j)  (256  + 64 * (j))
#define XB_XSUB(j)  (1280 + 64 * (j))
#define XB_XGEN(j)  (2304 + 64 * (j))
#define XB_TOP      3328
#define XB_TOPGEN   3392
#define XCD_BAR_WORDS 3456
#define XB_SPIN_CAP (1u << 22)
__device__ __forceinline__ unsigned xb_ld(unsigned* p)              { return __hip_atomic_load(p, __ATOMIC_RELAXED, __HIP_MEMORY_SCOPE_AGENT); }
__device__ __forceinline__ unsigned xb_add(unsigned* p, unsigned v) { return __hip_atomic_fetch_add(p, v, __ATOMIC_RELAXED, __HIP_MEMORY_SCOPE_AGENT); }
__device__ __forceinline__ unsigned xb_xcc_id() { return (unsigned)__builtin_amdgcn_s_getreg((3 << 11) | 20) & 0xFu; }
#define XB_SPIN(cond, bar) do { unsigned _sp = 0; while (cond) { __builtin_amdgcn_s_sleep(1); \
    if ((++_sp & 255u) == 0u) { if (xb_ld(&(bar)[XB_TMO])) break; if (_sp > XB_SPIN_CAP) { atomicAdd(&(bar)[XB_TMO], 1u); break; } } } } while (0)
struct XcdBarrier { unsigned* bar; unsigned x; volatile __attribute__((address_space(3))) unsigned* st; };
__device__ __forceinline__ XcdBarrier xcd_barrier_post(unsigned* bar, volatile __attribute__((address_space(3))) unsigned* st, bool leader) {
    XcdBarrier b; b.bar = bar; b.x = xb_xcc_id(); b.st = st;
    if (leader) (void)xb_add(&bar[XB_XCNT(b.x)], 1u);
    return b;
}
__device__ __forceinline__ void xcd_barrier_complete(unsigned* bar, unsigned x, unsigned G, unsigned& nloc, unsigned& nx) {
    unsigned sum, cnt, mine, sp = 0u;
    for (;;) {
        sum = 0u; cnt = 0u; mine = 0u;
#pragma unroll
        for (unsigned j = 0; j < 16; ++j) { const unsigned c = xb_ld(&bar[XB_XCNT(j)]); sum += c; cnt += (c > 0u) ? 1u : 0u; mine = (j == x) ? c : mine; }
        if (sum == G) break;
        __builtin_amdgcn_s_sleep(1);
        if ((++sp & 255u) == 0u) { if (xb_ld(&bar[XB_TMO])) break; if (sp > XB_SPIN_CAP) { atomicAdd(&bar[XB_TMO], 1u); break; } }
    }
    nloc = mine > 0u ? mine : 1u; nx = cnt > 0u ? cnt : 1u;
}
__device__ __forceinline__ void xcd_barrier(const XcdBarrier& b, bool leader, unsigned G) {
    asm volatile("s_waitcnt vmcnt(0)" ::: "memory");
    __syncthreads();
    if (leader) {
        unsigned* bar = b.bar;
        __builtin_amdgcn_s_waitcnt(0);
        unsigned nloc = b.st[0], nx = b.st[1];
        if (nloc == 0u) { xcd_barrier_complete(bar, b.x, G, nloc, nx); b.st[0] = nloc; b.st[1] = nx; }
        const unsigned old = xb_add(&bar[XB_XSUB(b.x)], 1u);
        const unsigned gen = old / nloc;
        if (old + 1u == (gen + 1u) * nloc) {
            __builtin_amdgcn_fence(__ATOMIC_RELEASE, "agent");
            asm volatile("s_waitcnt vmcnt(0)" ::: "memory");
            const unsigned og = xb_add(&bar[XB_TOP], 1u);
            const unsigned tg = og / nx;
            if (og + 1u == (tg + 1u) * nx) xb_add(&bar[XB_TOPGEN], 1u);
            else XB_SPIN(xb_ld(&bar[XB_TOPGEN]) == tg, bar);
            __builtin_amdgcn_fence(__ATOMIC_ACQUIRE, "agent");
            xb_add(&bar[XB_XGEN(b.x)], 1u);
            asm volatile("s_waitcnt vmcnt(0)" ::: "memory");
        } else {
            XB_SPIN(xb_ld(&bar[XB_XGEN(b.x)]) == gen, bar);
            __builtin_amdgcn_fence(__ATOMIC_ACQUIRE, "agent");
            asm volatile("s_waitcnt vmcnt(0)" ::: "memory");
        }
    }
    __syncthreads();
}

__device__ __forceinline__ int lane_now() { int l; asm volatile("v_mbcnt_lo_u32_b32 %0, -1, 0\n\tv_mbcnt_hi_u32_b32 %0, -1, %0" : "=v"(l)); return l; }

struct Params {
    const float* in[29];
    float* out;
    unsigned char* ws;
};

__device__ __forceinline__ float wave_sum(float v) {
    v += swz_xor<1>(v); v += swz_xor<2>(v); v += swz_xor<4>(v); v += swz_xor<8>(v); v += swz_xor<16>(v);
    return xhalf_sum(v);
}

template <class AT> __device__ void rms_rows(const AT* in, int ldi, const float* g, float* out, int ldo, int ncols, int nrows, int gw, int ngw, int lane) {
    for (int r = gw; r < nrows; r += ngw) {
        const AT* row = in + (size_t)r * ldi; float ss = 0.f;
        for (int c = lane; c < ncols; c += 64) { const float v = ldf(row, c); ss += v * v; }
        ss = wave_sum(ss);
        const float rs = rsqrtf(ss / (float)ncols + EPS);
        float* orow = out + (size_t)r * ldo;
        for (int c = lane; c < ncols; c += 64) orow[c] = ldf(row, c) * rs * g[c];
    }
}

template <class AT, bool DUAL, class RowFn, class Epi>
__device__ void gemm_tile(const AT* A, int lda, RowFn arow, const float* B, int ldb, int K, int m0, int n0, int n1, int Nmax, float* sm, Epi epi) {
    float* As = sm;
    float* Bs = sm + 16 * 132;
    float* Bs2 = Bs + 16 * 128;
    const int tid = threadIdx.x, ty = tid >> 4, tx = tid & 15;
    float acc[4][8], acc2[4][8];
#pragma unroll
    for (int i = 0; i < 4; ++i)
#pragma unroll
        for (int j = 0; j < 8; ++j) { acc[i][j] = 0.f; acc2[i][j] = 0.f; }
    const int ar = tid >> 2, ak = (tid & 3) * 4;
    const int srow = arow(m0 + ar);
    const int bk = tid >> 5, bn = (tid & 31) * 4;
    for (int k0 = 0; k0 < K; k0 += 16) {
        float a4[4];
#pragma unroll
        for (int j = 0; j < 4; ++j) a4[j] = (srow >= 0) ? ldf(A, (size_t)srow * lda + k0 + ak + j) : 0.f;
        float b4[4], c4[4];
#pragma unroll
        for (int j = 0; j < 4; ++j) { const int col = n0 + bn + j; b4[j] = (col < Nmax) ? B[(size_t)(k0 + bk) * ldb + col] : 0.f; }
        if (DUAL) {
#pragma unroll
            for (int j = 0; j < 4; ++j) c4[j] = B[(size_t)(k0 + bk) * ldb + n1 + bn + j];
        }
        __syncthreads();
#pragma unroll
        for (int j = 0; j < 4; ++j) As[(ak + j) * 132 + ar] = a4[j];
#pragma unroll
        for (int j = 0; j < 4; ++j) Bs[bk * 128 + bn + j] = b4[j];
        if (DUAL) {
#pragma unroll
            for (int j = 0; j < 4; ++j) Bs2[bk * 128 + bn + j] = c4[j];
        }
        __syncthreads();
#pragma unroll 2
        for (int kk = 0; kk < 16; ++kk) {
            float a[4], b[8];
#pragma unroll
            for (int i = 0; i < 4; ++i) a[i] = As[kk * 132 + ty * 4 + i];
#pragma unroll
            for (int j = 0; j < 8; ++j) b[j] = Bs[kk * 128 + tx * 8 + j];
#pragma unroll
            for (int i = 0; i < 4; ++i)
#pragma unroll
                for (int j = 0; j < 8; ++j) acc[i][j] += a[i] * b[j];
            if (DUAL) {
#pragma unroll
                for (int j = 0; j < 8; ++j) b[j] = Bs2[kk * 128 + tx * 8 + j];
#pragma unroll
                for (int i = 0; i < 4; ++i)
#pragma unroll
                    for (int j = 0; j < 8; ++j) acc2[i][j] += a[i] * b[j];
            }
        }
    }
    __syncthreads();
#pragma unroll
    for (int i = 0; i < 4; ++i)
#pragma unroll
        for (int j = 0; j < 8; ++j) epi(m0 + ty * 4 + i, tx * 8 + j, acc[i][j], acc2[i][j]);
}

struct RowId { __device__ int operator()(int r) const { return r; } };
struct RowTok { const int* rowtok; __device__ int operator()(int r) const { const int id = rowtok[r]; return id < 0 ? -1 : (id >> 2); } };
struct RowSlot { const int* rowtok; __device__ int operator()(int r) const { return rowtok[r] < 0 ? -1 : r; } };

__device__ __forceinline__ float sigmoidf_(float x) { return 1.f / (1.f + __expf(-x)); }

__global__ void __launch_bounds__(NTHR) fwd_naive(Params P) {
    cg::grid_group grid = cg::this_grid();
    extern __shared__ __attribute__((aligned(16))) unsigned char lds[];
    float* sm = (float*)lds;
    int* ism = (int*)(lds + 57600);
    PG8_LAS unsigned char* ldsl = (PG8_LAS unsigned char*)lds;
    const int wave_s = __builtin_amdgcn_readfirstlane((int)threadIdx.x >> 6);
#define TID_NOW() (wave_s * 64 + lane_now())
    int tid = TID_NOW(), lane = tid & 63, wave = tid >> 6;
    const int nblk = gridDim.x, blk = blockIdx.x;
    int gw = blk * NWAVE + wave; const int ngw = nblk * NWAVE;
#define REFRESH_IDS() do { tid = TID_NOW(); asm volatile("" : "+v"(tid)); lane = tid & 63; wave = tid >> 6; gw = blk * NWAVE + wave; } while (0)
    unsigned char* ws = P.ws;
    int* ctl = (int*)(ws + WS_CTL);
    volatile __attribute__((address_space(3))) unsigned* MISC = (volatile __attribute__((address_space(3))) unsigned*)(ldsl + MISC_OFF);
    if (tid < 2) MISC[tid] = 0u;
    __syncthreads();
    const XcdBarrier xbar = xcd_barrier_post((unsigned*)ctl + CT_BAR, MISC, tid == 0);
#define GSYNC() do { xcd_barrier(xbar, TID_NOW() == 0, (unsigned)nblk); REFRESH_IDS(); } while (0)
    float* logf_ = (float*)(ws + WS_LOGF);
    float* x1 = (float*)(ws + WS_X1);
    int* topi = (int*)(ws + WS_TOPI); float* topg = (float*)(ws + WS_TOPG);
    int* rowtok = (int*)(ws + WS_ROWTOK); float* rowgate = (float*)(ws + WS_ROWGATE);
    bf16_t* act = (bf16_t*)(ws + WS_ACT); bf16_t* Y = (bf16_t*)(ws + WS_Y);
    float* Gs = (float*)(ws + WS_GS);
    bf16_t* Win_t = (bf16_t*)(ws + WS_WIN); bf16_t* XN = (bf16_t*)(ws + WS_XN); bf16_t* QB = (bf16_t*)(ws + WS_Q);
    bf16_t* KB = QB + (size_t)T * 512; bf16_t* VB = KB + (size_t)T * 512; bf16_t* UX = (bf16_t*)(ws + WS_UX);
    bf16_t* S5H = (bf16_t*)(ws + WS_S5H); bf16_t* S5TG = (bf16_t*)(ws + WS_S5TG); float* A16 = (float*)(ws + WS_A16);
    bf16_t* Wgu_t = (bf16_t*)(ws + WS_WGU); bf16_t* Wdn_t = (bf16_t*)(ws + WS_WDN); bf16_t* X1B = (bf16_t*)(ws + WS_X1B);
    bf16_t* MIXB = (bf16_t*)(ws + WS_MIXB); float* psa = (float*)(ws + WS_PSA); float* pss = (float*)(ws + WS_PSS);
    bf16_t* GB = (bf16_t*)(ws + WS_GB); bf16_t* Wglu_t = (bf16_t*)(ws + WS_WGLU); bf16_t* Wout_t = (bf16_t*)(ws + WS_WOUT); bf16_t* Wpg_t = (bf16_t*)(ws + WS_WPG); bf16_t* Wpp_t = (bf16_t*)(ws + WS_WPP);
    bf16_t* PB = (bf16_t*)(ws + WS_PB); bf16_t* XN2 = (bf16_t*)(ws + WS_XN2); bf16_t* GSB = (bf16_t*)(ws + WS_GS);
    int* rowsrc = (int*)(ws + WS_ROWSRC); float* rowscl = (float*)(ws + WS_ROWSCL); float* r1 = (float*)(ws + WS_R1);
    const float* x = P.in[0]; const float* pin = P.in[1]; const float* norm_mix_g = P.in[2]; const float* w_in = P.in[3]; const float* b_f = P.in[4];
    const float* lam_re = P.in[5]; const float* lam_im = P.in[6]; const float* log_dt = P.in[7]; const float* b_re = P.in[8]; const float* b_im = P.in[9];
    const float* c_re = P.in[10]; const float* c_im = P.in[11]; const float* d_skip = P.in[12]; const float* w_glu = P.in[13]; const float* b_glu = P.in[14];
    const float* attn_out_g = P.in[15]; const float* ssm_out_g = P.in[16]; const float* w_out = P.in[17]; const float* norm_ffn_g = P.in[18];
    const float* w_router = P.in[19]; const float* b_router = P.in[20]; const float* w_gu = P.in[21]; const float* b_gu = P.in[22];
    const float* w_dn = P.in[23]; const float* b_dn = P.in[24]; const float* norm_ple_g = P.in[25]; const float* w_ple_gate = P.in[26];
    const float* w_ple_proj = P.in[27]; const float* norm_final_g = P.in[28];

    if (blk == 0 && tid < 128) ctl[tid] = 0;
    if (blk < NG) s5_precompute(blk, lam_re, lam_im, log_dt, b_re, b_im, c_re, c_im, S5H, S5TG, A16, sm);
    REP(1) {
        PG8_LAS float* scr = (PG8_LAS float*)(ldsl + wave * 16384);
        constexpr int I_IN = 16 * 64, I_GU = NE * 16 * 64, I_DN = NE * 16 * 32, I_GLU = 8 * 16, I_OUT = 16 * 32, I_PG = 16 * 32, I_PP = 4 * 32;
        constexpr int NI = I_IN + I_GLU + I_OUT + I_PG + I_PP + I_GU + I_DN;
        auto decode = [&](int it, TrItem& d) {
            int r = it;
            if (r < I_GLU) { const int kb = r >> 4, nb = r & 15; d = TrItem{w_glu, nullptr, Wglu_t, SW, kb * 64, nb * 32, SW, nb * 32}; return; }
            r -= I_GLU;
            if (r < I_OUT) { const int kb = r >> 5, nb = r & 31; d = TrItem{w_out, kb < 8 ? attn_out_g : ssm_out_g - AW, Wout_t, D, kb * 64, nb * 32, D, nb * 32}; return; }
            r -= I_OUT;
            if (r < I_PG) { const int kb = r >> 5, nb = r & 31; d = TrItem{w_ple_gate, norm_ple_g, Wpg_t, D, kb * 64, nb * 32, D, nb * 32}; return; }
            r -= I_PG;
            if (r < I_PP) { const int kb = r >> 5, nb = r & 31; d = TrItem{w_ple_proj, nullptr, Wpp_t, D, kb * 64, nb * 32, PLE, nb * 32}; return; }
            r -= I_PP;
            if (r < I_IN) { const int kb = r >> 6, nb = r & 63, n0 = nb * 32; d = TrItem{w_in, norm_mix_g, Win_t, INW, kb * 64, (n0 < 1536) ? n0 : n0 + 8, D, n0}; return; }
            r -= I_IN;
            if (r < I_GU) {
                const int e = r >> 10, kb = (r >> 6) & 15, nb = r & 63; const int n0 = nb * 32, pn = n0 >> 8, j0 = n0 & 255;
                d = TrItem{w_gu + (size_t)e * D * 2 * DFF, norm_ffn_g, Wgu_t + (size_t)e * 2 * DFF * D, 2 * DFF, kb * 64, (j0 < 128) ? pn * 128 + j0 : DFF + pn * 128 + (j0 - 128), D, n0}; return; }
            r -= I_GU;
            { const int e = r >> 9, kb = (r >> 5) & 15, nb = r & 31; d = TrItem{w_dn + (size_t)e * DFF * D, nullptr, Wdn_t + (size_t)e * D * DFF, D, kb * 64, nb * 32, DFF, nb * 32}; }
        };
        TrItem dc, dn; float vc[32], vn[32];
        int it = gw;
        if (it < NI) { decode(it, dc); tr_load(dc, vc, lane); }
        while (it < NI) {
            const int itn = it + ngw; const bool more = itn < NI;
            if (more) { decode(itn, dn); tr_load(dn, vn, lane); }
            tr_store(dc, vc, scr, lane);
            if (more) { dc = dn;
#pragma unroll
                for (int i = 0; i < 32; ++i) vc[i] = vn[i]; }
            it = itn;
        }
    }
    for (size_t i = (size_t)(blk * NTHR + tid) * 8; i < (size_t)T * PLE; i += (size_t)nblk * NTHR * 8) {
        const float4 a = *(const float4*)(pin + i), b4 = *(const float4*)(pin + i + 4);
        *(uint4*)(PB + i) = make_uint4(pk2(a.x, a.y), pk2(a.z, a.w), pk2(b4.x, b4.y), pk2(b4.z, b4.w)); }
    REP(10) {
        float wf[4][4][8];
#pragma unroll
        for (int j = 0; j < 4; ++j)
#pragma unroll
            for (int i = 0; i < 4; ++i) { const int k = 256 * j + 4 * lane + i; const float gk = norm_mix_g[k]; const float4 a = *(const float4*)(w_in + (size_t)k * INW + COL_F), b4 = *(const float4*)(w_in + (size_t)k * INW + COL_F + 4);
                wf[j][i][0] = a.x * gk; wf[j][i][1] = a.y * gk; wf[j][i][2] = a.z * gk; wf[j][i][3] = a.w * gk; wf[j][i][4] = b4.x * gk; wf[j][i][5] = b4.y * gk; wf[j][i][6] = b4.z * gk; wf[j][i][7] = b4.w * gk; }
        float4 vnx[4];
        if (gw < T) {
#pragma unroll
            for (int j = 0; j < 4; ++j) vnx[j] = ((const float4*)(x + (size_t)gw * D) + lane)[64 * j]; }
        for (int r = gw; r < T; r += ngw) {
            float4 v[4]; float ss = 0.f;
#pragma unroll
            for (int j = 0; j < 4; ++j) v[j] = vnx[j];
            if (r + ngw < T) {
#pragma unroll
                for (int j = 0; j < 4; ++j) vnx[j] = ((const float4*)(x + (size_t)(r + ngw) * D) + lane)[64 * j]; }
#pragma unroll
            for (int j = 0; j < 4; ++j) ss += (v[j].x * v[j].x + v[j].y * v[j].y) + (v[j].z * v[j].z + v[j].w * v[j].w);
            ss = wave_sum(ss); const float rs = rsqrtf(ss * (1.f / D) + EPS);
            float fl[8];
#pragma unroll
            for (int h = 0; h < 8; ++h) fl[h] = 0.f;
            uint2* o8 = (uint2*)(XN + (size_t)r * D) + lane;
#pragma unroll
            for (int j = 0; j < 4; ++j) { const float a0 = v[j].x * rs, a1 = v[j].y * rs, a2 = v[j].z * rs, a3 = v[j].w * rs;
                o8[64 * j] = make_uint2(pk2(a0, a1), pk2(a2, a3));
#pragma unroll
                for (int h = 0; h < 8; ++h) fl[h] += a0 * wf[j][0][h] + a1 * wf[j][1][h] + a2 * wf[j][2][h] + a3 * wf[j][3][h]; }
            float mine = 0.f;
#pragma unroll
            for (int h = 0; h < 8; ++h) { const float sfl = wave_sum(fl[h]); if (lane == h) mine = sfl; }
            if (lane < 8) { const float z = mine + b_f[lane]; logf_[(size_t)r * 8 + lane] = fminf(z, 0.f) - log1pf(__expf(-fabsf(z))); }
        }
    }
    __syncthreads();
    grid.sync(); REFRESH_IDS();

    REP(2) {
        pg8::Order So; So.init(T / 256, 2048 / 256, nblk, blk, nullptr);
        pg8::EpiQKVU E{QB, (size_t)T * 512, UX};
        pg8::gemm_phase(TID_NOW(), ldsl, (const char*)XN, (const char*)Win_t, 0, D, So, pg8::DenseRows{D}, E);
    }
    GSYNC();

    REP(3) {
        const int pm = (blk % 8) * (nblk / 8) + blk / 8, g = pm >> 3;
        pg8::OneUnit So{pm, g};
        pg8::EpiS5H E1{UX, A16 + g * 128};
        pg8::gemm_phase(TID_NOW(), ldsl, (const char*)UX, (const char*)S5H, (size_t)256 * 256 * 2, 256, So, pg8::DenseRows{UXP}, E1);
        pg8::EpiS5Y E2{UX, d_skip, GB};
        pg8::gemm_phase(TID_NOW(), ldsl, (const char*)UX, (const char*)S5TG, (size_t)256 * UXP * 2, UXP, So, pg8::DenseRows{UXP}, E2);
    }
    REP(4) {
        const int vcu = (blk % 8) * (nblk / 8) + blk / 8, bh = vcu >> 2, sg = vcu & 3, b = bh >> 3, h = bh & 7;
        attn_body::prep_c(TID_NOW(), b, h, logf_, (char*)lds);
        for (int i = 0; i < 4; ++i) { const int qb = (i == 0) ? sg : (i == 1) ? 7 - sg : (i == 2) ? 8 + sg : 15 - sg;
            attn_body::attn_unit<8>(TID_NOW(), b, h, qb, QB, KB, VB, MIXB, psa, (char*)lds); }
    }
    GSYNC();

    REP(9) {
        pg8::Order So; So.init(T / 256, SW / 256, nblk, blk, nullptr);
        pg8::EpiGlu E{GB, MIXB, b_glu, pss};
        pg8::gemm_phase(TID_NOW(), ldsl, (const char*)GB, (const char*)Wglu_t, 0, SW, So, pg8::DenseRows{SW}, E);
    }
    GSYNC();

    REP(5) {
        pg8::Order So; So.init(T / 256, D / 256, nblk, blk, nullptr);
        pg8::EpiOut E{x, x1, X1B, psa, pss};
        pg8::gemm_phase(TID_NOW(), ldsl, (const char*)MIXB, (const char*)Wout_t, 0, D, So, pg8::DenseRows{D}, E);
    }
    GSYNC();

    {
        typedef float f32x16 __attribute__((ext_vector_type(16)));
        float* Wr = sm;
        int* hist = (int*)(lds + 131072);
        for (int i = tid; i < D * NE; i += NTHR) Wr[i] = w_router[i] * norm_ffn_g[i >> 5];
        if (tid < NE) hist[tid] = 0;
        __syncthreads();
        if (wave >= 4) { for (int i = blk * 256 + (tid - 256); i < CAP; i += nblk * 256) { rowtok[i] = -1; rowgate[i] = 0.f; rowsrc[i] = 0; rowscl[i] = 0.f; } }
        else {
            const int r0 = (blk * 4 + wave) * 32, e = lane & 31, h = lane >> 5; const float* xp = x1 + (size_t)(r0 + e) * D + 4 * h;
            f32x16 acc;
#pragma unroll
            for (int r = 0; r < 16; ++r) acc[r] = 0.f;
            float ss = 0.f;
#pragma unroll 4
            for (int j = 0; j < 128; ++j) { const float4 xv = *(const float4*)(xp + 8 * j); const float* wp = Wr + (8 * j + 4 * h) * 32 + e;
                ss += (xv.x * xv.x + xv.y * xv.y) + (xv.z * xv.z + xv.w * xv.w);
                acc = __builtin_amdgcn_mfma_f32_32x32x2f32(xv.x, wp[0], acc, 0, 0, 0); acc = __builtin_amdgcn_mfma_f32_32x32x2f32(xv.y, wp[32], acc, 0, 0, 0);
                acc = __builtin_amdgcn_mfma_f32_32x32x2f32(xv.z, wp[64], acc, 0, 0, 0); acc = __builtin_amdgcn_mfma_f32_32x32x2f32(xv.w, wp[96], acc, 0, 0, 0); }
            ss = xhalf_sum(ss); const float rs = rsqrtf(ss * (1.f / D) + EPS);
            if (h == 0) r1[r0 + e] = rs;
            const float bias = b_router[e];
#pragma unroll
            for (int r = 0; r < 16; ++r) { const int ri = (r & 3) + 8 * (r >> 2) + 4 * h;
                float v = acc[r] * bperm(rs, ri) + bias; float tv[TOPK]; int ti[TOPK];
#pragma unroll
                for (int k = 0; k < TOPK; ++k) { float m = v;
                    m = fmaxf(m, swz_xor<1>(m)); m = fmaxf(m, swz_xor<2>(m)); m = fmaxf(m, swz_xor<4>(m)); m = fmaxf(m, swz_xor<8>(m)); m = fmaxf(m, swz_xor<16>(m));
                    const unsigned long long bm = __ballot(v == m); const unsigned half = h ? (unsigned)(bm >> 32) : (unsigned)bm; const int idx = __ffs((int)half) - 1;
                    tv[k] = m; ti[k] = idx; if (e == idx) v = -INFINITY; }
                float es[TOPK], den = 0.f;
#pragma unroll
                for (int k = 0; k < TOPK; ++k) { es[k] = __expf(tv[k] - tv[0]); den += es[k]; }
                if (e < TOPK) { float gsel = es[0]; int isel = ti[0];
#pragma unroll
                    for (int k = 1; k < TOPK; ++k) if (e == k) { gsel = es[k]; isel = ti[k]; }
                    topi[(size_t)(r0 + ri) * TOPK + e] = isel; topg[(size_t)(r0 + ri) * TOPK + e] = gsel / den; atomicAdd(&hist[isel], 1); } }
        }
        __syncthreads();
        if (tid < NE) atomicAdd(&ctl[CT_COUNT + tid], hist[tid]);
    }
    GSYNC();

    {
        int* lcnt = ism + 64; int* lbase = ism + 128;
        if (tid < NE) lcnt[tid] = 0;
        if (tid == 0) {
            int run = 0;
            for (int e = 0; e < NE; ++e) { ism[e] = run; const int cnt = ctl[CT_COUNT + e]; run += (cnt + MB - 1) / MB * MB; }
            ism[NE] = run;
            if (blk == 0) {
                for (int e = 0; e <= NE; ++e) ctl[CT_PADSTART + e] = ism[e];
                ctl[CT_NTILES] = run / MB;
                for (int e = 0; e < NE; ++e) for (int tt = ism[e] / MB; tt < ism[e + 1] / MB; ++tt) ctl[CT_TILEEXP + tt] = e;
            }
        }
        __syncthreads();
        const int i = blk * NTHR + tid; const int e = topi[i]; const int rank = atomicAdd(&lcnt[e], 1);
        __syncthreads();
        if (tid < NE) lbase[tid] = atomicAdd(&ctl[CT_CURSOR + tid], lcnt[tid]);
        __syncthreads();
        const int slot = ism[e] + lbase[e] + rank;
        rowtok[slot] = i; rowgate[slot] = topg[i]; rowsrc[slot] = i >> 2; rowscl[slot] = r1[i >> 2];
    }
    GSYNC();

    REP(6) {
        pg8::Order So; So.init(ctl[CT_NTILES], 2 * DFF / 256, nblk, blk, ctl + CT_TILEEXP);
        pg8::EpiSwiglu E{act, b_gu, rowscl};
        pg8::gemm_phase(TID_NOW(), ldsl, (const char*)X1B, (const char*)Wgu_t, (size_t)2 * DFF * D * 2, D, So, pg8::GatherRows{rowsrc, D}, E);
    }
    GSYNC();

    REP(7) {
        pg8::Order So; So.init(ctl[CT_NTILES], D / 256, nblk, blk, ctl + CT_TILEEXP);
        pg8::EpiScatter E{Y, b_dn, rowtok, rowgate};
        pg8::gemm_phase(TID_NOW(), ldsl, (const char*)act, (const char*)Wdn_t, (size_t)D * DFF * 2, DFF, So, pg8::DenseRows{DFF}, E);
    }
    GSYNC();

    for (int r = gw; r < T; r += ngw) {
        float4* xr = (float4*)(x1 + (size_t)r * D) + lane; float4 v[4]; float ss = 0.f;
#pragma unroll
        for (int j = 0; j < 4; ++j) { v[j] = xr[64 * j];
#pragma unroll
            for (int k = 0; k < TOPK; ++k) { const uint2 y = *((const uint2*)(Y + ((size_t)r * TOPK + k) * D) + lane + 64 * j);
                v[j].x += __builtin_bit_cast(float, y.x << 16); v[j].y += __builtin_bit_cast(float, y.x & 0xffff0000u); v[j].z += __builtin_bit_cast(float, y.y << 16); v[j].w += __builtin_bit_cast(float, y.y & 0xffff0000u); }
            xr[64 * j] = v[j]; ss += (v[j].x * v[j].x + v[j].y * v[j].y) + (v[j].z * v[j].z + v[j].w * v[j].w); }
        ss = wave_sum(ss); const float rs = rsqrtf(ss * (1.f / D) + EPS);
        uint2* o8 = (uint2*)(XN2 + (size_t)r * D) + lane;
#pragma unroll
        for (int j = 0; j < 4; ++j) o8[64 * j] = make_uint2(pk2(v[j].x * rs, v[j].y * rs), pk2(v[j].z * rs, v[j].w * rs));
    }
    GSYNC();

    {
        pg8::Order So; So.init(T / 256, D / 256, nblk, blk, nullptr);
        pg8::EpiGate E1{GSB};
        pg8::gemm_phase(TID_NOW(), ldsl, (const char*)XN2, (const char*)Wpg_t, 0, D, So, pg8::DenseRows{D}, E1);
        pg8::EpiPle E2{GSB, x1};
        pg8::gemm_phase(TID_NOW(), ldsl, (const char*)PB, (const char*)Wpp_t, 0, PLE, So, pg8::DenseRows{PLE}, E2);
    }
    GSYNC();

    REP(8)
    for (int r = gw; r < T; r += 2 * ngw) {
        const int r2 = r + ngw; const bool has2 = r2 < T;
        const float4* xr = (const float4*)(x1 + (size_t)r * D) + lane; const float4* xr2 = (const float4*)(x1 + (size_t)(has2 ? r2 : r) * D) + lane; float4 v[4], w[4]; float ss = 0.f, ss2 = 0.f;
#pragma unroll
        for (int j = 0; j < 4; ++j) { v[j] = xr[64 * j]; w[j] = xr2[64 * j]; }
#pragma unroll
        for (int j = 0; j < 4; ++j) { ss += (v[j].x * v[j].x + v[j].y * v[j].y) + (v[j].z * v[j].z + v[j].w * v[j].w); ss2 += (w[j].x * w[j].x + w[j].y * w[j].y) + (w[j].z * w[j].z + w[j].w * w[j].w); }
        ss = wave_sum(ss); ss2 = wave_sum(ss2); const float rs = rsqrtf(ss * (1.f / D) + EPS), rs2 = rsqrtf(ss2 * (1.f / D) + EPS);
        if (has2) { float4* orow2 = (float4*)(P.out + (size_t)r2 * D) + lane;
#pragma unroll
            for (int j = 0; j < 4; ++j) { const float4 g4 = ((const float4*)norm_final_g)[lane + 64 * j]; orow2[64 * j] = make_float4(w[j].x * rs2 * g4.x, w[j].y * rs2 * g4.y, w[j].z * rs2 * g4.z, w[j].w * rs2 * g4.w); } }
        float4* orow = (float4*)(P.out + (size_t)r * D) + lane;
#pragma unroll
        for (int j = 0; j < 4; ++j) { const float4 g4 = ((const float4*)norm_final_g)[lane + 64 * j]; orow[64 * j] = make_float4(v[j].x * rs * g4.x, v[j].y * rs * g4.y, v[j].z * rs * g4.z, v[j].w * rs * g4.w); }
    }
}

extern "C" void kernel_launch(void* const* d_in, const int* in_sizes, int n_in, void* d_out, int out_size, void* d_ws, size_t ws_size, hipStream_t stream) {
    static int grid = 0;
    if (grid == 0) {
        int dev = 0, cus = 0, per_cu = 0;
        (void)hipGetDevice(&dev);
        (void)hipDeviceGetAttribute(&cus, hipDeviceAttributeMultiprocessorCount, dev);
        if (hipFuncSetAttribute((const void*)fwd_naive, hipFuncAttributeMaxDynamicSharedMemorySize, LDS_BYTES) != hipSuccess) fprintf(stderr, "kernel_launch: hipFuncSetAttribute failed\n");
        (void)hipOccupancyMaxActiveBlocksPerMultiprocessor(&per_cu, (const void*)fwd_naive, NTHR, LDS_BYTES);
        if (per_cu < 1) { fprintf(stderr, "kernel_launch: occupancy query says %d blocks per CU\n", per_cu); per_cu = 1; }
        grid = cus;
        if (n_in != 29 || ws_size < WS_END) { fprintf(stderr, "kernel_launch: unexpected n_in %d or ws_size %zu\n", n_in, ws_size); }
    }
    (void)hipMemsetAsync((char*)d_ws + WS_CTL, 0, CTL_ZERO_BYTES, stream);
    Params p{};
    for (int i = 0; i < 29; ++i) p.in[i] = (const float*)d_in[i];
    p.out = (float*)d_out; p.ws = (unsigned char*)d_ws;
    void* args[] = {&p};
    hipError_t e = hipLaunchCooperativeKernel((const void*)fwd_naive, dim3(grid), dim3(NTHR), args, LDS_BYTES, stream);
    if (e != hipSuccess) fprintf(stderr, "cooperative launch failed: %s (grid %d)\n", hipGetErrorString(e), grid);
}
```

```cpp
#include <hip/hip_runtime.h>
#include <hip/hip_cooperative_groups.h>
#include <cstdio>
#include <cstdint>
namespace cg = cooperative_groups;

constexpr int NB = 8, S = 4096, T = NB * S, D = 1024, NH = 8, HD = 64, AW = 512, SW = 512, INW = 2056;
constexpr int NG = 32, NP = 64, NC = 16, NE = 32, TOPK = 4, DFF = 1024, PLE = 256;
constexpr int COL_K = 512, COL_V = 1024, COL_F = 1536, COL_U = 1544;
constexpr float EPS = 1e-5f;
constexpr int NTHR = 512, NWAVE = 8;
#ifndef PROBE_DUP
#define PROBE_DUP 0
#endif
#define REP(k) for (int rep_ = 0; rep_ < ((PROBE_DUP == (k)) ? 2 : 1); ++rep_)
constexpr int MB = 256;
constexpr int CAP = T * TOPK + NE * MB;
constexpr int MAXTILES = CAP / MB;
constexpr int LDS_BYTES = 147456;

typedef unsigned short bf16_t;
__device__ __forceinline__ unsigned pk4_fp8(float a, float b, float c, float d) { int w = 0; w = __builtin_amdgcn_cvt_pk_fp8_f32(a, b, w, false); w = __builtin_amdgcn_cvt_pk_fp8_f32(c, d, w, true); return (unsigned)w; }
template <int M> __device__ __forceinline__ float swz_xor(float v) { return __builtin_bit_cast(float, __builtin_amdgcn_ds_swizzle(__builtin_bit_cast(int, v), (M << 10) | 0x1f)); }
__device__ __forceinline__ float xhalf_sum(float v) { unsigned a = __builtin_bit_cast(unsigned, v), b = a; asm volatile("" : "+v"(b));
    auto rr = __builtin_amdgcn_permlane32_swap(a, b, false, false); unsigned r0 = rr[0], r1 = rr[1]; asm volatile("" : "+v"(r0), "+v"(r1));
    return __builtin_bit_cast(float, r0) + __builtin_bit_cast(float, r1); }
__device__ __forceinline__ float bperm(float v, int srclane) { return __builtin_bit_cast(float, __builtin_amdgcn_ds_bpermute(srclane << 2, __builtin_bit_cast(int, v))); }
__device__ __forceinline__ bf16_t f2bf(float f) { unsigned u = __builtin_bit_cast(unsigned, f); return (bf16_t)((u + 0x7fffu + ((u >> 16) & 1u)) >> 16); }
__device__ __forceinline__ float bf2f(bf16_t b) { return __builtin_bit_cast(float, (unsigned)b << 16); }
__device__ __forceinline__ unsigned pk2(float lo, float hi) { return (unsigned)f2bf(lo) | ((unsigned)f2bf(hi) << 16); }
__device__ __forceinline__ float ldf(const float* p, size_t i) { return p[i]; }
__device__ __forceinline__ float ldf(const bf16_t* p, size_t i) { return bf2f(p[i]); }

constexpr size_t MiB = 1u << 20;
constexpr size_t WS_CTL = 0;
constexpr size_t WS_WIN = 1 * MiB;
constexpr size_t WS_WGLU = 5 * MiB;
constexpr size_t WS_WOUT = 6 * MiB;
constexpr size_t WS_WPG = 8 * MiB;
constexpr size_t WS_WPP = 10 * MiB;
constexpr size_t WS_A16 = 11 * MiB;
constexpr size_t WS_S5H = 12 * MiB;
constexpr size_t WS_S5TG = 16 * MiB;
constexpr size_t WS_WDN = 22 * MiB;
constexpr size_t WS_X1 = 86 * MiB;
constexpr size_t WS_TOPI = 214 * MiB;
constexpr size_t WS_TOPG = 214 * MiB + 512 * 1024;
constexpr size_t WS_ROWTOK = 215 * MiB;
constexpr size_t WS_ROWGATE = 216 * MiB;
constexpr size_t WS_ROWSRC = 217 * MiB;
constexpr size_t WS_ROWSCL = 218 * MiB;
constexpr size_t WS_R1 = 219 * MiB;
constexpr size_t WS_PSA = 220 * MiB;
constexpr size_t WS_PSS = 221 * MiB;
constexpr size_t WS_LOGF = 222 * MiB;
constexpr size_t WS_PB = 223 * MiB;
constexpr size_t WS_A = 239 * MiB;
constexpr size_t WS_XN = WS_A;
constexpr size_t WS_Q = WS_A + 64 * MiB;
constexpr size_t WS_UX = WS_A + 160 * MiB;
constexpr size_t WS_MIXB = WS_A + 212 * MiB;
constexpr size_t WS_GB = WS_A + 276 * MiB;
constexpr size_t WS_ACT = WS_A;
constexpr size_t WS_XN2 = WS_A;
constexpr size_t WS_GS = WS_A + 64 * MiB;
constexpr size_t WS_B = WS_A + 308 * MiB;
constexpr size_t WS_WGU = WS_B;
constexpr size_t WS_X1B = WS_B + 128 * MiB;
constexpr size_t WS_Y = WS_B;
constexpr size_t WS_END = WS_B + 256 * MiB;
static_assert((size_t)CAP * 4 <= MiB && (size_t)CAP * DFF * 2 <= 272 * MiB, "list arrays fit 1 MiB each; ACT fits");
constexpr int UXP = 384;
constexpr int CT_COUNT = 0, CT_CURSOR = 64, CT_PADSTART = 128, CT_NTILES = 192, CT_TILEEXP = 256, CT_BAR = 4096;
constexpr size_t CTL_ZERO_BYTES = 65536;
constexpr int MISC_OFF = 147200, PTAB_OFF = 146944;
constexpr float LOG2E = 1.4426950408889634f, C2 = 0.125f * LOG2E;

namespace pg8 {
#define PG8_LAS __attribute__((address_space(3)))
typedef short bf16x8 __attribute__((ext_vector_type(8)));
typedef float f32x4 __attribute__((ext_vector_type(4)));
typedef unsigned u32x4 __attribute__((ext_vector_type(4)));
typedef int i32x4 __attribute__((ext_vector_type(4)));
typedef int i32x8 __attribute__((ext_vector_type(8)));
constexpr float W8_MUL = 64.f, W8_INV = 1.f / 64.f;
constexpr int BM = 256, BK = 64, HALF = 128, HTB = HALF * BK * 2, STAGE_BYTES = 8 * HTB, NXCD = 8, WGM = 8;
__device__ __forceinline__ int lds_byte(int r, int c) { const int st = (r >> 4) * 2 + (c >> 5), rr = r & 15, cc = c & 31, ob = rr * 64 + cc * 2; return st * 1024 + (ob ^ (((ob >> 9) & 1) << 5)); }
__device__ __forceinline__ void stage_rc(int b, int& R, int& C) { const int st = b / 1024, sb = b % 1024, swz = sb ^ (((sb >> 9) & 1) << 5); R = (st >> 1) * 16 + swz / 64; C = (st & 1) * 32 + (swz % 64) / 2; }
__device__ __forceinline__ int perm32(int rho) { const int n = rho >> 4, i = rho & 15; return 8 * (i >> 2) + 4 * n + (i & 3); }
struct Unit { int pm, pn, e; };
__device__ __forceinline__ unsigned long long uni64(const void* p) { const unsigned long long v = (unsigned long long)p; return (unsigned long long)(unsigned)__builtin_amdgcn_readfirstlane((int)(unsigned)v) | ((unsigned long long)(unsigned)__builtin_amdgcn_readfirstlane((int)(unsigned)(v >> 32)) << 32); }
struct Order {
    int nM, nN, nwg, G, c; const int* texp;
    __device__ void init(int nM_, int nN_, int G_, int c_, const int* texp_) { nM = nM_; nN = nN_; nwg = nM * nN; G = G_; c = c_; texp = texp_; }
    __device__ bool next(int i, Unit& u) const {
        const long L = (long)i * G + c; if (L >= nwg) return false;
        int wgid = (int)L; { const int q = nwg / NXCD, r = nwg % NXCD, xcd = wgid % NXCD, off = wgid / NXCD; wgid = (xcd < r ? xcd * (q + 1) : r * (q + 1) + (xcd - r) * q) + off; }
        const int nig = WGM * nN, gid = wgid / nig, fm = gid * WGM, gsz = (nM - fm) < WGM ? (nM - fm) : WGM;
        u.pm = __builtin_amdgcn_readfirstlane(fm + ((wgid % nig) % gsz)); u.pn = __builtin_amdgcn_readfirstlane((wgid % nig) / gsz);
        u.e = texp ? __builtin_amdgcn_readfirstlane(texp[u.pm]) : 0; return true;
    }
};
struct DenseRows { static constexpr bool UNIFORM = true; int lda; __device__ __forceinline__ unsigned rowoff(const Unit&, int r) const { return (unsigned)r * (unsigned)lda; }
    __device__ __forceinline__ size_t tilebase(const Unit& u) const { return (size_t)u.pm * BM * (size_t)lda; } };
struct GatherRows { static constexpr bool UNIFORM = false; const int* src; int lda; __device__ __forceinline__ unsigned rowoff(const Unit& u, int r) const { return (unsigned)src[u.pm * BM + r] * (unsigned)lda; }
    __device__ __forceinline__ size_t tilebase(const Unit&) const { return 0; } };
struct OneUnit { int pm, e; __device__ bool next(int i, Unit& u) const { if (i) return false; u.pm = pm; u.pn = 0; u.e = e; return true; } };
typedef float f32x2_t __attribute__((ext_vector_type(2))); typedef __bf16 bf16x2_t __attribute__((ext_vector_type(2)));
__device__ __forceinline__ unsigned cvt_pk_bf16(float lo, float hi) { f32x2_t v = {lo, hi}; bf16x2_t b = __builtin_convertvector(v, bf16x2_t); return __builtin_bit_cast(unsigned, b); }

template <int ELT = 2, class Epi, class ARow, class Sched>
__device__ __forceinline__ void gemm_phase(int tid0, PG8_LAS unsigned char* lds, const char* Abase, const char* Bbase, size_t b_estride, int K, const Sched& S, const ARow& AR, const Epi& E) {
    int tid = tid0; asm volatile("" : "+v"(tid));
    const int wid = __builtin_amdgcn_readfirstlane(tid >> 6), lane = tid & 63, wr = wid >> 2, wc = wid & 3, fr = lane & 15, fq = lane >> 4;
    const int nt = K * ELT / 128;
    unsigned voffB[2];
#pragma unroll
    for (int i = 0; i < 2; ++i) { int R, C; stage_rc(tid * 16 + i * 8192, R, C); const int Rb = Epi::PERM ? ((R & ~31) + perm32(R & 31)) : R; voffB[i] = (unsigned)Rb * (unsigned)(K * ELT) + (unsigned)C * 2u; }
    const size_t kstep = (size_t)(BK * 2), hstep = (size_t)HALF * K * ELT, tstep = 2 * hstep;
    const unsigned ldsw = (unsigned)wid * 1024u;
    const int aoff = lds_byte(wr * 64 + fr, fq * 8), boff = lds_byte(wc * 32 + fr, fq * 8);
#define PG8_SA(b, h) (((b) * 2 + (h)) * HTB)
#define PG8_SB(b, h) ((4 + (b) * 2 + (h)) * HTB)
#define PG8_STAGE(bufoff, gbase, voff) do { _Pragma("unroll") for (int _i = 0; _i < 2; ++_i) \
        __builtin_amdgcn_global_load_lds((const unsigned*)((const char*)(gbase) + (voff)[_i]), (PG8_LAS unsigned*)(lds + (bufoff) + ldsw + _i * 8192), 16, 0, 0); } while (0)
#define PG8_LD16(off) (*(const PG8_LAS bf16x8*)(lds + (off)))
#define PG8_CAT(x, y) __builtin_shufflevector(__builtin_bit_cast(i32x4, x), __builtin_bit_cast(i32x4, y), 0, 1, 2, 3, 4, 5, 6, 7)
#define PG8_LDA(dst, b, h) do { _Pragma("unroll") for (int m = 0; m < 4; ++m) { \
        if constexpr (ELT == 2) { dst##2[m][0] = PG8_LD16(PG8_SA(b, h) + aoff + m * 2048); dst##2[m][1] = PG8_LD16(PG8_SA(b, h) + aoff + m * 2048 + 1024); } \
        else dst##1[m] = PG8_CAT(PG8_LD16(PG8_SA(b, h) + aoff + m * 2048), PG8_LD16(PG8_SA(b, h) + aoff + m * 2048 + 1024)); } } while (0)
#define PG8_LDB(dst, b, h) do { _Pragma("unroll") for (int n = 0; n < 2; ++n) { \
        if constexpr (ELT == 2) { dst##2[n][0] = PG8_LD16(PG8_SB(b, h) + boff + n * 2048); dst##2[n][1] = PG8_LD16(PG8_SB(b, h) + boff + n * 2048 + 1024); } \
        else dst##1[n] = PG8_CAT(PG8_LD16(PG8_SB(b, h) + boff + n * 2048), PG8_LD16(PG8_SB(b, h) + boff + n * 2048 + 1024)); } } while (0)
#define PG8_MMA(ai, bj, At, Bt) do { __builtin_amdgcn_s_setprio(1); _Pragma("unroll") for (int m = 0; m < 4; ++m) _Pragma("unroll") for (int n = 0; n < 2; ++n) { \
        if constexpr (ELT == 2) { _Pragma("unroll") for (int k = 0; k < 2; ++k) acc[ai][bj][m][n] = __builtin_amdgcn_mfma_f32_16x16x32_bf16(Bt##2[n][k], At##2[m][k], acc[ai][bj][m][n], 0, 0, 0); } \
        else asm volatile("v_mfma_scale_f32_16x16x128_f8f6f4 %0, %1, %2, %0, %3, %3 op_sel_hi:[0,0,0]" : "+v"(acc[ai][bj][m][n]) : "v"(Bt##1[n]), "v"(At##1[m]), "v"(one8)); } \
        __builtin_amdgcn_s_setprio(0); } while (0)
#define PG8_WAIT_V(n) asm volatile("s_waitcnt vmcnt(" #n ")" ::: "memory")
#define PG8_WAIT_L(n) asm volatile("s_waitcnt lgkmcnt(" #n ")" ::: "memory")
#define PG8_BAR __builtin_amdgcn_s_barrier()
#define PG8_SCHED __builtin_amdgcn_sched_barrier(0)
#define PG8_VOFF(dst, u) do { _Pragma("unroll") for (int _i = 0; _i < 2; ++_i) { int _R, _C; stage_rc(tid * 16 + _i * 8192, _R, _C); _Pragma("unroll") for (int _h = 0; _h < 2; ++_h) dst[_h][_i] = AR.rowoff(u, _h * HALF + _R) * (unsigned)ELT + (unsigned)_C * 2u; } } while (0)
    Unit cur, nxt; int ui = 0;
    if (!S.next(0, cur)) return;
    f32x4 acc[2][2][4][2];
#pragma unroll
    for (int a = 0; a < 2; ++a)
#pragma unroll
        for (int b = 0; b < 2; ++b)
#pragma unroll
            for (int m = 0; m < 4; ++m)
#pragma unroll
                for (int n = 0; n < 2; ++n) acc[a][b][m][n] = (f32x4){0.f, 0.f, 0.f, 0.f};
    bf16x8 At2[4][2], B02[2][2], B12[2][2]; i32x8 At1[4], B01[2], B11[2];
    int one8 = 0x7F7F7F7F; asm volatile("" : "+v"(one8));
    unsigned cvA[2][2], nvA[2][2];
    PG8_VOFF(cvA, cur);
    const char* cA = Abase + AR.tilebase(cur) * ELT;
    const char* cB = Bbase + (size_t)cur.e * b_estride + (size_t)cur.pn * tstep;
    PG8_STAGE(PG8_SB(0, 0), cB, voffB); PG8_STAGE(PG8_SB(0, 1), cB + hstep, voffB); PG8_STAGE(PG8_SA(0, 0), cA, cvA[0]); PG8_STAGE(PG8_SA(0, 1), cA, cvA[1]);
    if (wr == 1) PG8_BAR;
    PG8_WAIT_V(2); PG8_BAR;
    PG8_STAGE(PG8_SB(1, 0), cB + kstep, voffB); PG8_STAGE(PG8_SA(1, 0), cA + kstep, cvA[0]); PG8_STAGE(PG8_SB(1, 1), cB + hstep + kstep, voffB);
    PG8_WAIT_V(6); PG8_BAR;
    for (;;) {
        const bool has_next = S.next(ui + 1, nxt);
        if constexpr (!ARow::UNIFORM) { if (has_next) { PG8_VOFF(nvA, nxt); } else {
#pragma unroll
            for (int h = 0; h < 2; ++h)
#pragma unroll
                for (int i = 0; i < 2; ++i) nvA[h][i] = cvA[h][i]; } }
        const char* nA = has_next ? Abase + AR.tilebase(nxt) * ELT : cA;
        const char* nB = has_next ? Bbase + (size_t)nxt.e * b_estride + (size_t)nxt.pn * tstep : cB;
#pragma nounroll
        for (int t = 0; t < nt; t += 2) {
            const bool last = (t == nt - 2);
            if constexpr (Epi::MID) { if (t == nt / 2) { int fr2 = fr, fq2 = fq; asm volatile("" : "+v"(fr2), "+v"(fq2)); E.mid(acc, cur, wr, wc, fr2, fq2); } }
            const char* a1 = cA + (size_t)(t + 1) * kstep;
            const char* a2 = last ? nA : cA + (size_t)(t + 2) * kstep; const char* b2 = last ? nB : cB + (size_t)(t + 2) * kstep;
            const char* a3 = a2 + kstep; const char* b3 = b2 + kstep;
            unsigned v2[2][2];
#pragma unroll
            for (int h = 0; h < 2; ++h)
#pragma unroll
                for (int i = 0; i < 2; ++i) v2[h][i] = (!ARow::UNIFORM && last) ? nvA[h][i] : cvA[h][i];
            PG8_LDB(B0, 0, 0); PG8_LDB(B1, 0, 1); PG8_SCHED; PG8_LDA(At, 0, 0); PG8_STAGE(PG8_SA(1, 1), a1, cvA[1]);
            PG8_WAIT_V(8); PG8_WAIT_L(0); PG8_BAR; PG8_MMA(0, 0, At, B0); PG8_MMA(0, 1, At, B1); PG8_BAR; PG8_SCHED;
            PG8_LDA(At, 0, 1); PG8_STAGE(PG8_SB(0, 0), b2, voffB); PG8_STAGE(PG8_SB(0, 1), b2 + hstep, voffB); PG8_STAGE(PG8_SA(0, 0), a2, v2[0]);
            PG8_WAIT_V(8); PG8_WAIT_L(0); PG8_BAR; PG8_MMA(1, 0, At, B0); PG8_MMA(1, 1, At, B1); PG8_BAR; PG8_SCHED;
            PG8_LDB(B0, 1, 0); PG8_LDB(B1, 1, 1); PG8_SCHED; PG8_LDA(At, 1, 0); PG8_STAGE(PG8_SA(0, 1), a2, v2[1]);
            PG8_WAIT_V(8); PG8_WAIT_L(0); PG8_BAR; PG8_MMA(0, 0, At, B0); PG8_MMA(0, 1, At, B1); PG8_BAR; PG8_SCHED;
            PG8_LDA(At, 1, 1); PG8_STAGE(PG8_SB(1, 0), b3, voffB); PG8_STAGE(PG8_SB(1, 1), b3 + hstep, voffB); PG8_STAGE(PG8_SA(1, 0), a3, v2[0]);
            PG8_WAIT_V(8); PG8_WAIT_L(0); PG8_BAR; PG8_MMA(1, 0, At, B0); PG8_MMA(1, 1, At, B1); PG8_BAR; PG8_SCHED;
        }
        if (wr == 0) PG8_BAR;
        if constexpr (ELT == 1) asm volatile("s_nop 15\n\ts_nop 7" ::: "memory");
        if constexpr (!Epi::AFTER) { int fr2 = fr, fq2 = fq; asm volatile("" : "+v"(fr2), "+v"(fq2)); E(acc, cur, wr, wc, fr2, fq2); }
        if (!has_next) break;
#pragma unroll
        for (int a = 0; a < 2; ++a)
#pragma unroll
            for (int b = 0; b < 2; ++b)
#pragma unroll
                for (int m = 0; m < 4; ++m)
#pragma unroll
                    for (int n = 0; n < 2; ++n) acc[a][b][m][n] = (f32x4){0.f, 0.f, 0.f, 0.f};
        cur = nxt; cA = nA; cB = nB; ++ui;
        if constexpr (!ARow::UNIFORM) {
#pragma unroll
        for (int h = 0; h < 2; ++h)
#pragma unroll
            for (int i = 0; i < 2; ++i) cvA[h][i] = nvA[h][i]; }
        if (wr == 1) PG8_BAR;
    }
    PG8_WAIT_V(0);
    PG8_BAR;
    if constexpr (Epi::AFTER) { int fr2 = fr, fq2 = fq; asm volatile("" : "+v"(fr2), "+v"(fq2)); E.after(acc, cur, wr, wc, fr2, fq2, lds); }
#undef PG8_SA
#undef PG8_SB
#undef PG8_STAGE
#undef PG8_LDA
#undef PG8_LDB
#undef PG8_MMA
#undef PG8_WAIT_V
#undef PG8_WAIT_L
#undef PG8_BAR
#undef PG8_SCHED
#undef PG8_VOFF
#undef PG8_LD16
#undef PG8_CAT
}

__device__ __forceinline__ float sigm(float x) { return __builtin_amdgcn_rcpf(1.f + __builtin_amdgcn_exp2f(-1.4426950408889634f * x)); }
struct EpiSwiglu {
    static constexpr bool PERM = true, MID = false, AFTER = false;
    unsigned char* act; const float* b_gu; const float* rowscale;
    __device__ __forceinline__ void operator()(const f32x4 (&acc)[2][2][4][2], const Unit& u, int wr, int wc, int fr, int fq) const {
        const int row0 = u.pm * BM + wr * 64 + fr, col0 = u.pn * HALF + wc * 32 + 8 * fq;
        const float* bias = b_gu + (size_t)u.e * (2 * DFF) + col0;
        f32x4 bg[2], bu[2];
#pragma unroll
        for (int n = 0; n < 2; ++n) { bg[n] = *(const f32x4*)(bias + 4 * n); bu[n] = *(const f32x4*)(bias + DFF + 4 * n); }
#pragma unroll
        for (int ai = 0; ai < 2; ++ai)
#pragma unroll
            for (int m = 0; m < 4; ++m) { const int row = row0 + ai * HALF + m * 16; const float rs = rowscale[row] * W8_INV;
                float o[8];
#pragma unroll
                for (int n = 0; n < 2; ++n)
#pragma unroll
                    for (int j = 0; j < 4; ++j) { const float g = fminf(acc[ai][0][m][n][j] * rs + bg[n][j], 7.f); const float up = fminf(fmaxf(acc[ai][1][m][n][j] * rs + bu[n][j], -7.f), 7.f);
                        o[4 * n + j] = g * sigm(1.702f * g) * (up + 1.f); }
                *(uint2*)(act + (size_t)row * DFF + col0) = make_uint2(pk4_fp8(o[0], o[1], o[2], o[3]), pk4_fp8(o[4], o[5], o[6], o[7])); }
    }
};
struct EpiScatter {
    static constexpr bool PERM = true, MID = false, AFTER = false;
    bf16_t* Y; const float* b_dn; const int* rowtok; const float* rowgate;
    __device__ __forceinline__ void operator()(const f32x4 (&acc)[2][2][4][2], const Unit& u, int wr, int wc, int fr, int fq) const {
        const int row0 = u.pm * BM + wr * 64 + fr, col0 = u.pn * BM + wc * 32 + 8 * fq;
        const float* bias = b_dn + (size_t)u.e * D + col0;
        f32x4 bv[2][2];
#pragma unroll
        for (int bj = 0; bj < 2; ++bj)
#pragma unroll
            for (int n = 0; n < 2; ++n) bv[bj][n] = *(const f32x4*)(bias + bj * HALF + 4 * n) * W8_MUL;
#pragma unroll
        for (int ai = 0; ai < 2; ++ai)
#pragma unroll
            for (int m = 0; m < 4; ++m) { const int row = row0 + ai * HALF + m * 16; const int id = rowtok[row]; const float gt = rowgate[row] * W8_INV;
                if (id >= 0) { bf16_t* yp = Y + (size_t)id * D + col0;
#pragma unroll
                    for (int bj = 0; bj < 2; ++bj) { const f32x4 v0 = (acc[ai][bj][m][0] + bv[bj][0]) * gt, v1 = (acc[ai][bj][m][1] + bv[bj][1]) * gt;
                        u32x4 w; w.x = cvt_pk_bf16(v0[0], v0[1]); w.y = cvt_pk_bf16(v0[2], v0[3]); w.z = cvt_pk_bf16(v1[0], v1[1]); w.w = cvt_pk_bf16(v1[2], v1[3]);
                        *(u32x4*)(yp + bj * HALF) = w; } } }
    }
};
struct EpiQKVU {
    static constexpr bool PERM = true, MID = false, AFTER = false;
    bf16_t* O; size_t stride; bf16_t* ux;
    __device__ __forceinline__ void operator()(const f32x4 (&acc)[2][2][4][2], const Unit& u, int wr, int wc, int fr, int fq) const {
        const int row0 = u.pm * BM + wr * 64 + fr, t = u.pn >> 1; const float sc = (t == 0) ? C2 : 1.f;
        const int colt = (u.pn & 1) * BM + wc * 32 + 8 * fq;
        bf16_t* base = O + (size_t)t * stride + colt;
#pragma unroll
        for (int ai = 0; ai < 2; ++ai)
#pragma unroll
            for (int m = 0; m < 4; ++m) { const int row = row0 + ai * HALF + m * 16;
#pragma unroll
                for (int bj = 0; bj < 2; ++bj) { const f32x4 v0 = acc[ai][bj][m][0] * sc, v1 = acc[ai][bj][m][1] * sc;
                    u32x4 w; w.x = cvt_pk_bf16(v0[0], v0[1]); w.y = cvt_pk_bf16(v0[2], v0[3]); w.z = cvt_pk_bf16(v1[0], v1[1]); w.w = cvt_pk_bf16(v1[2], v1[3]);
                    if (t < 3) *(u32x4*)(base + (size_t)row * 512 + bj * HALF) = w;
                    else { const int col = colt + bj * HALF, g = col >> 4, b = row >> 12, tt = row & (S - 1);
                        *(u32x4*)(ux + ((size_t)((g * NB + b) * 256 + (tt >> 4))) * UXP + (tt & 15) * 16 + (col & 15)) = w; } } }
    }
};
struct EpiS5H {
    static constexpr bool PERM = false, MID = false, AFTER = true;
    bf16_t* ux; const float* a16;
    __device__ __forceinline__ void operator()(const f32x4 (&)[2][2][4][2], const Unit&, int, int, int, int) const {}
    __device__ __forceinline__ void after(const f32x4 (&acc)[2][2][4][2], const Unit& u, int wr, int wc, int fr, int fq, PG8_LAS unsigned char* lds) const {
        PG8_LAS float* Sx = (PG8_LAS float*)lds;
        const int row0 = wr * 64 + fr, col0 = wc * 32 + 4 * fq;
#pragma unroll
        for (int ai = 0; ai < 2; ++ai)
#pragma unroll
            for (int m = 0; m < 4; ++m)
#pragma unroll
                for (int n = 0; n < 2; ++n) *(PG8_LAS f32x4*)(Sx + (row0 + ai * HALF + m * 16) * 128 + col0 + n * 16) = acc[ai][0][m][n];
        asm volatile("s_waitcnt lgkmcnt(0)" ::: "memory"); __builtin_amdgcn_s_barrier(); asm volatile("" ::: "memory");
        int tq = (wr * 4 + wc) * 64 + fq * 16 + fr; asm volatile("" : "+v"(tq));
        if (tq < 64) {
            const int p = tq; const float ar = a16[2 * p], ai_ = a16[2 * p + 1]; float xr = 0.f, xi = 0.f;
            bf16_t* urow = ux + (size_t)u.pm * 256 * UXP + 256;
            urow[p] = 0; urow[64 + p] = 0;
#pragma unroll 8
            for (int c = 0; c < 255; ++c) { const float sr = Sx[c * 128 + p], si = Sx[c * 128 + 64 + p];
                const float nxr = ar * xr - ai_ * xi + sr, nxi = ar * xi + ai_ * xr + si; xr = nxr; xi = nxi;
                urow[(size_t)(c + 1) * UXP + p] = f2bf(xr); urow[(size_t)(c + 1) * UXP + 64 + p] = f2bf(xi); }
            asm volatile("s_waitcnt vmcnt(0)" ::: "memory");
        }
        asm volatile("s_waitcnt lgkmcnt(0)" ::: "memory"); __builtin_amdgcn_s_barrier(); asm volatile("" ::: "memory");
    }
};
struct EpiS5Y {
    static constexpr bool PERM = true, MID = false, AFTER = false;
    const bf16_t* ux; const float* d_skip; bf16_t* G;
    __device__ __forceinline__ void operator()(const f32x4 (&acc)[2][2][4][2], const Unit& u, int wr, int wc, int fr, int fq) const {
        const int row0 = wr * 64 + fr, g = u.e, b = u.pm & 7, co0 = 8 * (fq & 1);
        const f32x4 d0 = *(const f32x4*)(d_skip + g * 16 + co0), d1 = *(const f32x4*)(d_skip + g * 16 + co0 + 4);
#pragma unroll
        for (int ai = 0; ai < 2; ++ai)
#pragma unroll
            for (int m = 0; m < 4; ++m) { const int c = row0 + ai * HALF + m * 16;
#pragma unroll
                for (int bj = 0; bj < 2; ++bj) { const int ncol = bj * HALF + wc * 32 + 8 * fq, i = ncol >> 4;
                    const u32x4 uv = *(const u32x4*)(ux + ((size_t)u.pm * 256 + c) * UXP + ncol); float o[8];
#pragma unroll
                    for (int n = 0; n < 2; ++n)
#pragma unroll
                        for (int j = 0; j < 4; ++j) { const unsigned w = uv[2 * n + (j >> 1)]; const float uu = __builtin_bit_cast(float, (j & 1) ? (w & 0xffff0000u) : (w << 16));
                            const float y = acc[ai][bj][m][n][j] + (n ? d1[j] : d0[j]) * uu; o[4 * n + j] = y * sigm(1.5957691216057308f * (y + 0.044715f * y * y * y)); }
                    u32x4 w; w.x = cvt_pk_bf16(o[0], o[1]); w.y = cvt_pk_bf16(o[2], o[3]); w.z = cvt_pk_bf16(o[4], o[5]); w.w = cvt_pk_bf16(o[6], o[7]);
                    *(u32x4*)(G + ((size_t)b * S + c * 16 + i) * SW + g * 16 + co0) = w; } }
    }
};
struct EpiGlu {
    static constexpr bool PERM = true, MID = false, AFTER = false;
    const bf16_t* G; bf16_t* mixb; const float* b_glu; float* pss;
    __device__ __forceinline__ void operator()(const f32x4 (&acc)[2][2][4][2], const Unit& u, int wr, int wc, int fr, int fq) const {
        const int row0 = u.pm * BM + wr * 64 + fr, col0 = u.pn * BM + wc * 32 + 8 * fq;
        f32x4 bv[2][2];
#pragma unroll
        for (int bj = 0; bj < 2; ++bj)
#pragma unroll
            for (int n = 0; n < 2; ++n) bv[bj][n] = *(const f32x4*)(b_glu + col0 + bj * HALF + 4 * n);
#pragma unroll
        for (int ai = 0; ai < 2; ++ai)
#pragma unroll
            for (int m = 0; m < 4; ++m) { const int row = row0 + ai * HALF + m * 16; float ss = 0.f;
#pragma unroll
                for (int bj = 0; bj < 2; ++bj) { const u32x4 gv = *(const u32x4*)(G + (size_t)row * SW + col0 + bj * HALF); float o[8];
#pragma unroll
                    for (int n = 0; n < 2; ++n)
#pragma unroll
                        for (int j = 0; j < 4; ++j) { const unsigned w = gv[2 * n + (j >> 1)]; const float g = __builtin_bit_cast(float, (j & 1) ? (w & 0xffff0000u) : (w << 16));
                            const float v = g * sigm(acc[ai][bj][m][n][j] + bv[bj][n][j]); o[4 * n + j] = v; ss += v * v; }
                    u32x4 w; w.x = cvt_pk_bf16(o[0], o[1]); w.y = cvt_pk_bf16(o[2], o[3]); w.z = cvt_pk_bf16(o[4], o[5]); w.w = cvt_pk_bf16(o[6], o[7]);
                    *(u32x4*)(mixb + (size_t)row * D + AW + col0 + bj * HALF) = w; }
                ss += swz_xor<16>(ss); ss = xhalf_sum(ss);
                if (fq == 0) pss[(size_t)row * 8 + u.pn * 4 + wc] = ss; }
    }
};
struct EpiOut {
    static constexpr bool PERM = false, MID = true, AFTER = false;
    const float* x; float* x1; unsigned char* x1f8; const PG8_LAS float* stat;
    __device__ __forceinline__ void mid(f32x4 (&acc)[2][2][4][2], const Unit& u, int wr, int wc, int fr, int fq) const {
        const PG8_LAS float* st = stat + (((u.pm >> 3) & 1) * 256 + wr * 64 + fr) * 2;
#pragma unroll
        for (int ai = 0; ai < 2; ++ai)
#pragma unroll
            for (int m = 0; m < 4; ++m) { const float f = st[(ai * HALF + m * 16) * 2];
#pragma unroll
                for (int bj = 0; bj < 2; ++bj)
#pragma unroll
                    for (int n = 0; n < 2; ++n) acc[ai][bj][m][n] *= f; }
    }
    __device__ __forceinline__ void operator()(const f32x4 (&acc)[2][2][4][2], const Unit& u, int wr, int wc, int fr, int fq) const {
        int row0 = u.pm * BM + wr * 64 + fr; asm volatile("" : "+v"(row0)); const int col0 = u.pn * BM + wc * 32 + 4 * fq;
        const PG8_LAS float* st = stat + (((u.pm >> 3) & 1) * 256 + wr * 64 + fr) * 2 + 1;
#pragma unroll
        for (int ai = 0; ai < 2; ++ai)
#pragma unroll
            for (int m = 0; m < 4; ++m) { const int row = row0 + ai * HALF + m * 16; const float rs = st[(ai * HALF + m * 16) * 2]; const size_t off = (size_t)row * D + col0;
#pragma unroll
                for (int bj = 0; bj < 2; ++bj)
#pragma unroll
                    for (int n = 0; n < 2; ++n) { const size_t o2 = off + bj * HALF + n * 16; const f32x4 v = *(const f32x4*)(x + o2) + acc[ai][bj][m][n] * rs;
                        *(f32x4*)(x1 + o2) = v; *(unsigned*)(x1f8 + o2) = pk4_fp8(v[0], v[1], v[2], v[3]); }
                if (m & 1) asm volatile("" ::: "memory"); }
    }
};
struct EpiGate {
    static constexpr bool PERM = false, MID = false, AFTER = false;
    bf16_t* gs;
    __device__ __forceinline__ void operator()(const f32x4 (&acc)[2][2][4][2], const Unit& u, int wr, int wc, int fr, int fq) const {
        const int row0 = u.pm * BM + wr * 64 + fr, col0 = u.pn * BM + wc * 32 + 4 * fq;
#pragma unroll
        for (int ai = 0; ai < 2; ++ai)
#pragma unroll
            for (int m = 0; m < 4; ++m) { const size_t off = (size_t)(row0 + ai * HALF + m * 16) * D + col0;
#pragma unroll
                for (int bj = 0; bj < 2; ++bj)
#pragma unroll
                    for (int n = 0; n < 2; ++n) { const f32x4 a = acc[ai][bj][m][n]; uint2 w; w.x = cvt_pk_bf16(sigm(a[0]), sigm(a[1])); w.y = cvt_pk_bf16(sigm(a[2]), sigm(a[3])); *(uint2*)(gs + off + bj * HALF + n * 16) = w; } }
    }
};
struct EpiPle {
    static constexpr bool PERM = false, MID = false, AFTER = false;
    const bf16_t* gs; float* x2;
    __device__ __forceinline__ void operator()(const f32x4 (&acc)[2][2][4][2], const Unit& u, int wr, int wc, int fr, int fq) const {
        const int row0 = u.pm * BM + wr * 64 + fr, col0 = u.pn * BM + wc * 32 + 4 * fq;
#pragma unroll
        for (int ai = 0; ai < 2; ++ai)
#pragma unroll
            for (int m = 0; m < 4; ++m) { const size_t off = (size_t)(row0 + ai * HALF + m * 16) * D + col0;
#pragma unroll
                for (int bj = 0; bj < 2; ++bj)
#pragma unroll
                    for (int n = 0; n < 2; ++n) { const size_t o2 = off + bj * HALF + n * 16;
                        const unsigned long long gw_ = __hip_atomic_load((const unsigned long long*)(gs + o2), __ATOMIC_RELAXED, __HIP_MEMORY_SCOPE_AGENT);
                        const unsigned lo = (unsigned)gw_, hi = (unsigned)(gw_ >> 32);
                        f32x4 g; g[0] = __builtin_bit_cast(float, lo << 16); g[1] = __builtin_bit_cast(float, lo & 0xffff0000u); g[2] = __builtin_bit_cast(float, hi << 16); g[3] = __builtin_bit_cast(float, hi & 0xffff0000u);
                        *(f32x4*)(x2 + o2) = *(const f32x4*)(x2 + o2) + g * acc[ai][bj][m][n]; } }
    }
};
}

struct TrItem { const float* W; const float* kscale; bf16_t* WT; int ldw, k0, c0, K, r0; bool f8; };
__device__ __forceinline__ void tr_load(const TrItem& d, float (&v)[32], int lane) {
    const float* p = d.W + (size_t)(d.k0 + (lane >> 5)) * d.ldw + d.c0 + (lane & 31);
#pragma unroll
    for (int i = 0; i < 32; ++i) v[i] = p[(size_t)(2 * i) * d.ldw];
}
__device__ __forceinline__ void tr_store(const TrItem& d, const float (&v)[32], __attribute__((address_space(3))) float* scr, int lane) {
    const int c = lane & 7;
    float ks[8];
#pragma unroll
    for (int j = 0; j < 8; ++j) ks[j] = d.kscale ? d.kscale[d.k0 + 8 * c + j] : 1.f;
#pragma unroll
    for (int i = 0; i < 32; ++i) scr[(2 * i + (lane >> 5)) * 33 + (lane & 31)] = v[i];
    __builtin_amdgcn_s_waitcnt(0xC07F); asm volatile("" ::: "memory");
#pragma unroll
    for (int j = 0; j < 4; ++j) { const int n = (lane >> 3) + 8 * j; const __attribute__((address_space(3))) float* s = scr + (8 * c) * 33 + n;
        uint4 o; o.x = pk2(s[0 * 33] * ks[0], s[1 * 33] * ks[1]); o.y = pk2(s[2 * 33] * ks[2], s[3 * 33] * ks[3]); o.z = pk2(s[4 * 33] * ks[4], s[5 * 33] * ks[5]); o.w = pk2(s[6 * 33] * ks[6], s[7 * 33] * ks[7]);
        if (!d.f8) *(uint4*)(d.WT + (size_t)(d.r0 + n) * d.K + d.k0 + 8 * c) = o;
        else *(uint2*)((unsigned char*)d.WT + (size_t)(d.r0 + n) * d.K + d.k0 + 8 * c) = make_uint2(pk4_fp8(s[0 * 33] * ks[0] * pg8::W8_MUL, s[1 * 33] * ks[1] * pg8::W8_MUL, s[2 * 33] * ks[2] * pg8::W8_MUL, s[3 * 33] * ks[3] * pg8::W8_MUL),
                                                                                                           pk4_fp8(s[4 * 33] * ks[4] * pg8::W8_MUL, s[5 * 33] * ks[5] * pg8::W8_MUL, s[6 * 33] * ks[6] * pg8::W8_MUL, s[7 * 33] * ks[7] * pg8::W8_MUL)); }
    __builtin_amdgcn_s_waitcnt(0xC07F); asm volatile("" ::: "memory");
}

namespace attn_body {
using bf16x8=__attribute__((ext_vector_type(8)))short;
using s16x4=__attribute__((ext_vector_type(4)))short;
using f32x16=__attribute__((ext_vector_type(16)))float;
using f32x4=__attribute__((ext_vector_type(4)))float;
using u32x4=__attribute__((ext_vector_type(4)))unsigned;
constexpr int SEQ=S,DH=64,DM=NH*DH,OPITCH=D;
constexpr int NW=8,QBLK=32,QB=QBLK*NW,KVBLK=64,NQB=SEQ/QB;
__device__ __forceinline__ int crow(int r,int hi){return (r&3)+8*(r>>2)+4*hi;}
#define SBAR() __builtin_amdgcn_sched_barrier(0)
__device__ __forceinline__ void cmask(f32x16&p0,f32x16&p1,int jb,int qrel,int hi){
  const float NEG=-INFINITY; int kb=64*jb+4*hi;
  #pragma unroll
  for(int r=0;r<16;++r){int kv=kb+(r&3)+8*(r>>2); if(kv>qrel)p0[r]=NEG; if(kv+32>qrel)p1[r]=NEG;}
}
constexpr int NSLOT=3, SLOTB=8192;
constexpr int LDS_K=0, LDS_V=NSLOT*SLOTB, LDS_WS=2*NSLOT*SLOTB, LDS_OST=LDS_WS+NW*64*4, LDS_C=LDS_OST+NW*4096, ATT_LDS_BYTES=LDS_C+(SEQ+64)*4;
__device__ __forceinline__ void glds16(const void*gsrc,unsigned lds_dst){unsigned keep;
  asm volatile("s_mov_b32 %0, m0\n\ts_mov_b32 m0, %2\n\ts_nop 0\n\tglobal_load_lds_dwordx4 %1, off\n\ts_mov_b32 m0, %0":"=&s"(keep):"v"(gsrc),"s"(lds_dst):"memory");}
__device__ __forceinline__ float max3f(float a,float b,float c){float r;asm("v_max3_f32 %0, %1, %2, %3":"=v"(r):"v"(a),"v"(b),"v"(c));return r;}
__device__ __forceinline__ float max2f(float a,float b){float r;asm("v_max_f32_e32 %0, %1, %2":"=v"(r):"v"(a),"v"(b));return r;}
__device__ __forceinline__ float fadd_s(float a,float b){float r;asm("v_add_f32_e32 %0, %1, %2":"=v"(r):"v"(a),"v"(b));return r;}
__device__ __forceinline__ float fsub_s(float a,float b){float r;asm("v_sub_f32_e32 %0, %1, %2":"=v"(r):"v"(a),"v"(b));return r;}
typedef float f32x2_t __attribute__((ext_vector_type(2))); typedef __bf16 bf16x2_t __attribute__((ext_vector_type(2)));
__device__ __forceinline__ unsigned cvtpk_s(float lo,float hi){f32x2_t v={lo,hi};bf16x2_t b=__builtin_convertvector(v,bf16x2_t);return __builtin_bit_cast(unsigned,b);}
#define WAIT_BAR(N) asm volatile("s_waitcnt vmcnt(" #N ") lgkmcnt(0)\n\ts_barrier":::"memory")
typedef __attribute__((address_space(3))) const char* lds_cptr;
typedef __attribute__((address_space(3))) const float* lds_fptr;
typedef short v4i16_t __attribute__((ext_vector_type(4)));
__device__ __forceinline__ void qkt(f32x16&p0,f32x16&p1,const char*Kslot,const bf16x8*qr,int r32,int hi){
  const char*kb=Kslot+hi*1024+r32*16;
  #pragma unroll
  for(int d0=0;d0<4;++d0){
    const bf16x8 b0=*reinterpret_cast<const bf16x8*>(kb+d0*2048);
    const bf16x8 b1=*reinterpret_cast<const bf16x8*>(kb+d0*2048+512);
    p0=__builtin_amdgcn_mfma_f32_32x32x16_bf16(b0,qr[d0],p0,0,0,0);p1=__builtin_amdgcn_mfma_f32_32x32x16_bf16(b1,qr[d0],p1,0,0,0);}
}
__device__ __forceinline__ void kload8(bf16x8*kf,lds_cptr kp){
  kf[0]=*(const __attribute__((address_space(3))) bf16x8*)(kp);      kf[1]=*(const __attribute__((address_space(3))) bf16x8*)(kp+512);
  kf[2]=*(const __attribute__((address_space(3))) bf16x8*)(kp+2048); kf[3]=*(const __attribute__((address_space(3))) bf16x8*)(kp+2560);
  kf[4]=*(const __attribute__((address_space(3))) bf16x8*)(kp+4096); kf[5]=*(const __attribute__((address_space(3))) bf16x8*)(kp+4608);
  kf[6]=*(const __attribute__((address_space(3))) bf16x8*)(kp+6144); kf[7]=*(const __attribute__((address_space(3))) bf16x8*)(kp+6656);
}
__device__ __forceinline__ void kload2(bf16x8*kf,lds_cptr kp,int j){ kf[2*j]=*(const __attribute__((address_space(3))) bf16x8*)(kp+j*2048); kf[2*j+1]=*(const __attribute__((address_space(3))) bf16x8*)(kp+j*2048+512); }
__device__ __forceinline__ s16x4 vtr(lds_cptr p){ return __builtin_bit_cast(s16x4,__builtin_amdgcn_ds_read_tr16_b64_v4i16((__attribute__((address_space(3))) v4i16_t*)p)); }
__device__ __forceinline__ float rowmax(const f32x16&p0,const f32x16&p1){
  float a=max3f(p0[0],p0[1],p1[0]),b=max3f(p0[2],p0[3],p1[1]);a=max3f(a,p1[2],p1[3]);
  #pragma unroll
  for(int r=4;r<16;r+=4){a=max3f(a,p0[r],p0[r+1]);b=max3f(b,p0[r+2],p0[r+3]);a=max3f(a,p1[r],p1[r+1]);b=max3f(b,p1[r+2],p1[r+3]);}
  const float m=max2f(a,b);
  auto rr=__builtin_amdgcn_permlane32_swap(__float_as_uint(m),__float_as_uint(m),false,false);
  return max2f(__uint_as_float(rr[0]),__uint_as_float(rr[1]));
}
__device__ __forceinline__ void pv(f32x16*o,int vb,bf16x8 pa0,bf16x8 pa1,bf16x8 pa2,bf16x8 pa3){
  #pragma unroll
  for(int d0=0;d0<2;++d0){s16x4 lo[4],hi[4];
    #pragma unroll
    for(int ks=0;ks<4;++ks){
      asm volatile("ds_read_b64_tr_b16 %0,%1 offset:%c2":"=&v"(lo[ks]):"v"(vb),"i"(d0*4096+ks*1024):"memory");
      asm volatile("ds_read_b64_tr_b16 %0,%1 offset:%c2":"=&v"(hi[ks]):"v"(vb),"i"(d0*4096+ks*1024+512):"memory");}
    asm volatile("s_waitcnt lgkmcnt(0)":::"memory");SBAR();
    #define PK(k) (bf16x8){lo[k][0],lo[k][1],lo[k][2],lo[k][3],hi[k][0],hi[k][1],hi[k][2],hi[k][3]}
    o[d0]=__builtin_amdgcn_mfma_f32_32x32x16_bf16(pa0,PK(0),o[d0],0,0,0);
    o[d0]=__builtin_amdgcn_mfma_f32_32x32x16_bf16(pa1,PK(1),o[d0],0,0,0);
    o[d0]=__builtin_amdgcn_mfma_f32_32x32x16_bf16(pa2,PK(2),o[d0],0,0,0);
    o[d0]=__builtin_amdgcn_mfma_f32_32x32x16_bf16(pa3,PK(3),o[d0],0,0,0);
    #undef PK
  }
}
__device__ __forceinline__ void prep_c(int tid0,int b,int h,const float*logf,char*shm){
  int tid=tid0; asm volatile("":"+v"(tid)); const int lane=tid&63,wid=tid>>6;
  float*cl=(float*)(shm+LDS_C); float*wtot=(float*)(shm+LDS_WS);
  float v[8]; float tot=0.f;
  #pragma unroll
  for(int i=0;i<8;++i){ v[i]=logf[((size_t)b*SEQ+tid*8+i)*8+h]; tot+=v[i]; }
  float incl=tot;
  #pragma unroll
  for(int o=1;o<64;o<<=1){ const float n=bperm(incl,(lane-o)&63); if(lane>=o)incl+=n; }
  if(lane==63)wtot[wid]=incl;
  __syncthreads();
  float pre=incl-tot;
  #pragma unroll
  for(int w=0;w<8;++w) if(w<wid)pre+=wtot[w];
  #pragma unroll
  for(int i=0;i<8;++i){ pre+=v[i]; cl[tid*8+i]=pre*LOG2E; }
  if(tid<64)cl[SEQ+tid]=0.f;
  __syncthreads();
}
template<int THRL> __device__ __forceinline__ void attn_unit(int tid0,int b,int h,int qb,const bf16_t*Q,const bf16_t*__restrict__ K,const bf16_t*__restrict__ V,bf16_t*O,float*psa,char*shm){
  int tid=tid0; asm volatile("":"+v"(tid)); const int lane=tid&63,r32=lane&31,hi=lane>>5; const int wid=__builtin_amdgcn_readfirstlane(tid>>6);
  const long rowbase=(long)b*SEQ; const int q0=qb*QB;
  const bf16_t*Qw=Q+(rowbase+q0+wid*QBLK)*DM+h*DH;
  const bf16_t*Kh=K+rowbase*DM+h*DH,*Vh=V+rowbase*DM+h*DH;
  const unsigned lds0=(unsigned)(uintptr_t)shm;
  float*wsf=(float*)(shm+LDS_WS)+wid*64;
  const bf16_t*ksrc=Kh+(long)lane*DM+wid*8;
  const bf16_t*vsrc=Vh+(long)(16*(wid&3)+(lane>>2))*DM+(wid>>2)*32+(lane&3)*8;
  const unsigned kdst=lds0+LDS_K+wid*1024, vdst=lds0+LDS_V+wid*1024;
  #define DMA_K(t,slot) glds16(ksrc+(long)(t)*KVBLK*DM,(unsigned)__builtin_amdgcn_readfirstlane(kdst+(slot)))
  #define DMA_V(t,slot) glds16(vsrc+(long)(t)*KVBLK*DM,(unsigned)__builtin_amdgcn_readfirstlane(vdst+(slot)))
  const int vb0=(int)(lds0+LDS_V)+((lane>>4)&1)*32+(lane&3)*8+(4*hi+((lane&15)>>2))*64;
  const char*Kbase=shm+LDS_K; bf16x8 kf[8];
  const lds_cptr shm3=(lds_cptr)shm; const lds_cptr kp0=shm3+LDS_K+hi*1024+r32*16; const lds_cptr vp0=shm3+LDS_V+((lane>>4)&1)*32+(lane&3)*8+(4*hi+((lane&15)>>2))*64;
  const lds_fptr clh=(lds_fptr)(shm3+LDS_C)+4*hi;
  const int NT=(q0+QB)/KVBLK;
  DMA_K(0,0);DMA_V(0,0);DMA_K(1,SLOTB);
  bf16x8 qr[4];
  #pragma unroll
  for(int d0=0;d0<4;++d0)qr[d0]=*reinterpret_cast<const bf16x8*>(&Qw[(long)r32*DM+d0*16+hi*8]);
  float mhat=0.f,l_reg=0.f;f32x16 o[2];o[0]=f32x16{};o[1]=f32x16{};
  const int qrel=wid*QBLK+r32;
  const float cq2=((lds_fptr)(shm3+LDS_C))[q0+qrel];
  #define CMASK(P0,P1,t) do{int jb_=(t)-(NT-4); if(jb_>=0)cmask(P0,P1,jb_,qrel,hi);}while(0)
  #define CINIT(P0,P1,tt,basev_) do{ _Pragma("unroll") for(int g_=0;g_<4;++g_){ const f32x4 a_=*(const __attribute__((address_space(3))) f32x4*)(clh+64*(tt)+8*g_); const f32x4 b_=*(const __attribute__((address_space(3))) f32x4*)(clh+64*(tt)+32+8*g_); \
      _Pragma("unroll") for(int j_=0;j_<4;++j_){ P0[4*g_+j_]=(basev_)-a_[j_]; P1[4*g_+j_]=(basev_)-b_[j_]; } } }while(0)
  bool resc=false;
  #define START(P0,P1) do{ const float rm=rowmax(P0,P1); resc=false; \
    { const float dl=rm; mhat=fadd_s(mhat,dl); \
      _Pragma("unroll") for(int r=0;r<16;++r){P0[r]=fsub_s(P0[r],dl);P1[r]=fsub_s(P1[r],dl);} } \
    _Pragma("unroll") for(int r=0;r<16;++r)P0[r]=__builtin_amdgcn_exp2f(P0[r]); }while(0)
  #define RESC() do{ if(resc){ asm volatile("s_waitcnt lgkmcnt(0)":::"memory"); \
      _Pragma("unroll") for(int d_=0;d_<2;++d_) _Pragma("unroll") for(int r=0;r<16;++r)o[d_][r]*=wsf[crow(r,hi)]; } }while(0)
  f32x16 pA0,pA1,pB0,pB1;
  int sl_prev=0,sl_cur=0,sl_next=SLOTB;
  #define ROT() do{sl_prev=sl_cur;sl_cur=sl_next;sl_next=(sl_next==(NSLOT-1)*SLOTB)?0:sl_next+SLOTB;}while(0)
  DMA_K(2,2*SLOTB);
  CINIT(pA0,pA1,0,cq2);
  WAIT_BAR(3);
  qkt(pA0,pA1,Kbase,qr,r32,hi);asm volatile("s_nop 15\n\ts_nop 7":"+v"(pA0),"+v"(pA1));CMASK(pA0,pA1,0);
  START(pA0,pA1);
  _Pragma("unroll") for(int r=0;r<16;++r)pA1[r]=__builtin_amdgcn_exp2f(pA1[r]);
  { const float bv0=cq2-mhat; CINIT(pB0,pB1,1,bv0); }
  WAIT_BAR(0);
  DMA_K(3,0);DMA_V(1,SLOTB);
  ROT();
  kload8(kf,kp0+sl_cur);
  WAIT_BAR(2);
  s16x4 vlo[8],vhi[8]; u32x4 pw0,pw1,pw2,pw3;
  #define PKW(P,B) cvtpk_s(P[B],P[B+1])
  #define PAF(k) __builtin_bit_cast(bf16x8,pw##k)
  #define VFR(i) (bf16x8){vlo[i][0],vlo[i][1],vlo[i][2],vlo[i][3],vhi[i][0],vhi[i][1],vhi[i][2],vhi[i][3]}
  #define PIN(x) asm volatile("":"+v"(x))
  #define MX3(a,b,c) __builtin_fmaxf(__builtin_fmaxf((a),(b)),(c))
  #define GAPA(MF,A0,A1,A2,A3,W0,W1,PW) do{ MF; sacc+=A0; sacc+=A1; sacc+=A2; sacc+=A3; PIN(sacc); W0; W1; PIN(PW); SBAR(); }while(0)
  #define EX(v) __builtin_amdgcn_exp2f(v)
  #define CKRD(i) (*(const __attribute__((address_space(3))) f32x4*)(clt_+(((i)>>2)*32+((i)&3)*8)))
  #define GAPB(MF,X,B,PN,G,IROW) do{ const f32x4 ck_=CKRD(IROW); MF; X[B]=EX(X[B]); X[B+1]=EX(X[B+1]); X[B+2]=EX(X[B+2]); X[B+3]=EX(X[B+3]); PIN(X); \
      PN[4*(G)]=basev-ck_[0]; PN[4*(G)+1]=basev-ck_[1]; PN[4*(G)+2]=basev-ck_[2]; PN[4*(G)+3]=basev-ck_[3]; PIN(PN); SBAR(); }while(0)
  #define VRD(i) do{ vlo[i]=vtr(vp_+(((i)>>2)*4096+((i)&3)*1024)); vhi[i]=vtr(vp_+(((i)>>2)*4096+((i)&3)*1024+512)); }while(0)
  #define KRD(G,j) do{ if(G){ kload2(kf,kp0+sl_next,j); SBAR(); } }while(0)
  #define STEP(C0,C1,P0,P1,t,GK,GV,GL) do{ SBAR(); \
    const lds_cptr vp_=vp0+sl_prev; const lds_fptr clt_=clh+64*((t)+1); \
    VRD(0); SBAR(); float sacc=(P0[0]+P0[1]); \
    GAPA(C0=__builtin_amdgcn_mfma_f32_32x32x16_bf16(kf[0],qr[0],C0,0,0,0), P0[2],P0[3],P0[4],P0[5],     pw0[0]=PKW(P0,0), pw0[1]=PKW(P0,2), pw0); \
    VRD(4); SBAR(); GAPA(C1=__builtin_amdgcn_mfma_f32_32x32x16_bf16(kf[1],qr[0],C1,0,0,0), P0[6],P0[7],P0[8],P0[9],     pw0[2]=PKW(P0,4), pw0[3]=PKW(P0,6), pw0); \
    VRD(1); SBAR(); GAPA(C0=__builtin_amdgcn_mfma_f32_32x32x16_bf16(kf[2],qr[1],C0,0,0,0),   P0[10],P0[11],P0[12],P0[13], pw1[0]=PKW(P0,8), pw1[1]=PKW(P0,10), pw1); \
    VRD(5); SBAR(); GAPA(C1=__builtin_amdgcn_mfma_f32_32x32x16_bf16(kf[3],qr[1],C1,0,0,0),   P0[14],P0[15],P1[0],P1[1],   pw1[2]=PKW(P0,12),pw1[3]=PKW(P0,14), pw1); \
    VRD(2); SBAR(); GAPA(C0=__builtin_amdgcn_mfma_f32_32x32x16_bf16(kf[4],qr[2],C0,0,0,0),   P1[2],P1[3],P1[4],P1[5],     pw2[0]=PKW(P1,0), pw2[1]=PKW(P1,2), pw2); \
    VRD(6); SBAR(); GAPA(C1=__builtin_amdgcn_mfma_f32_32x32x16_bf16(kf[5],qr[2],C1,0,0,0),   P1[6],P1[7],P1[8],P1[9],     pw2[2]=PKW(P1,4), pw2[3]=PKW(P1,6), pw2); \
    VRD(3); SBAR(); GAPA(C0=__builtin_amdgcn_mfma_f32_32x32x16_bf16(kf[6],qr[3],C0,0,0,0),   P1[10],P1[11],P1[12],P1[13], pw3[0]=PKW(P1,8), pw3[1]=PKW(P1,10), pw3); \
    VRD(7); SBAR(); GAPA(C1=__builtin_amdgcn_mfma_f32_32x32x16_bf16(kf[7],qr[3],C1,0,0,0),   P1[14],P1[15],0.f,0.f,       pw3[2]=PKW(P1,12),pw3[3]=PKW(P1,14), pw3); \
    l_reg+=sacc; \
    if(GK){DMA_K((t)+3,sl_cur);} if(GV){DMA_V((t)+1,sl_next);} \
    CMASK(C0,C1,t); \
    { float a=MX3(C0[0],C0[1],C1[0]),b=MX3(C0[2],C0[3],C1[1]); a=MX3(a,C1[2],C1[3]); \
      _Pragma("unroll") for(int r=4;r<16;r+=4){a=MX3(a,C0[r],C0[r+1]);b=MX3(b,C0[r+2],C0[r+3]);a=MX3(a,C1[r],C1[r+1]);b=MX3(b,C1[r+2],C1[r+3]);} \
      float rm=__builtin_fmaxf(a,b); { auto rr=__builtin_amdgcn_permlane32_swap(__float_as_uint(rm),__float_as_uint(rm),false,false); rm=__builtin_fmaxf(__uint_as_float(rr[0]),__uint_as_float(rr[1])); } \
      resc=false; \
      if(__builtin_expect(__any(rm>(float)THRL),0)){ const float dl=__builtin_fmaxf(rm,0.f); mhat+=dl; \
        _Pragma("unroll") for(int r=0;r<16;++r){C0[r]-=dl;C1[r]-=dl;} \
        const float f=__builtin_amdgcn_exp2f(-dl); l_reg*=f; if(hi==0)wsf[r32]=f; resc=true; } } \
    const float basev=cq2-mhat; \
    SBAR(); \
    GAPB(o[0]=__builtin_amdgcn_mfma_f32_32x32x16_bf16(PAF(0),VFR(0),o[0],0,0,0), C0,0,  P0,0,0); \
    GAPB(o[1]=__builtin_amdgcn_mfma_f32_32x32x16_bf16(PAF(0),VFR(4),o[1],0,0,0), C0,4,  P0,1,1); \
    KRD(GL,0); GAPB(o[0]=__builtin_amdgcn_mfma_f32_32x32x16_bf16(PAF(1),VFR(1),o[0],0,0,0), C0,8,  P0,2,2); \
    KRD(GL,1); GAPB(o[1]=__builtin_amdgcn_mfma_f32_32x32x16_bf16(PAF(1),VFR(5),o[1],0,0,0), C0,12, P0,3,3); \
    KRD(GL,2); GAPB(o[0]=__builtin_amdgcn_mfma_f32_32x32x16_bf16(PAF(2),VFR(2),o[0],0,0,0), C1,0,  P1,0,4); \
    KRD(GL,3); GAPB(o[1]=__builtin_amdgcn_mfma_f32_32x32x16_bf16(PAF(2),VFR(6),o[1],0,0,0), C1,4,  P1,1,5); \
    GAPB(o[0]=__builtin_amdgcn_mfma_f32_32x32x16_bf16(PAF(3),VFR(3),o[0],0,0,0), C1,8,  P1,2,6); \
    GAPB(o[1]=__builtin_amdgcn_mfma_f32_32x32x16_bf16(PAF(3),VFR(7),o[1],0,0,0), C1,12, P1,3,7); \
    }while(0)
  int t=1;
  #undef CMASK
  #define CMASK(P0,P1,t) do{}while(0)
  for(;t+5<NT;t+=2){
    STEP(pB0,pB1,pA0,pA1,t,true,true,true);     WAIT_BAR(2); RESC(); ROT();
    STEP(pA0,pA1,pB0,pB1,t+1,true,true,true);   WAIT_BAR(2); RESC(); ROT();
  }
  #undef CMASK
  #define CMASK(P0,P1,t) do{int jb_=(t)-(NT-4); if(jb_>=0)cmask(P0,P1,jb_,qrel,hi);}while(0)
  #define ENDW(tt) do{ if((tt)+3<NT){WAIT_BAR(2);} else if((tt)+2<NT){WAIT_BAR(1);} else {WAIT_BAR(0);} }while(0)
  for(;t+1<NT;t+=2){
    STEP(pB0,pB1,pA0,pA1,t,(t+3<NT),(t+1<NT),(t+1<NT));       ENDW(t);   RESC(); ROT();
    STEP(pA0,pA1,pB0,pB1,t+1,(t+4<NT),(t+2<NT),(t+2<NT));     ENDW(t+1); RESC(); ROT();
  }
  STEP(pB0,pB1,pA0,pA1,NT-1,false,false,false); RESC();
  { float sacc=pB0[0]+pB0[1]; _Pragma("unroll") for(int r=2;r<16;++r)sacc+=pB0[r]; _Pragma("unroll") for(int r=0;r<16;++r)sacc+=pB1[r]; l_reg+=sacc;
    pw0=(u32x4){PKW(pB0,0),PKW(pB0,2),PKW(pB0,4),PKW(pB0,6)};pw1=(u32x4){PKW(pB0,8),PKW(pB0,10),PKW(pB0,12),PKW(pB0,14)};pw2=(u32x4){PKW(pB1,0),PKW(pB1,2),PKW(pB1,4),PKW(pB1,6)};pw3=(u32x4){PKW(pB1,8),PKW(pB1,10),PKW(pB1,12),PKW(pB1,14)};
    SBAR(); pv(o,vb0+sl_cur,PAF(0),PAF(1),PAF(2),PAF(3)); }
  #undef PKW
  #undef PAF
  #undef VFR
  #undef PIN
  #undef MX3
  #undef GAPA
  #undef GAPB
  #undef CKRD
  #undef EX
  #undef VRD
  #undef KRD
  #undef STEP
  #undef ENDW
  {auto rr=__builtin_amdgcn_permlane32_swap(__float_as_uint(l_reg),__float_as_uint(l_reg),false,false);l_reg=__uint_as_float(rr[0])+__uint_as_float(rr[1]);}
  if(hi==0)wsf[32+r32]=l_reg;asm volatile("s_waitcnt lgkmcnt(0)":::"memory");
  float rli[16];
  #pragma unroll
  for(int r=0;r<16;++r)rli[r]=__builtin_amdgcn_rcpf(wsf[32+crow(r,hi)]);
  bf16_t*Ow=O+(rowbase+q0+wid*QBLK)*OPITCH+h*DH;
  { bf16_t*stg=(bf16_t*)(shm+LDS_OST)+wid*2048;
    #pragma unroll
    for(int r=0;r<16;++r){const int orow=crow(r,hi);
      #pragma unroll
      for(int d0=0;d0<2;++d0)stg[orow*64+d0*32+r32]=f2bf(o[d0][r]*rli[r]);}
    asm volatile("s_waitcnt lgkmcnt(0)":::"memory");
    #pragma unroll
    for(int i=0;i<4;++i){const int row=i*8+(lane>>3),ch=lane&7; const u32x4 v=*(const u32x4*)(stg+row*64+ch*8); *(u32x4*)(Ow+(long)row*OPITCH+ch*8)=v;
      float ss=0.f;
      #pragma unroll
      for(int j=0;j<4;++j){ const float lo_=__builtin_bit_cast(float,v[j]<<16), hi_=__builtin_bit_cast(float,v[j]&0xffff0000u); ss+=lo_*lo_+hi_*hi_; }
      ss+=swz_xor<1>(ss); ss+=swz_xor<2>(ss); ss+=swz_xor<4>(ss);
      if(ch==0)psa[(rowbase+q0+wid*QBLK+row)*8+h]=ss; } }
  asm volatile("s_waitcnt lgkmcnt(0)\n\ts_barrier":::"memory");
  #undef DMA_K
  #undef DMA_V
  #undef CMASK
  #undef CINIT
  #undef START
  #undef RESC
  #undef ROT
}
#undef SBAR
#undef WAIT_BAR
}

__device__ void s5_precompute(int g, const float* lam_re, const float* lam_im, const float* log_dt, const float* b_re, const float* b_im, const float* c_re, const float* c_im,
                              bf16_t* bth, bf16_t* bttg, float* a16, float* sm) {
    float* apr = sm; float* api = apr + 17 * 64; float* bbr = api + 17 * 64; float* bbi = bbr + 1024; float* cr = bbi + 1024; float* ci = cr + 1024; float* Kt = ci + 1024;
    const int tid = threadIdx.x;
    if (tid < 64) { const int p = tid; const float dt = __expf(log_dt[g]); const float lr = lam_re[g * NP + p], li = lam_im[g * NP + p];
        for (int tau = 0; tau <= 16; ++tau) { const float mag = __expf(lr * dt * (float)tau), ang = li * dt * (float)tau; apr[tau * 64 + p] = mag * cosf(ang); api[tau * 64 + p] = mag * sinf(ang); }
        const float abr = apr[64 + p], abi = api[64 + p], den = lr * lr + li * li, nr = abr - 1.f; const float zr = (nr * lr + abi * li) / den, zi = (abi * lr - nr * li) / den;
        for (int c = 0; c < NC; ++c) { const float br = b_re[(size_t)(g * NP + p) * NC + c], bi = b_im[(size_t)(g * NP + p) * NC + c]; bbr[p * 16 + c] = zr * br - zi * bi; bbi[p * 16 + c] = zr * bi + zi * br; }
        a16[(g * 64 + p) * 2] = apr[16 * 64 + p]; a16[(g * 64 + p) * 2 + 1] = api[16 * 64 + p]; }
    for (int i = tid; i < 1024; i += NTHR) { cr[i] = c_re[(size_t)g * 1024 + i]; ci[i] = c_im[(size_t)g * 1024 + i]; }
    __syncthreads();
    for (int idx = tid; idx < 4096; idx += NTHR) { const int tau = idx >> 8, co = (idx >> 4) & 15, cin = idx & 15; float sacc = 0.f;
        for (int p = 0; p < 64; ++p) { const float c_r = cr[co * 64 + p], c_i = ci[co * 64 + p], a_r = apr[tau * 64 + p], a_i = api[tau * 64 + p]; const float wr_ = c_r * a_r - c_i * a_i, wi_ = c_r * a_i + c_i * a_r;
            sacc += wr_ * bbr[p * 16 + cin] - wi_ * bbi[p * 16 + cin]; }
        Kt[idx] = sacc; }
    __syncthreads();
    bf16_t* tg = bttg + (size_t)g * 256 * UXP; bf16_t* hh = bth + (size_t)g * 256 * 256;
    for (int idx = tid; idx < 256 * UXP; idx += NTHR) { const int n = idx / UXP, k = idx - n * UXP, i = n >> 4, co = n & 15; float v;
        if (k < 256) { const int j = k >> 4, cin = k & 15; v = (j <= i) ? Kt[((i - j) << 8) + (co << 4) + cin] : 0.f; }
        else if (k < 320) { const int p = k - 256; v = cr[co * 64 + p] * apr[(i + 1) * 64 + p] - ci[co * 64 + p] * api[(i + 1) * 64 + p]; }
        else { const int p = k - 320; v = -(cr[co * 64 + p] * api[(i + 1) * 64 + p] + ci[co * 64 + p] * apr[(i + 1) * 64 + p]); }
        tg[idx] = f2bf(v); }
    for (int idx = tid; idx < 256 * 256; idx += NTHR) { const int n = idx >> 8, k = idx & 255, j = k >> 4, cin = k & 15; float v = 0.f;
        if (n < 64) v = apr[(15 - j) * 64 + n] * bbr[n * 16 + cin] - api[(15 - j) * 64 + n] * bbi[n * 16 + cin];
        else if (n < 128) { const int p = n - 64; v = apr[(15 - j) * 64 + p] * bbi[p * 16 + cin] + api[(15 - j) * 64 + p] * bbr[p * 16 + cin]; }
        hh[idx] = f2bf(v); }
    __syncthreads();
}


#define XB_TMO      128
#define XB_XCNT(j)  (256  + 64 * (j))
#define XB_XSUB(j)  (1280 + 64 * (j))
#define XB_XGEN(j)  (2304 + 64 * (j))
#define XB_TOP      3328
#define XB_TOPGEN   3392
#define XCD_BAR_WORDS 3456
#define XB_SPIN_CAP (1u << 22)
__device__ __forceinline__ unsigned xb_ld(unsigned* p)              { return __hip_atomic_load(p, __ATOMIC_RELAXED, __HIP_MEMORY_SCOPE_AGENT); }
__device__ __forceinline__ unsigned xb_add(unsigned* p, unsigned v) { return __hip_atomic_fetch_add(p, v, __ATOMIC_RELAXED, __HIP_MEMORY_SCOPE_AGENT); }
__device__ __forceinline__ unsigned xb_xcc_id() { return (unsigned)__builtin_amdgcn_s_getreg((3 << 11) | 20) & 0xFu; }
#define XB_SPIN(cond, bar) do { unsigned _sp = 0; while (cond) { __builtin_amdgcn_s_sleep(1); \
    if ((++_sp & 255u) == 0u) { if (xb_ld(&(bar)[XB_TMO])) break; if (_sp > XB_SPIN_CAP) { atomicAdd(&(bar)[XB_TMO], 1u); break; } } } } while (0)
struct XcdBarrier { unsigned* bar; unsigned x; volatile __attribute__((address_space(3))) unsigned* st; };
__device__ __forceinline__ XcdBarrier xcd_barrier_post(unsigned* bar, volatile __attribute__((address_space(3))) unsigned* st, bool leader) {
    XcdBarrier b; b.bar = bar; b.x = xb_xcc_id(); b.st = st;
    if (leader) (void)xb_add(&bar[XB_XCNT(b.x)], 1u);
    return b;
}
__device__ __forceinline__ void xcd_barrier_complete(unsigned* bar, unsigned x, unsigned G, unsigned& nloc, unsigned& nx) {
    unsigned sum, cnt, mine, sp = 0u;
    for (;;) {
        sum = 0u; cnt = 0u; mine = 0u;
#pragma unroll
        for (unsigned j = 0; j < 16; ++j) { const unsigned c = xb_ld(&bar[XB_XCNT(j)]); sum += c; cnt += (c > 0u) ? 1u : 0u; mine = (j == x) ? c : mine; }
        if (sum == G) break;
        __builtin_amdgcn_s_sleep(1);
        if ((++sp & 255u) == 0u) { if (xb_ld(&bar[XB_TMO])) break; if (sp > XB_SPIN_CAP) { atomicAdd(&bar[XB_TMO], 1u); break; } }
    }
    nloc = mine > 0u ? mine : 1u; nx = cnt > 0u ? cnt : 1u;
}
__device__ __forceinline__ void xcd_barrier(const XcdBarrier& b, bool leader, unsigned G) {
    asm volatile("s_waitcnt vmcnt(0)" ::: "memory");
    __syncthreads();
    if (leader) {
        unsigned* bar = b.bar;
        __builtin_amdgcn_s_waitcnt(0);
        unsigned nloc = b.st[0], nx = b.st[1];
        if (nloc == 0u) { xcd_barrier_complete(bar, b.x, G, nloc, nx); b.st[0] = nloc; b.st[1] = nx; }
        const unsigned old = xb_add(&bar[XB_XSUB(b.x)], 1u);
        const unsigned gen = old / nloc;
        if (old + 1u == (gen + 1u) * nloc) {
            __builtin_amdgcn_fence(__ATOMIC_RELEASE, "agent");
            asm volatile("s_waitcnt vmcnt(0)" ::: "memory");
            const unsigned og = xb_add(&bar[XB_TOP], 1u);
            const unsigned tg = og / nx;
            if (og + 1u == (tg + 1u) * nx) xb_add(&bar[XB_TOPGEN], 1u);
            else XB_SPIN(xb_ld(&bar[XB_TOPGEN]) == tg, bar);
            __builtin_amdgcn_fence(__ATOMIC_ACQUIRE, "agent");
            xb_add(&bar[XB_XGEN(b.x)], 1u);
            asm volatile("s_waitcnt vmcnt(0)" ::: "memory");
        } else {
            XB_SPIN(xb_ld(&bar[XB_XGEN(b.x)]) == gen, bar);
            __builtin_amdgcn_fence(__ATOMIC_ACQUIRE, "agent");
            asm volatile("s_waitcnt vmcnt(0)" ::: "memory");
        }
    }
    __syncthreads();
}

__device__ __forceinline__ int lane_now() { int l; asm volatile("v_mbcnt_lo_u32_b32 %0, -1, 0\n\tv_mbcnt_hi_u32_b32 %0, -1, %0" : "=v"(l)); return l; }

struct Params {
    const float* in[29];
    float* out;
    unsigned char* ws;
};

__device__ __forceinline__ float wave_sum(float v) {
    v += swz_xor<1>(v); v += swz_xor<2>(v); v += swz_xor<4>(v); v += swz_xor<8>(v); v += swz_xor<16>(v);
    return xhalf_sum(v);
}

template <class AT> __device__ void rms_rows(const AT* in, int ldi, const float* g, float* out, int ldo, int ncols, int nrows, int gw, int ngw, int lane) {
    for (int r = gw; r < nrows; r += ngw) {
        const AT* row = in + (size_t)r * ldi; float ss = 0.f;
        for (int c = lane; c < ncols; c += 64) { const float v = ldf(row, c); ss += v * v; }
        ss = wave_sum(ss);
        const float rs = rsqrtf(ss / (float)ncols + EPS);
        float* orow = out + (size_t)r * ldo;
        for (int c = lane; c < ncols; c += 64) orow[c] = ldf(row, c) * rs * g[c];
    }
}

template <class AT, bool DUAL, class RowFn, class Epi>
__device__ void gemm_tile(const AT* A, int lda, RowFn arow, const float* B, int ldb, int K, int m0, int n0, int n1, int Nmax, float* sm, Epi epi) {
    float* As = sm;
    float* Bs = sm + 16 * 132;
    float* Bs2 = Bs + 16 * 128;
    const int tid = threadIdx.x, ty = tid >> 4, tx = tid & 15;
    float acc[4][8], acc2[4][8];
#pragma unroll
    for (int i = 0; i < 4; ++i)
#pragma unroll
        for (int j = 0; j < 8; ++j) { acc[i][j] = 0.f; acc2[i][j] = 0.f; }
    const int ar = tid >> 2, ak = (tid & 3) * 4;
    const int srow = arow(m0 + ar);
    const int bk = tid >> 5, bn = (tid & 31) * 4;
    for (int k0 = 0; k0 < K; k0 += 16) {
        float a4[4];
#pragma unroll
        for (int j = 0; j < 4; ++j) a4[j] = (srow >= 0) ? ldf(A, (size_t)srow * lda + k0 + ak + j) : 0.f;
        float b4[4], c4[4];
#pragma unroll
        for (int j = 0; j < 4; ++j) { const int col = n0 + bn + j; b4[j] = (col < Nmax) ? B[(size_t)(k0 + bk) * ldb + col] : 0.f; }
        if (DUAL) {
#pragma unroll
            for (int j = 0; j < 4; ++j) c4[j] = B[(size_t)(k0 + bk) * ldb + n1 + bn + j];
        }
        __syncthreads();
#pragma unroll
        for (int j = 0; j < 4; ++j) As[(ak + j) * 132 + ar] = a4[j];
#pragma unroll
        for (int j = 0; j < 4; ++j) Bs[bk * 128 + bn + j] = b4[j];
        if (DUAL) {
#pragma unroll
            for (int j = 0; j < 4; ++j) Bs2[bk * 128 + bn + j] = c4[j];
        }
        __syncthreads();
#pragma unroll 2
        for (int kk = 0; kk < 16; ++kk) {
            float a[4], b[8];
#pragma unroll
            for (int i = 0; i < 4; ++i) a[i] = As[kk * 132 + ty * 4 + i];
#pragma unroll
            for (int j = 0; j < 8; ++j) b[j] = Bs[kk * 128 + tx * 8 + j];
#pragma unroll
            for (int i = 0; i < 4; ++i)
#pragma unroll
                for (int j = 0; j < 8; ++j) acc[i][j] += a[i] * b[j];
            if (DUAL) {
#pragma unroll
                for (int j = 0; j < 8; ++j) b[j] = Bs2[kk * 128 + tx * 8 + j];
#pragma unroll
                for (int i = 0; i < 4; ++i)
#pragma unroll
                    for (int j = 0; j < 8; ++j) acc2[i][j] += a[i] * b[j];
            }
        }
    }
    __syncthreads();
#pragma unroll
    for (int i = 0; i < 4; ++i)
#pragma unroll
        for (int j = 0; j < 8; ++j) epi(m0 + ty * 4 + i, tx * 8 + j, acc[i][j], acc2[i][j]);
}

struct RowId { __device__ int operator()(int r) const { return r; } };
struct RowTok { const int* rowtok; __device__ int operator()(int r) const { const int id = rowtok[r]; return id < 0 ? -1 : (id >> 2); } };
struct RowSlot { const int* rowtok; __device__ int operator()(int r) const { return rowtok[r] < 0 ? -1 : r; } };

__device__ __forceinline__ float sigmoidf_(float x) { return 1.f / (1.f + __expf(-x)); }

__global__ void __launch_bounds__(NTHR) fwd_naive(Params P) {
    cg::grid_group grid = cg::this_grid();
    extern __shared__ __attribute__((aligned(16))) unsigned char lds[];
    float* sm = (float*)lds;
    int* ism = (int*)(lds + 57600);
    PG8_LAS unsigned char* ldsl = (PG8_LAS unsigned char*)lds;
    const int wave_s = __builtin_amdgcn_readfirstlane((int)threadIdx.x >> 6);
#define TID_NOW() (wave_s * 64 + lane_now())
    int tid = TID_NOW(), lane = tid & 63, wave = tid >> 6;
    const int nblk = gridDim.x, blk = blockIdx.x;
    int gw = blk * NWAVE + wave; const int ngw = nblk * NWAVE;
#define REFRESH_IDS() do { tid = TID_NOW(); asm volatile("" : "+v"(tid)); lane = tid & 63; wave = tid >> 6; gw = blk * NWAVE + wave; } while (0)
    PG8_LAS unsigned long long* ptab = (PG8_LAS unsigned long long*)(ldsl + PTAB_OFF);
    if (tid == 0) {
#pragma unroll
        for (int k = 0; k < 29; ++k) ptab[k] = (unsigned long long)P.in[k];
        ptab[29] = (unsigned long long)P.out; ptab[30] = (unsigned long long)P.ws; }
    volatile __attribute__((address_space(3))) unsigned* MISC = (volatile __attribute__((address_space(3))) unsigned*)(ldsl + MISC_OFF);
    if (tid < 2) MISC[tid] = 0u;
    __syncthreads();
#define LPTRI(k) ((unsigned long long)(unsigned)__builtin_amdgcn_readfirstlane((int)(unsigned)ptab[k]) | ((unsigned long long)(unsigned)__builtin_amdgcn_readfirstlane((int)(unsigned)(ptab[k] >> 32)) << 32))
    const XcdBarrier xbar = xcd_barrier_post((unsigned*)((unsigned char*)(__attribute__((address_space(1))) unsigned char*)LPTRI(30) + WS_CTL) + CT_BAR, MISC, tid == 0);
#define GSYNC() do { xcd_barrier(xbar, TID_NOW() == 0, (unsigned)nblk); REFRESH_IDS(); } while (0)
#define ALLPTRS() \
    unsigned char* ws = (unsigned char*)(__attribute__((address_space(1))) unsigned char*)LPTRI(30); int* ctl = (int*)(ws + WS_CTL); float* outp = (float*)(__attribute__((address_space(1))) float*)LPTRI(29); \
    float* logf_ = (float*)(ws + WS_LOGF); float* x1 = (float*)(ws + WS_X1); \
    int* topi = (int*)(ws + WS_TOPI); float* topg = (float*)(ws + WS_TOPG); int* rowtok = (int*)(ws + WS_ROWTOK); float* rowgate = (float*)(ws + WS_ROWGATE); \
    bf16_t* act = (bf16_t*)(ws + WS_ACT); bf16_t* Y = (bf16_t*)(ws + WS_Y); \
    bf16_t* Win_t = (bf16_t*)(ws + WS_WIN); bf16_t* XN = (bf16_t*)(ws + WS_XN); bf16_t* QB = (bf16_t*)(ws + WS_Q); \
    bf16_t* KB = QB + (size_t)T * 512; bf16_t* VB = KB + (size_t)T * 512; bf16_t* UX = (bf16_t*)(ws + WS_UX); \
    bf16_t* S5H = (bf16_t*)(ws + WS_S5H); bf16_t* S5TG = (bf16_t*)(ws + WS_S5TG); float* A16 = (float*)(ws + WS_A16); \
    bf16_t* Wgu_t = (bf16_t*)(ws + WS_WGU); bf16_t* Wdn_t = (bf16_t*)(ws + WS_WDN); bf16_t* X1B = (bf16_t*)(ws + WS_X1B); \
    bf16_t* MIXB = (bf16_t*)(ws + WS_MIXB); float* psa = (float*)(ws + WS_PSA); float* pss = (float*)(ws + WS_PSS); \
    bf16_t* GB = (bf16_t*)(ws + WS_GB); bf16_t* Wglu_t = (bf16_t*)(ws + WS_WGLU); bf16_t* Wout_t = (bf16_t*)(ws + WS_WOUT); bf16_t* Wpg_t = (bf16_t*)(ws + WS_WPG); bf16_t* Wpp_t = (bf16_t*)(ws + WS_WPP); \
    bf16_t* PB = (bf16_t*)(ws + WS_PB); bf16_t* XN2 = (bf16_t*)(ws + WS_XN2); bf16_t* GSB = (bf16_t*)(ws + WS_GS); \
    int* rowsrc = (int*)(ws + WS_ROWSRC); float* rowscl = (float*)(ws + WS_ROWSCL); float* r1 = (float*)(ws + WS_R1); \
    const float* x = (const float*)(__attribute__((address_space(1))) const float*)LPTRI(0); const float* pin = (const float*)(__attribute__((address_space(1))) const float*)LPTRI(1); const float* norm_mix_g = (const float*)(__attribute__((address_space(1))) const float*)LPTRI(2); const float* w_in = (const float*)(__attribute__((address_space(1))) const float*)LPTRI(3); const float* b_f = (const float*)(__attribute__((address_space(1))) const float*)LPTRI(4); \
    const float* lam_re = (const float*)(__attribute__((address_space(1))) const float*)LPTRI(5); const float* lam_im = (const float*)(__attribute__((address_space(1))) const float*)LPTRI(6); const float* log_dt = (const float*)(__attribute__((address_space(1))) const float*)LPTRI(7); const float* b_re = (const float*)(__attribute__((address_space(1))) const float*)LPTRI(8); const float* b_im = (const float*)(__attribute__((address_space(1))) const float*)LPTRI(9); \
    const float* c_re = (const float*)(__attribute__((address_space(1))) const float*)LPTRI(10); const float* c_im = (const float*)(__attribute__((address_space(1))) const float*)LPTRI(11); const float* d_skip = (const float*)(__attribute__((address_space(1))) const float*)LPTRI(12); const float* w_glu = (const float*)(__attribute__((address_space(1))) const float*)LPTRI(13); const float* b_glu = (const float*)(__attribute__((address_space(1))) const float*)LPTRI(14); \
    const float* attn_out_g = (const float*)(__attribute__((address_space(1))) const float*)LPTRI(15); const float* ssm_out_g = (const float*)(__attribute__((address_space(1))) const float*)LPTRI(16); const float* w_out = (const float*)(__attribute__((address_space(1))) const float*)LPTRI(17); const float* norm_ffn_g = (const float*)(__attribute__((address_space(1))) const float*)LPTRI(18); \
    const float* w_router = (const float*)(__attribute__((address_space(1))) const float*)LPTRI(19); const float* b_router = (const float*)(__attribute__((address_space(1))) const float*)LPTRI(20); const float* w_gu = (const float*)(__attribute__((address_space(1))) const float*)LPTRI(21); const float* b_gu = (const float*)(__attribute__((address_space(1))) const float*)LPTRI(22); \
    const float* w_dn = (const float*)(__attribute__((address_space(1))) const float*)LPTRI(23); const float* b_dn = (const float*)(__attribute__((address_space(1))) const float*)LPTRI(24); const float* norm_ple_g = (const float*)(__attribute__((address_space(1))) const float*)LPTRI(25); const float* w_ple_gate = (const float*)(__attribute__((address_space(1))) const float*)LPTRI(26); \
    const float* w_ple_proj = (const float*)(__attribute__((address_space(1))) const float*)LPTRI(27); const float* norm_final_g = (const float*)(__attribute__((address_space(1))) const float*)LPTRI(28); \
    (void)ctl; (void)outp; (void)logf_; (void)x1; (void)topi; (void)topg; (void)rowtok; (void)rowgate; (void)act; (void)Y; (void)Win_t; (void)XN; (void)QB; (void)KB; (void)VB; (void)UX; (void)S5H; (void)S5TG; (void)A16; (void)Wgu_t; (void)Wdn_t; (void)X1B; \
    (void)MIXB; (void)psa; (void)pss; (void)GB; (void)Wglu_t; (void)Wout_t; (void)Wpg_t; (void)Wpp_t; (void)PB; (void)XN2; (void)GSB; (void)rowsrc; (void)rowscl; (void)r1; (void)x; (void)pin; (void)norm_mix_g; (void)w_in; (void)b_f; \
    (void)lam_re; (void)lam_im; (void)log_dt; (void)b_re; (void)b_im; (void)c_re; (void)c_im; (void)d_skip; (void)w_glu; (void)b_glu; (void)attn_out_g; (void)ssm_out_g; (void)w_out; (void)norm_ffn_g; (void)w_router; (void)b_router; (void)w_gu; (void)b_gu; \
    (void)w_dn; (void)b_dn; (void)norm_ple_g; (void)w_ple_gate; (void)w_ple_proj; (void)norm_final_g

    { ALLPTRS();
    if (blk == 0 && tid < 128) ctl[tid] = 0;
    if (blk < NG) s5_precompute(blk, lam_re, lam_im, log_dt, b_re, b_im, c_re, c_im, S5H, S5TG, A16, sm);
    REP(1) {
        PG8_LAS float* scr = (PG8_LAS float*)(ldsl + wave * 16384);
        constexpr int I_IN = 16 * 64, I_GU = NE * 16 * 64, I_DN = NE * 16 * 32, I_GLU = 8 * 16, I_OUT = 16 * 32, I_PG = 16 * 32, I_PP = 4 * 32;
        constexpr int NI = I_IN + I_GLU + I_OUT + I_PG + I_PP + I_GU + I_DN;
        auto decode = [&](int it, TrItem& d) {
            int r = it;
            if (r < I_GLU) { const int kb = r >> 4, nb = r & 15; d = TrItem{w_glu, nullptr, Wglu_t, SW, kb * 64, nb * 32, SW, nb * 32, false}; return; }
            r -= I_GLU;
            if (r < I_OUT) { const int kb = r >> 5, nb = r & 31; d = TrItem{w_out, kb < 8 ? attn_out_g : ssm_out_g - AW, Wout_t, D, kb * 64, nb * 32, D, nb * 32, false}; return; }
            r -= I_OUT;
            if (r < I_PG) { const int kb = r >> 5, nb = r & 31; d = TrItem{w_ple_gate, norm_ple_g, Wpg_t, D, kb * 64, nb * 32, D, nb * 32, false}; return; }
            r -= I_PG;
            if (r < I_PP) { const int kb = r >> 5, nb = r & 31; d = TrItem{w_ple_proj, nullptr, Wpp_t, D, kb * 64, nb * 32, PLE, nb * 32, false}; return; }
            r -= I_PP;
            if (r < I_IN) { const int kb = r >> 6, nb = r & 63, n0 = nb * 32; d = TrItem{w_in, norm_mix_g, Win_t, INW, kb * 64, (n0 < 1536) ? n0 : n0 + 8, D, n0, false}; return; }
            r -= I_IN;
            if (r < I_GU) {
                const int e = r >> 10, kb = (r >> 6) & 15, nb = r & 63; const int n0 = nb * 32, pn = n0 >> 8, j0 = n0 & 255;
                d = TrItem{w_gu + (size_t)e * D * 2 * DFF, norm_ffn_g, (bf16_t*)((unsigned char*)Wgu_t + (size_t)e * 2 * DFF * D), 2 * DFF, kb * 64, (j0 < 128) ? pn * 128 + j0 : DFF + pn * 128 + (j0 - 128), D, n0, true}; return; }
            r -= I_GU;
            { const int e = r >> 9, kb = (r >> 5) & 15, nb = r & 31; d = TrItem{w_dn + (size_t)e * DFF * D, nullptr, (bf16_t*)((unsigned char*)Wdn_t + (size_t)e * D * DFF), D, kb * 64, nb * 32, DFF, nb * 32, true}; }
        };
        TrItem dc, dn; float vc[32], vn[32];
        int it = gw;
        if (it < NI) { decode(it, dc); tr_load(dc, vc, lane); }
        while (it < NI) {
            const int itn = it + ngw; const bool more = itn < NI;
            if (more) { decode(itn, dn); tr_load(dn, vn, lane); }
            tr_store(dc, vc, scr, lane);
            if (more) { dc = dn;
#pragma unroll
                for (int i = 0; i < 32; ++i) vc[i] = vn[i]; }
            it = itn;
        }
    }
    for (size_t i = (size_t)(blk * NTHR + tid) * 8; i < (size_t)T * PLE; i += (size_t)nblk * NTHR * 8) {
        const float4 a = *(const float4*)(pin + i), b4 = *(const float4*)(pin + i + 4);
        *(uint4*)(PB + i) = make_uint4(pk2(a.x, a.y), pk2(a.z, a.w), pk2(b4.x, b4.y), pk2(b4.z, b4.w)); }
    REP(10) {
        float wf[4][4][8];
#pragma unroll
        for (int j = 0; j < 4; ++j)
#pragma unroll
            for (int i = 0; i < 4; ++i) { const int k = 256 * j + 4 * lane + i; const float gk = norm_mix_g[k]; const float4 a = *(const float4*)(w_in + (size_t)k * INW + COL_F), b4 = *(const float4*)(w_in + (size_t)k * INW + COL_F + 4);
                wf[j][i][0] = a.x * gk; wf[j][i][1] = a.y * gk; wf[j][i][2] = a.z * gk; wf[j][i][3] = a.w * gk; wf[j][i][4] = b4.x * gk; wf[j][i][5] = b4.y * gk; wf[j][i][6] = b4.z * gk; wf[j][i][7] = b4.w * gk; }
        float4 vnx[4];
        if (gw < T) {
#pragma unroll
            for (int j = 0; j < 4; ++j) vnx[j] = ((const float4*)(x + (size_t)gw * D) + lane)[64 * j]; }
        for (int r = gw; r < T; r += ngw) {
            float4 v[4]; float ss = 0.f;
#pragma unroll
            for (int j = 0; j < 4; ++j) v[j] = vnx[j];
            if (r + ngw < T) {
#pragma unroll
                for (int j = 0; j < 4; ++j) vnx[j] = ((const float4*)(x + (size_t)(r + ngw) * D) + lane)[64 * j]; }
#pragma unroll
            for (int j = 0; j < 4; ++j) ss += (v[j].x * v[j].x + v[j].y * v[j].y) + (v[j].z * v[j].z + v[j].w * v[j].w);
            ss = wave_sum(ss); const float rs = rsqrtf(ss * (1.f / D) + EPS);
            float fl[8];
#pragma unroll
            for (int h = 0; h < 8; ++h) fl[h] = 0.f;
            uint2* o8 = (uint2*)(XN + (size_t)r * D) + lane;
#pragma unroll
            for (int j = 0; j < 4; ++j) { const float a0 = v[j].x * rs, a1 = v[j].y * rs, a2 = v[j].z * rs, a3 = v[j].w * rs;
                o8[64 * j] = make_uint2(pk2(a0, a1), pk2(a2, a3));
#pragma unroll
                for (int h = 0; h < 8; ++h) fl[h] += a0 * wf[j][0][h] + a1 * wf[j][1][h] + a2 * wf[j][2][h] + a3 * wf[j][3][h]; }
            float mine = 0.f;
#pragma unroll
            for (int h = 0; h < 8; ++h) { const float sfl = wave_sum(fl[h]); if (lane == h) mine = sfl; }
            if (lane < 8) { const float z = mine + b_f[lane]; logf_[(size_t)r * 8 + lane] = fminf(z, 0.f) - log1pf(__expf(-fabsf(z))); }
        }
    }
    __syncthreads();
    }
    grid.sync(); REFRESH_IDS();
    { ALLPTRS();

    REP(2) {
        pg8::Order So; So.init(T / 256, 2048 / 256, nblk, blk, nullptr);
        pg8::EpiQKVU E{QB, (size_t)T * 512, UX};
        pg8::gemm_phase(TID_NOW(), ldsl, (const char*)XN, (const char*)Win_t, 0, D, So, pg8::DenseRows{D}, E);
    }
    }
    GSYNC();
    { ALLPTRS();

    REP(3) {
        const int pm = (blk % 8) * (nblk / 8) + blk / 8, g = pm >> 3;
        pg8::OneUnit So{pm, g};
        pg8::EpiS5H E1{UX, A16 + g * 128};
        pg8::gemm_phase(TID_NOW(), ldsl, (const char*)UX, (const char*)S5H, (size_t)256 * 256 * 2, 256, So, pg8::DenseRows{UXP}, E1);
        pg8::EpiS5Y E2{UX, d_skip, GB};
        pg8::gemm_phase(TID_NOW(), ldsl, (const char*)UX, (const char*)S5TG, (size_t)256 * UXP * 2, UXP, So, pg8::DenseRows{UXP}, E2);
    }
    REP(4) {
        const int vcu = (blk % 8) * (nblk / 8) + blk / 8, bh = vcu >> 2, sg = vcu & 3, b = bh >> 3, h = bh & 7;
        attn_body::prep_c(TID_NOW(), b, h, logf_, (char*)lds);
        for (int i = 0; i < 4; ++i) { const int qb = (i == 0) ? sg : (i == 1) ? 7 - sg : (i == 2) ? 8 + sg : 15 - sg;
            attn_body::attn_unit<8>(TID_NOW(), b, h, qb, QB, KB, VB, MIXB, psa, (char*)lds); }
    }
    }
    GSYNC();
    { ALLPTRS();

    REP(9) {
        pg8::Order So; So.init(T / 256, SW / 256, nblk, blk, nullptr);
        pg8::EpiGlu E{GB, MIXB, b_glu, pss};
        pg8::gemm_phase(TID_NOW(), ldsl, (const char*)GB, (const char*)Wglu_t, 0, SW, So, pg8::DenseRows{SW}, E);
    }
    }
    GSYNC();
    { ALLPTRS();

    REP(5) {
        pg8::Order So; So.init(T / 256, D / 256, nblk, blk, nullptr);
        PG8_LAS float* stat = (PG8_LAS float*)(ldsl + 131072);
        {   pg8::Unit uu; if (So.next(tid >> 8, uu)) { const int row = uu.pm * 256 + (tid & 255); const float4* pa = (const float4*)(psa + (size_t)row * 8); const float4* ps = (const float4*)(pss + (size_t)row * 8);
                const float4 a0 = pa[0], a1 = pa[1], s0 = ps[0], s1 = ps[1];
                const float ra = rsqrtf((((a0.x + a0.y) + (a0.z + a0.w)) + ((a1.x + a1.y) + (a1.z + a1.w))) * (1.f / AW) + EPS), rs = rsqrtf((((s0.x + s0.y) + (s0.z + s0.w)) + ((s1.x + s1.y) + (s1.z + s1.w))) * (1.f / SW) + EPS);
                PG8_LAS float* d2 = stat + (((uu.pm >> 3) & 1) * 256 + (tid & 255)) * 2; d2[0] = ra / rs; d2[1] = rs; } }
        __syncthreads();
        pg8::EpiOut E{x, x1, (unsigned char*)X1B, stat};
        pg8::gemm_phase(TID_NOW(), ldsl, (const char*)MIXB, (const char*)Wout_t, 0, D, So, pg8::DenseRows{D}, E);
    }
    }
    GSYNC();
    { ALLPTRS();

    {
        typedef float f32x16 __attribute__((ext_vector_type(16)));
        float* Wr = sm;
        int* hist = (int*)(lds + 131072);
        for (int i = tid; i < D * NE; i += NTHR) Wr[i] = w_router[i] * norm_ffn_g[i >> 5];
        if (tid < NE) hist[tid] = 0;
        __syncthreads();
        if (wave >= 4) { for (int i = blk * 256 + (tid - 256); i < CAP; i += nblk * 256) { rowtok[i] = -1; rowgate[i] = 0.f; rowsrc[i] = 0; rowscl[i] = 0.f; } }
        else {
            const int r0 = (blk * 4 + wave) * 32, e = lane & 31, h = lane >> 5; const float* xp = x1 + (size_t)(r0 + e) * D + 4 * h;
            f32x16 acc;
#pragma unroll
            for (int r = 0; r < 16; ++r) acc[r] = 0.f;
            float ss = 0.f;
#pragma unroll 4
            for (int j = 0; j < 128; ++j) { const float4 xv = *(const float4*)(xp + 8 * j); const float* wp = Wr + (8 * j + 4 * h) * 32 + e;
                ss += (xv.x * xv.x + xv.y * xv.y) + (xv.z * xv.z + xv.w * xv.w);
                acc = __builtin_amdgcn_mfma_f32_32x32x2f32(xv.x, wp[0], acc, 0, 0, 0); acc = __builtin_amdgcn_mfma_f32_32x32x2f32(xv.y, wp[32], acc, 0, 0, 0);
                acc = __builtin_amdgcn_mfma_f32_32x32x2f32(xv.z, wp[64], acc, 0, 0, 0); acc = __builtin_amdgcn_mfma_f32_32x32x2f32(xv.w, wp[96], acc, 0, 0, 0); }
            ss = xhalf_sum(ss); const float rs = rsqrtf(ss * (1.f / D) + EPS);
            if (h == 0) r1[r0 + e] = rs;
            const float bias = b_router[e];
#pragma unroll
            for (int r = 0; r < 16; ++r) { const int ri = (r & 3) + 8 * (r >> 2) + 4 * h;
                float v = acc[r] * bperm(rs, ri) + bias; float tv[TOPK]; int ti[TOPK];
#pragma unroll
                for (int k = 0; k < TOPK; ++k) { float m = v;
                    m = fmaxf(m, swz_xor<1>(m)); m = fmaxf(m, swz_xor<2>(m)); m = fmaxf(m, swz_xor<4>(m)); m = fmaxf(m, swz_xor<8>(m)); m = fmaxf(m, swz_xor<16>(m));
                    const unsigned long long bm = __ballot(v == m); const unsigned half = h ? (unsigned)(bm >> 32) : (unsigned)bm; const int idx = __ffs((int)half) - 1;
                    tv[k] = m; ti[k] = idx; if (e == idx) v = -INFINITY; }
                float es[TOPK], den = 0.f;
#pragma unroll
                for (int k = 0; k < TOPK; ++k) { es[k] = __expf(tv[k] - tv[0]); den += es[k]; }
                if (e < TOPK) { float gsel = es[0]; int isel = ti[0];
#pragma unroll
                    for (int k = 1; k < TOPK; ++k) if (e == k) { gsel = es[k]; isel = ti[k]; }
                    topi[(size_t)(r0 + ri) * TOPK + e] = isel; topg[(size_t)(r0 + ri) * TOPK + e] = gsel / den; atomicAdd(&hist[isel], 1); } }
        }
        __syncthreads();
        if (tid < NE) atomicAdd(&ctl[CT_COUNT + tid], hist[tid]);
    }
    }
    GSYNC();
    { ALLPTRS();

    {
        int* lcnt = ism + 64; int* lbase = ism + 128;
        if (tid < NE) lcnt[tid] = 0;
        if (tid == 0) {
            int run = 0;
            for (int e = 0; e < NE; ++e) { ism[e] = run; const int cnt = ctl[CT_COUNT + e]; run += (cnt + MB - 1) / MB * MB; }
            ism[NE] = run;
            if (blk == 0) {
                for (int e = 0; e <= NE; ++e) ctl[CT_PADSTART + e] = ism[e];
                ctl[CT_NTILES] = run / MB;
                for (int e = 0; e < NE; ++e) for (int tt = ism[e] / MB; tt < ism[e + 1] / MB; ++tt) ctl[CT_TILEEXP + tt] = e;
            }
        }
        __syncthreads();
        const int i = blk * NTHR + tid; const int e = topi[i]; const int rank = atomicAdd(&lcnt[e], 1);
        __syncthreads();
        if (tid < NE) lbase[tid] = atomicAdd(&ctl[CT_CURSOR + tid], lcnt[tid]);
        __syncthreads();
        const int slot = ism[e] + lbase[e] + rank;
        rowtok[slot] = i; rowgate[slot] = topg[i]; rowsrc[slot] = i >> 2; rowscl[slot] = r1[i >> 2];
    }
    }
    GSYNC();
    { ALLPTRS();

    REP(6) {
        pg8::Order So; So.init(__builtin_amdgcn_readfirstlane(ctl[CT_NTILES]), 2 * DFF / 256, nblk, blk, ctl + CT_TILEEXP);
        pg8::EpiSwiglu E{(unsigned char*)act, b_gu, rowscl};
        pg8::gemm_phase<1>(TID_NOW(), ldsl, (const char*)X1B, (const char*)Wgu_t, (size_t)2 * DFF * D, D, So, pg8::GatherRows{rowsrc, D}, E);
    }
    }
    GSYNC();
    { ALLPTRS();

    REP(7) {
        pg8::Order So; So.init(__builtin_amdgcn_readfirstlane(ctl[CT_NTILES]), D / 256, nblk, blk, ctl + CT_TILEEXP);
        pg8::EpiScatter E{Y, b_dn, rowtok, rowgate};
        pg8::gemm_phase<1>(TID_NOW(), ldsl, (const char*)act, (const char*)Wdn_t, (size_t)D * DFF, DFF, So, pg8::DenseRows{DFF}, E);
    }
    }
    GSYNC();
    { ALLPTRS();

    for (int r = gw; r < T; r += ngw) {
        float4* xr = (float4*)(x1 + (size_t)r * D) + lane; float4 v[4]; float ss = 0.f;
#pragma unroll
        for (int j = 0; j < 4; ++j) { v[j] = xr[64 * j];
#pragma unroll
            for (int k = 0; k < TOPK; ++k) { const uint2 y = *((const uint2*)(Y + ((size_t)r * TOPK + k) * D) + lane + 64 * j);
                v[j].x += __builtin_bit_cast(float, y.x << 16); v[j].y += __builtin_bit_cast(float, y.x & 0xffff0000u); v[j].z += __builtin_bit_cast(float, y.y << 16); v[j].w += __builtin_bit_cast(float, y.y & 0xffff0000u); }
            xr[64 * j] = v[j]; ss += (v[j].x * v[j].x + v[j].y * v[j].y) + (v[j].z * v[j].z + v[j].w * v[j].w); }
        ss = wave_sum(ss); const float rs = rsqrtf(ss * (1.f / D) + EPS);
        uint2* o8 = (uint2*)(XN2 + (size_t)r * D) + lane;
#pragma unroll
        for (int j = 0; j < 4; ++j) o8[64 * j] = make_uint2(pk2(v[j].x * rs, v[j].y * rs), pk2(v[j].z * rs, v[j].w * rs));
    }
    }
    GSYNC();
    { ALLPTRS();

    {
        pg8::Order So; So.init(T / 256, D / 256, nblk, blk, nullptr);
        pg8::EpiGate E1{GSB};
        pg8::gemm_phase(TID_NOW(), ldsl, (const char*)XN2, (const char*)Wpg_t, 0, D, So, pg8::DenseRows{D}, E1);
        pg8::EpiPle E2{GSB, x1};
        pg8::gemm_phase(TID_NOW(), ldsl, (const char*)PB, (const char*)Wpp_t, 0, PLE, So, pg8::DenseRows{PLE}, E2);
    }
    }
    GSYNC();
    { ALLPTRS();

    REP(8)
    for (int r = gw; r < T; r += 2 * ngw) {
        const int r2 = r + ngw; const bool has2 = r2 < T;
        const float4* xr = (const float4*)(x1 + (size_t)r * D) + lane; const float4* xr2 = (const float4*)(x1 + (size_t)(has2 ? r2 : r) * D) + lane; float4 v[4], w[4]; float ss = 0.f, ss2 = 0.f;
#pragma unroll
        for (int j = 0; j < 4; ++j) { v[j] = xr[64 * j]; w[j] = xr2[64 * j]; }
#pragma unroll
        for (int j = 0; j < 4; ++j) { ss += (v[j].x * v[j].x + v[j].y * v[j].y) + (v[j].z * v[j].z + v[j].w * v[j].w); ss2 += (w[j].x * w[j].x + w[j].y * w[j].y) + (w[j].z * w[j].z + w[j].w * w[j].w); }
        ss = wave_sum(ss); ss2 = wave_sum(ss2); const float rs = rsqrtf(ss * (1.f / D) + EPS), rs2 = rsqrtf(ss2 * (1.f / D) + EPS);
        if (has2) { float4* orow2 = (float4*)(outp + (size_t)r2 * D) + lane;
#pragma unroll
            for (int j = 0; j < 4; ++j) { const float4 g4 = ((const float4*)norm_final_g)[lane + 64 * j]; orow2[64 * j] = make_float4(w[j].x * rs2 * g4.x, w[j].y * rs2 * g4.y, w[j].z * rs2 * g4.z, w[j].w * rs2 * g4.w); } }
        float4* orow = (float4*)(outp + (size_t)r * D) + lane;
#pragma unroll
        for (int j = 0; j < 4; ++j) { const float4 g4 = ((const float4*)norm_final_g)[lane + 64 * j]; orow[64 * j] = make_float4(v[j].x * rs * g4.x, v[j].y * rs * g4.y, v[j].z * rs * g4.z, v[j].w * rs * g4.w); }
    }
    }
}

extern "C" void kernel_launch(void* const* d_in, const int* in_sizes, int n_in, void* d_out, int out_size, void* d_ws, size_t ws_size, hipStream_t stream) {
    static int grid = 0;
    if (grid == 0) {
        int dev = 0, cus = 0, per_cu = 0;
        (void)hipGetDevice(&dev);
        (void)hipDeviceGetAttribute(&cus, hipDeviceAttributeMultiprocessorCount, dev);
        if (hipFuncSetAttribute((const void*)fwd_naive, hipFuncAttributeMaxDynamicSharedMemorySize, LDS_BYTES) != hipSuccess) fprintf(stderr, "kernel_launch: hipFuncSetAttribute failed\n");
        (void)hipOccupancyMaxActiveBlocksPerMultiprocessor(&per_cu, (const void*)fwd_naive, NTHR, LDS_BYTES);
        if (per_cu < 1) { fprintf(stderr, "kernel_launch: occupancy query says %d blocks per CU\n", per_cu); per_cu = 1; }
        grid = cus;
        if (n_in != 29 || ws_size < WS_END) { fprintf(stderr, "kernel_launch: unexpected n_in %d or ws_size %zu\n", n_in, ws_size); }
    }
    (void)hipMemsetAsync((char*)d_ws + WS_CTL, 0, CTL_ZERO_BYTES, stream);
    Params p{};
    for (int i = 0; i < 29; ++i) p.in[i] = (const float*)d_in[i];
    p.out = (float*)d_out; p.ws = (unsigned char*)d_ws;
    void* args[] = {&p};
    hipError_t e = hipLaunchCooperativeKernel((const void*)fwd_naive, dim3(grid), dim3(NTHR), args, LDS_BYTES, stream);
    if (e != hipSuccess) fprintf(stderr, "cooperative launch failed: %s (grid %d)\n", hipGetErrorString(e), grid);
}
```

```cpp
#include <hip/hip_runtime.h>
#include <hip/hip_cooperative_groups.h>
#include <cstdio>
#include <cstdint>
namespace cg = cooperative_groups;

constexpr int NB = 8, S = 4096, T = NB * S, D = 1024, NH = 8, HD = 64, AW = 512, SW = 512, INW = 2056;
constexpr int NG = 32, NP = 64, NC = 16, NE = 32, TOPK = 4, DFF = 1024, PLE = 256;
constexpr int COL_K = 512, COL_V = 1024, COL_F = 1536, COL_U = 1544;
constexpr float EPS = 1e-5f;
constexpr int NTHR = 512, NWAVE = 8;
#ifndef PROBE_DUP
#define PROBE_DUP 0
#endif
#define REP(k) for (int rep_ = 0; rep_ < ((PROBE_DUP == (k)) ? 2 : 1); ++rep_)
constexpr int MB = 256;
constexpr int CAP = T * TOPK + NE * MB;
constexpr int MAXTILES = CAP / MB;
constexpr int LDS_BYTES = 147456;

typedef unsigned short bf16_t;
__device__ __forceinline__ unsigned pk4_fp8(float a, float b, float c, float d) { int w = 0; w = __builtin_amdgcn_cvt_pk_fp8_f32(a, b, w, false); w = __builtin_amdgcn_cvt_pk_fp8_f32(c, d, w, true); return (unsigned)w; }
template <int M> __device__ __forceinline__ float swz_xor(float v) { return __builtin_bit_cast(float, __builtin_amdgcn_ds_swizzle(__builtin_bit_cast(int, v), (M << 10) | 0x1f)); }
__device__ __forceinline__ float xhalf_sum(float v) { unsigned a = __builtin_bit_cast(unsigned, v), b = a; asm volatile("" : "+v"(b));
    auto rr = __builtin_amdgcn_permlane32_swap(a, b, false, false); unsigned r0 = rr[0], r1 = rr[1]; asm volatile("" : "+v"(r0), "+v"(r1));
    return __builtin_bit_cast(float, r0) + __builtin_bit_cast(float, r1); }
__device__ __forceinline__ float bperm(float v, int srclane) { return __builtin_bit_cast(float, __builtin_amdgcn_ds_bpermute(srclane << 2, __builtin_bit_cast(int, v))); }
__device__ __forceinline__ bf16_t f2bf(float f) { unsigned u = __builtin_bit_cast(unsigned, f); return (bf16_t)((u + 0x7fffu + ((u >> 16) & 1u)) >> 16); }
__device__ __forceinline__ float bf2f(bf16_t b) { return __builtin_bit_cast(float, (unsigned)b << 16); }
__device__ __forceinline__ unsigned pk2(float lo, float hi) { return (unsigned)f2bf(lo) | ((unsigned)f2bf(hi) << 16); }
__device__ __forceinline__ float ldf(const float* p, size_t i) { return p[i]; }
__device__ __forceinline__ float ldf(const bf16_t* p, size_t i) { return bf2f(p[i]); }

constexpr size_t MiB = 1u << 20;
constexpr size_t WS_CTL = 0;
constexpr size_t WS_WIN = 1 * MiB;
constexpr size_t WS_WGLU = 5 * MiB;
constexpr size_t WS_WOUT = 6 * MiB;
constexpr size_t WS_WPG = 8 * MiB;
constexpr size_t WS_WPP = 10 * MiB;
constexpr size_t WS_A16 = 11 * MiB;
constexpr size_t WS_S5H = 12 * MiB;
constexpr size_t WS_S5TG = 16 * MiB;
constexpr size_t WS_WDN = 22 * MiB;
constexpr size_t WS_X1 = 86 * MiB;
constexpr size_t WS_TOPI = 214 * MiB;
constexpr size_t WS_TOPG = 214 * MiB + 512 * 1024;
constexpr size_t WS_ROWTOK = 215 * MiB;
constexpr size_t WS_ROWGATE = 216 * MiB;
constexpr size_t WS_ROWSRC = 217 * MiB;
constexpr size_t WS_ROWSCL = 218 * MiB;
constexpr size_t WS_R1 = 219 * MiB;
constexpr size_t WS_PSA = 220 * MiB;
constexpr size_t WS_PSS = 221 * MiB;
constexpr size_t WS_LOGF = 222 * MiB;
constexpr size_t WS_PB = 223 * MiB;
constexpr size_t WS_A = 239 * MiB;
constexpr size_t WS_XN = WS_A;
constexpr size_t WS_Q = WS_A + 64 * MiB;
constexpr size_t WS_UX = WS_A + 160 * MiB;
constexpr size_t WS_MIXB = WS_A + 212 * MiB;
constexpr size_t WS_GB = WS_A + 276 * MiB;
constexpr size_t WS_ACT = WS_A;
constexpr size_t WS_XN2 = WS_A;
constexpr size_t WS_X1H = WS_A + 144 * MiB;
constexpr size_t WS_R2 = WS_R1 + 256 * 1024;
constexpr size_t WS_SLOTOF = WS_R1 + 512 * 1024;
constexpr size_t WS_GS = WS_A + 64 * MiB;
constexpr size_t WS_B = WS_A + 308 * MiB;
constexpr size_t WS_WGU = WS_B;
constexpr size_t WS_X1B = WS_B + 128 * MiB;
constexpr size_t WS_Y = WS_B;
constexpr size_t WS_END = WS_B + 272 * MiB;
static_assert((size_t)CAP * 4 <= MiB && (size_t)CAP * DFF * 2 <= 272 * MiB, "list arrays fit 1 MiB each; ACT fits");
constexpr int UXP = 384;
constexpr int CT_COUNT = 0, CT_CURSOR = 64, CT_PADSTART = 128, CT_NTILES = 192, CT_TILEEXP = 256, CT_BAR = 4096;
constexpr size_t CTL_ZERO_BYTES = 65536;
constexpr int MISC_OFF = 147200, PTAB_OFF = 146944;
constexpr float LOG2E = 1.4426950408889634f, C2 = 0.125f * LOG2E;

namespace pg8 {
#define PG8_LAS __attribute__((address_space(3)))
typedef short bf16x8 __attribute__((ext_vector_type(8)));
typedef float f32x4 __attribute__((ext_vector_type(4)));
typedef unsigned u32x4 __attribute__((ext_vector_type(4)));
typedef int i32x4 __attribute__((ext_vector_type(4)));
typedef int i32x8 __attribute__((ext_vector_type(8)));
constexpr float W8_MUL = 64.f, W8_INV = 1.f / 64.f;
constexpr int BM = 256, BK = 64, HALF = 128, HTB = HALF * BK * 2, STAGE_BYTES = 8 * HTB, NXCD = 8, WGM = 8;
__device__ __forceinline__ int lds_byte(int r, int c) { const int st = (r >> 4) * 2 + (c >> 5), rr = r & 15, cc = c & 31, ob = rr * 64 + cc * 2; return st * 1024 + (ob ^ (((ob >> 9) & 1) << 5)); }
__device__ __forceinline__ void stage_rc(int b, int& R, int& C) { const int st = b / 1024, sb = b % 1024, swz = sb ^ (((sb >> 9) & 1) << 5); R = (st >> 1) * 16 + swz / 64; C = (st & 1) * 32 + (swz % 64) / 2; }
__device__ __forceinline__ int perm32(int rho) { const int n = rho >> 4, i = rho & 15; return 8 * (i >> 2) + 4 * n + (i & 3); }
struct Unit { int pm, pn, e; };
__device__ __forceinline__ unsigned long long uni64(const void* p) { const unsigned long long v = (unsigned long long)p; return (unsigned long long)(unsigned)__builtin_amdgcn_readfirstlane((int)(unsigned)v) | ((unsigned long long)(unsigned)__builtin_amdgcn_readfirstlane((int)(unsigned)(v >> 32)) << 32); }
struct Order {
    int nM, nN, nwg, G, c; const int* texp;
    __device__ void init(int nM_, int nN_, int G_, int c_, const int* texp_) { nM = nM_; nN = nN_; nwg = nM * nN; G = G_; c = c_; texp = texp_; }
    __device__ bool next(int i, Unit& u) const {
        const long L = (long)i * G + c; if (L >= nwg) return false;
        int wgid = (int)L; { const int q = nwg / NXCD, r = nwg % NXCD, xcd = wgid % NXCD, off = wgid / NXCD; wgid = (xcd < r ? xcd * (q + 1) : r * (q + 1) + (xcd - r) * q) + off; }
        const int nig = WGM * nN, gid = wgid / nig, fm = gid * WGM, gsz = (nM - fm) < WGM ? (nM - fm) : WGM;
        u.pm = __builtin_amdgcn_readfirstlane(fm + ((wgid % nig) % gsz)); u.pn = __builtin_amdgcn_readfirstlane((wgid % nig) / gsz);
        u.e = texp ? __builtin_amdgcn_readfirstlane(texp[u.pm]) : 0; return true;
    }
};
struct DenseRows { static constexpr bool UNIFORM = true; int lda; __device__ __forceinline__ unsigned rowoff(const Unit&, int r) const { return (unsigned)r * (unsigned)lda; }
    __device__ __forceinline__ size_t tilebase(const Unit& u) const { return (size_t)u.pm * BM * (size_t)lda; } };
struct GatherRows { static constexpr bool UNIFORM = false; const int* src; int lda; __device__ __forceinline__ unsigned rowoff(const Unit& u, int r) const { return (unsigned)src[u.pm * BM + r] * (unsigned)lda; }
    __device__ __forceinline__ size_t tilebase(const Unit&) const { return 0; } };
struct OneUnit { int pm, e; __device__ bool next(int i, Unit& u) const { if (i) return false; u.pm = pm; u.pn = 0; u.e = e; return true; } };
typedef float f32x2_t __attribute__((ext_vector_type(2))); typedef __bf16 bf16x2_t __attribute__((ext_vector_type(2)));
__device__ __forceinline__ unsigned cvt_pk_bf16(float lo, float hi) { f32x2_t v = {lo, hi}; bf16x2_t b = __builtin_convertvector(v, bf16x2_t); return __builtin_bit_cast(unsigned, b); }

template <int ELT = 2, class Epi, class ARow, class Sched>
__device__ __forceinline__ void gemm_phase(int tid0, PG8_LAS unsigned char* lds, const char* Abase, const char* Bbase, size_t b_estride, int K, const Sched& S, const ARow& AR, const Epi& E) {
    int tid = tid0; asm volatile("" : "+v"(tid));
    const int wid = __builtin_amdgcn_readfirstlane(tid >> 6), lane = tid & 63, wr = wid >> 2, wc = wid & 3, fr = lane & 15, fq = lane >> 4;
    const int nt = K * ELT / 128;
    unsigned voffB[2];
#pragma unroll
    for (int i = 0; i < 2; ++i) { int R, C; stage_rc(tid * 16 + i * 8192, R, C); const int Rb = Epi::PERM ? ((R & ~31) + perm32(R & 31)) : R; voffB[i] = (unsigned)Rb * (unsigned)(K * ELT) + (unsigned)C * 2u; }
    const size_t kstep = (size_t)(BK * 2), hstep = (size_t)HALF * K * ELT, tstep = 2 * hstep;
    const unsigned ldsw = (unsigned)wid * 1024u;
    const int aoff = lds_byte(wr * 64 + fr, fq * 8), boff = lds_byte(wc * 32 + fr, fq * 8);
#define PG8_SA(b, h) (((b) * 2 + (h)) * HTB)
#define PG8_SB(b, h) ((4 + (b) * 2 + (h)) * HTB)
#define PG8_STAGE(bufoff, gbase, voff) do { _Pragma("unroll") for (int _i = 0; _i < 2; ++_i) \
        __builtin_amdgcn_global_load_lds((const unsigned*)((const char*)(gbase) + (voff)[_i]), (PG8_LAS unsigned*)(lds + (bufoff) + ldsw + _i * 8192), 16, 0, 0); } while (0)
#define PG8_LD16(off) (*(const PG8_LAS bf16x8*)(lds + (off)))
#define PG8_CAT(x, y) __builtin_shufflevector(__builtin_bit_cast(i32x4, x), __builtin_bit_cast(i32x4, y), 0, 1, 2, 3, 4, 5, 6, 7)
#define PG8_LDA(dst, b, h) do { _Pragma("unroll") for (int m = 0; m < 4; ++m) { \
        if constexpr (ELT == 2) { dst##2[m][0] = PG8_LD16(PG8_SA(b, h) + aoff + m * 2048); dst##2[m][1] = PG8_LD16(PG8_SA(b, h) + aoff + m * 2048 + 1024); } \
        else dst##1[m] = PG8_CAT(PG8_LD16(PG8_SA(b, h) + aoff + m * 2048), PG8_LD16(PG8_SA(b, h) + aoff + m * 2048 + 1024)); } } while (0)
#define PG8_LDB(dst, b, h) do { _Pragma("unroll") for (int n = 0; n < 2; ++n) { \
        if constexpr (ELT == 2) { dst##2[n][0] = PG8_LD16(PG8_SB(b, h) + boff + n * 2048); dst##2[n][1] = PG8_LD16(PG8_SB(b, h) + boff + n * 2048 + 1024); } \
        else dst##1[n] = PG8_CAT(PG8_LD16(PG8_SB(b, h) + boff + n * 2048), PG8_LD16(PG8_SB(b, h) + boff + n * 2048 + 1024)); } } while (0)
#define PG8_MMA(ai, bj, At, Bt) do { __builtin_amdgcn_s_setprio(1); _Pragma("unroll") for (int m = 0; m < 4; ++m) _Pragma("unroll") for (int n = 0; n < 2; ++n) { \
        if constexpr (ELT == 2) { _Pragma("unroll") for (int k = 0; k < 2; ++k) acc[ai][bj][m][n] = __builtin_amdgcn_mfma_f32_16x16x32_bf16(Bt##2[n][k], At##2[m][k], acc[ai][bj][m][n], 0, 0, 0); } \
        else asm volatile("v_mfma_scale_f32_16x16x128_f8f6f4 %0, %1, %2, %0, %3, %3 op_sel_hi:[0,0,0]" : "+v"(acc[ai][bj][m][n]) : "v"(Bt##1[n]), "v"(At##1[m]), "v"(one8)); } \
        __builtin_amdgcn_s_setprio(0); } while (0)
#define PG8_WAIT_V(n) asm volatile("s_waitcnt vmcnt(" #n ")" ::: "memory")
#define PG8_WAIT_L(n) asm volatile("s_waitcnt lgkmcnt(" #n ")" ::: "memory")
#define PG8_BAR __builtin_amdgcn_s_barrier()
#define PG8_SCHED __builtin_amdgcn_sched_barrier(0)
#define PG8_VOFF(dst, u) do { _Pragma("unroll") for (int _i = 0; _i < 2; ++_i) { int _R, _C; stage_rc(tid * 16 + _i * 8192, _R, _C); _Pragma("unroll") for (int _h = 0; _h < 2; ++_h) dst[_h][_i] = AR.rowoff(u, _h * HALF + _R) * (unsigned)ELT + (unsigned)_C * 2u; } } while (0)
    Unit cur, nxt; int ui = 0;
    if (!S.next(0, cur)) return;
    f32x4 acc[2][2][4][2];
#pragma unroll
    for (int a = 0; a < 2; ++a)
#pragma unroll
        for (int b = 0; b < 2; ++b)
#pragma unroll
            for (int m = 0; m < 4; ++m)
#pragma unroll
                for (int n = 0; n < 2; ++n) acc[a][b][m][n] = (f32x4){0.f, 0.f, 0.f, 0.f};
    bf16x8 At2[4][2], B02[2][2], B12[2][2]; i32x8 At1[4], B01[2], B11[2];
    int one8 = 0x7F7F7F7F; asm volatile("" : "+v"(one8));
    unsigned cvA[2][2], nvA[2][2];
    PG8_VOFF(cvA, cur);
    const char* cA = Abase + AR.tilebase(cur) * ELT;
    const char* cB = Bbase + (size_t)cur.e * b_estride + (size_t)cur.pn * tstep;
    PG8_STAGE(PG8_SB(0, 0), cB, voffB); PG8_STAGE(PG8_SB(0, 1), cB + hstep, voffB); PG8_STAGE(PG8_SA(0, 0), cA, cvA[0]); PG8_STAGE(PG8_SA(0, 1), cA, cvA[1]);
    if (wr == 1) PG8_BAR;
    PG8_WAIT_V(2); PG8_BAR;
    PG8_STAGE(PG8_SB(1, 0), cB + kstep, voffB); PG8_STAGE(PG8_SA(1, 0), cA + kstep, cvA[0]); PG8_STAGE(PG8_SB(1, 1), cB + hstep + kstep, voffB);
    PG8_WAIT_V(6); PG8_BAR;
    for (;;) {
        const bool has_next = S.next(ui + 1, nxt);
        if constexpr (!ARow::UNIFORM) { if (has_next) { PG8_VOFF(nvA, nxt); } else {
#pragma unroll
            for (int h = 0; h < 2; ++h)
#pragma unroll
                for (int i = 0; i < 2; ++i) nvA[h][i] = cvA[h][i]; } }
        const char* nA = has_next ? Abase + AR.tilebase(nxt) * ELT : cA;
        const char* nB = has_next ? Bbase + (size_t)nxt.e * b_estride + (size_t)nxt.pn * tstep : cB;
#pragma nounroll
        for (int t = 0; t < nt; t += 2) {
            const bool last = (t == nt - 2);
            if constexpr (Epi::MID) { if (t == nt / 2) { int fr2 = fr, fq2 = fq; asm volatile("" : "+v"(fr2), "+v"(fq2)); E.mid(acc, cur, wr, wc, fr2, fq2); } }
            const char* a1 = cA + (size_t)(t + 1) * kstep;
            const char* a2 = last ? nA : cA + (size_t)(t + 2) * kstep; const char* b2 = last ? nB : cB + (size_t)(t + 2) * kstep;
            const char* a3 = a2 + kstep; const char* b3 = b2 + kstep;
            unsigned v2[2][2];
#pragma unroll
            for (int h = 0; h < 2; ++h)
#pragma unroll
                for (int i = 0; i < 2; ++i) v2[h][i] = (!ARow::UNIFORM && last) ? nvA[h][i] : cvA[h][i];
            PG8_LDB(B0, 0, 0); PG8_LDB(B1, 0, 1); PG8_SCHED; PG8_LDA(At, 0, 0); PG8_STAGE(PG8_SA(1, 1), a1, cvA[1]);
            PG8_WAIT_V(8); PG8_WAIT_L(0); PG8_BAR; PG8_MMA(0, 0, At, B0); PG8_MMA(0, 1, At, B1); PG8_BAR; PG8_SCHED;
            PG8_LDA(At, 0, 1); PG8_STAGE(PG8_SB(0, 0), b2, voffB); PG8_STAGE(PG8_SB(0, 1), b2 + hstep, voffB); PG8_STAGE(PG8_SA(0, 0), a2, v2[0]);
            PG8_WAIT_V(8); PG8_WAIT_L(0); PG8_BAR; PG8_MMA(1, 0, At, B0); PG8_MMA(1, 1, At, B1); PG8_BAR; PG8_SCHED;
            PG8_LDB(B0, 1, 0); PG8_LDB(B1, 1, 1); PG8_SCHED; PG8_LDA(At, 1, 0); PG8_STAGE(PG8_SA(0, 1), a2, v2[1]);
            PG8_WAIT_V(8); PG8_WAIT_L(0); PG8_BAR; PG8_MMA(0, 0, At, B0); PG8_MMA(0, 1, At, B1); PG8_BAR; PG8_SCHED;
            PG8_LDA(At, 1, 1); PG8_STAGE(PG8_SB(1, 0), b3, voffB); PG8_STAGE(PG8_SB(1, 1), b3 + hstep, voffB); PG8_STAGE(PG8_SA(1, 0), a3, v2[0]);
            PG8_WAIT_V(8); PG8_WAIT_L(0); PG8_BAR; PG8_MMA(1, 0, At, B0); PG8_MMA(1, 1, At, B1); PG8_BAR; PG8_SCHED;
        }
        if (wr == 0) PG8_BAR;
        if constexpr (ELT == 1) asm volatile("s_nop 15\n\ts_nop 7" ::: "memory");
        if constexpr (!Epi::AFTER) { int fr2 = fr, fq2 = fq; asm volatile("" : "+v"(fr2), "+v"(fq2)); E(acc, cur, wr, wc, fr2, fq2); }
        if (!has_next) break;
#pragma unroll
        for (int a = 0; a < 2; ++a)
#pragma unroll
            for (int b = 0; b < 2; ++b)
#pragma unroll
                for (int m = 0; m < 4; ++m)
#pragma unroll
                    for (int n = 0; n < 2; ++n) acc[a][b][m][n] = (f32x4){0.f, 0.f, 0.f, 0.f};
        cur = nxt; cA = nA; cB = nB; ++ui;
        if constexpr (!ARow::UNIFORM) {
#pragma unroll
        for (int h = 0; h < 2; ++h)
#pragma unroll
            for (int i = 0; i < 2; ++i) cvA[h][i] = nvA[h][i]; }
        if (wr == 1) PG8_BAR;
    }
    PG8_WAIT_V(0);
    PG8_BAR;
    if constexpr (Epi::AFTER) { int fr2 = fr, fq2 = fq; asm volatile("" : "+v"(fr2), "+v"(fq2)); E.after(acc, cur, wr, wc, fr2, fq2, lds); }
#undef PG8_SA
#undef PG8_SB
#undef PG8_STAGE
#undef PG8_LDA
#undef PG8_LDB
#undef PG8_MMA
#undef PG8_WAIT_V
#undef PG8_WAIT_L
#undef PG8_BAR
#undef PG8_SCHED
#undef PG8_VOFF
#undef PG8_LD16
#undef PG8_CAT
}

__device__ __forceinline__ float sigm(float x) { return __builtin_amdgcn_rcpf(1.f + __builtin_amdgcn_exp2f(-1.4426950408889634f * x)); }
struct EpiSwiglu {
    static constexpr bool PERM = true, MID = false, AFTER = false;
    unsigned char* act; const float* b_gu; const float* rowscale;
    __device__ __forceinline__ void operator()(const f32x4 (&acc)[2][2][4][2], const Unit& u, int wr, int wc, int fr, int fq) const {
        const int row0 = u.pm * BM + wr * 64 + fr, col0 = u.pn * HALF + wc * 32 + 8 * fq;
        const float* bias = b_gu + (size_t)u.e * (2 * DFF) + col0;
        f32x4 bg[2], bu[2];
#pragma unroll
        for (int n = 0; n < 2; ++n) { bg[n] = *(const f32x4*)(bias + 4 * n); bu[n] = *(const f32x4*)(bias + DFF + 4 * n); }
#pragma unroll
        for (int ai = 0; ai < 2; ++ai)
#pragma unroll
            for (int m = 0; m < 4; ++m) { const int row = row0 + ai * HALF + m * 16; const float rs = rowscale[row] * W8_INV;
                float o[8];
#pragma unroll
                for (int n = 0; n < 2; ++n)
#pragma unroll
                    for (int j = 0; j < 4; ++j) { const float g = fminf(acc[ai][0][m][n][j] * rs + bg[n][j], 7.f); const float up = fminf(fmaxf(acc[ai][1][m][n][j] * rs + bu[n][j], -7.f), 7.f);
                        o[4 * n + j] = g * sigm(1.702f * g) * (up + 1.f); }
                *(uint2*)(act + (size_t)row * DFF + col0) = make_uint2(pk4_fp8(o[0], o[1], o[2], o[3]), pk4_fp8(o[4], o[5], o[6], o[7])); }
    }
};
struct EpiScatter {
    static constexpr bool PERM = true, MID = false, AFTER = false;
    bf16_t* Y; const float* b_dn; const float* rowgate;
    __device__ __forceinline__ void operator()(const f32x4 (&acc)[2][2][4][2], const Unit& u, int wr, int wc, int fr, int fq) const {
        const int row0 = u.pm * BM + wr * 64 + fr, col0 = u.pn * BM + wc * 32 + 8 * fq;
        const float* bias = b_dn + (size_t)u.e * D + col0;
        f32x4 bv[2][2];
#pragma unroll
        for (int bj = 0; bj < 2; ++bj)
#pragma unroll
            for (int n = 0; n < 2; ++n) bv[bj][n] = *(const f32x4*)(bias + bj * HALF + 4 * n) * W8_MUL;
#pragma unroll
        for (int ai = 0; ai < 2; ++ai)
#pragma unroll
            for (int m = 0; m < 4; ++m) { const int row = row0 + ai * HALF + m * 16; const float gt = rowgate[row] * W8_INV; bf16_t* yp = Y + (size_t)row * D + col0;
#pragma unroll
                for (int bj = 0; bj < 2; ++bj) { const f32x4 v0 = (acc[ai][bj][m][0] + bv[bj][0]) * gt, v1 = (acc[ai][bj][m][1] + bv[bj][1]) * gt;
                    u32x4 w; w.x = cvt_pk_bf16(v0[0], v0[1]); w.y = cvt_pk_bf16(v0[2], v0[3]); w.z = cvt_pk_bf16(v1[0], v1[1]); w.w = cvt_pk_bf16(v1[2], v1[3]);
                    *(u32x4*)(yp + bj * HALF) = w; } }
    }
};
struct EpiQKVU {
    static constexpr bool PERM = true, MID = false, AFTER = false;
    bf16_t* O; size_t stride; bf16_t* ux;
    __device__ __forceinline__ void operator()(const f32x4 (&acc)[2][2][4][2], const Unit& u, int wr, int wc, int fr, int fq) const {
        const int row0 = u.pm * BM + wr * 64 + fr, t = u.pn >> 1; const float sc = (t == 0) ? C2 : 1.f;
        const int colt = (u.pn & 1) * BM + wc * 32 + 8 * fq;
        bf16_t* base = O + (size_t)t * stride + colt;
#pragma unroll
        for (int ai = 0; ai < 2; ++ai)
#pragma unroll
            for (int m = 0; m < 4; ++m) { const int row = row0 + ai * HALF + m * 16;
#pragma unroll
                for (int bj = 0; bj < 2; ++bj) { const f32x4 v0 = acc[ai][bj][m][0] * sc, v1 = acc[ai][bj][m][1] * sc;
                    u32x4 w; w.x = cvt_pk_bf16(v0[0], v0[1]); w.y = cvt_pk_bf16(v0[2], v0[3]); w.z = cvt_pk_bf16(v1[0], v1[1]); w.w = cvt_pk_bf16(v1[2], v1[3]);
                    if (t < 3) *(u32x4*)(base + (size_t)row * 512 + bj * HALF) = w;
                    else { const int col = colt + bj * HALF, g = col >> 4, b = row >> 12, tt = row & (S - 1);
                        *(u32x4*)(ux + ((size_t)((g * NB + b) * 256 + (tt >> 4))) * UXP + (tt & 15) * 16 + (col & 15)) = w; } } }
    }
};
struct EpiS5H {
    static constexpr bool PERM = false, MID = false, AFTER = true;
    bf16_t* ux; const float* a16;
    __device__ __forceinline__ void operator()(const f32x4 (&)[2][2][4][2], const Unit&, int, int, int, int) const {}
    __device__ __forceinline__ void after(const f32x4 (&acc)[2][2][4][2], const Unit& u, int wr, int wc, int fr, int fq, PG8_LAS unsigned char* lds) const {
        PG8_LAS float* Sx = (PG8_LAS float*)lds;
        const int row0 = wr * 64 + fr, col0 = wc * 32 + 4 * fq;
#pragma unroll
        for (int ai = 0; ai < 2; ++ai)
#pragma unroll
            for (int m = 0; m < 4; ++m)
#pragma unroll
                for (int n = 0; n < 2; ++n) *(PG8_LAS f32x4*)(Sx + (row0 + ai * HALF + m * 16) * 128 + col0 + n * 16) = acc[ai][0][m][n];
        asm volatile("s_waitcnt lgkmcnt(0)" ::: "memory"); __builtin_amdgcn_s_barrier(); asm volatile("" ::: "memory");
        int tq = (wr * 4 + wc) * 64 + fq * 16 + fr; asm volatile("" : "+v"(tq));
        if (tq < 64) {
            const int p = tq; const float ar = a16[2 * p], ai_ = a16[2 * p + 1]; float xr = 0.f, xi = 0.f;
            bf16_t* urow = ux + (size_t)u.pm * 256 * UXP + 256;
            urow[p] = 0; urow[64 + p] = 0;
#pragma unroll 8
            for (int c = 0; c < 255; ++c) { const float sr = Sx[c * 128 + p], si = Sx[c * 128 + 64 + p];
                const float nxr = ar * xr - ai_ * xi + sr, nxi = ar * xi + ai_ * xr + si; xr = nxr; xi = nxi;
                urow[(size_t)(c + 1) * UXP + p] = f2bf(xr); urow[(size_t)(c + 1) * UXP + 64 + p] = f2bf(xi); }
            asm volatile("s_waitcnt vmcnt(0)" ::: "memory");
        }
        asm volatile("s_waitcnt lgkmcnt(0)" ::: "memory"); __builtin_amdgcn_s_barrier(); asm volatile("" ::: "memory");
    }
};
struct EpiS5Y {
    static constexpr bool PERM = true, MID = false, AFTER = false;
    const bf16_t* ux; const float* d_skip; bf16_t* G;
    __device__ __forceinline__ void operator()(const f32x4 (&acc)[2][2][4][2], const Unit& u, int wr, int wc, int fr, int fq) const {
        const int row0 = wr * 64 + fr, g = u.e, b = u.pm & 7, co0 = 8 * (fq & 1);
        const f32x4 d0 = *(const f32x4*)(d_skip + g * 16 + co0), d1 = *(const f32x4*)(d_skip + g * 16 + co0 + 4);
#pragma unroll
        for (int ai = 0; ai < 2; ++ai)
#pragma unroll
            for (int m = 0; m < 4; ++m) { const int c = row0 + ai * HALF + m * 16;
#pragma unroll
                for (int bj = 0; bj < 2; ++bj) { const int ncol = bj * HALF + wc * 32 + 8 * fq, i = ncol >> 4;
                    const u32x4 uv = *(const u32x4*)(ux + ((size_t)u.pm * 256 + c) * UXP + ncol); float o[8];
#pragma unroll
                    for (int n = 0; n < 2; ++n)
#pragma unroll
                        for (int j = 0; j < 4; ++j) { const unsigned w = uv[2 * n + (j >> 1)]; const float uu = __builtin_bit_cast(float, (j & 1) ? (w & 0xffff0000u) : (w << 16));
                            const float y = acc[ai][bj][m][n][j] + (n ? d1[j] : d0[j]) * uu; o[4 * n + j] = y * sigm(1.5957691216057308f * (y + 0.044715f * y * y * y)); }
                    u32x4 w; w.x = cvt_pk_bf16(o[0], o[1]); w.y = cvt_pk_bf16(o[2], o[3]); w.z = cvt_pk_bf16(o[4], o[5]); w.w = cvt_pk_bf16(o[6], o[7]);
                    *(u32x4*)(G + ((size_t)b * S + c * 16 + i) * SW + g * 16 + co0) = w; } }
    }
};
struct EpiGlu {
    static constexpr bool PERM = true, MID = false, AFTER = false;
    const bf16_t* G; bf16_t* mixb; const float* b_glu; float* pss;
    __device__ __forceinline__ void operator()(const f32x4 (&acc)[2][2][4][2], const Unit& u, int wr, int wc, int fr, int fq) const {
        const int row0 = u.pm * BM + wr * 64 + fr, col0 = u.pn * BM + wc * 32 + 8 * fq;
        f32x4 bv[2][2];
#pragma unroll
        for (int bj = 0; bj < 2; ++bj)
#pragma unroll
            for (int n = 0; n < 2; ++n) bv[bj][n] = *(const f32x4*)(b_glu + col0 + bj * HALF + 4 * n);
#pragma unroll
        for (int ai = 0; ai < 2; ++ai)
#pragma unroll
            for (int m = 0; m < 4; ++m) { const int row = row0 + ai * HALF + m * 16; float ss = 0.f;
#pragma unroll
                for (int bj = 0; bj < 2; ++bj) { const u32x4 gv = *(const u32x4*)(G + (size_t)row * SW + col0 + bj * HALF); float o[8];
#pragma unroll
                    for (int n = 0; n < 2; ++n)
#pragma unroll
                        for (int j = 0; j < 4; ++j) { const unsigned w = gv[2 * n + (j >> 1)]; const float g = __builtin_bit_cast(float, (j & 1) ? (w & 0xffff0000u) : (w << 16));
                            const float v = g * sigm(acc[ai][bj][m][n][j] + bv[bj][n][j]); o[4 * n + j] = v; ss += v * v; }
                    u32x4 w; w.x = cvt_pk_bf16(o[0], o[1]); w.y = cvt_pk_bf16(o[2], o[3]); w.z = cvt_pk_bf16(o[4], o[5]); w.w = cvt_pk_bf16(o[6], o[7]);
                    *(u32x4*)(mixb + (size_t)row * D + AW + col0 + bj * HALF) = w; }
                ss += swz_xor<16>(ss); ss = xhalf_sum(ss);
                if (fq == 0) pss[(size_t)row * 8 + u.pn * 4 + wc] = ss; }
    }
};
struct EpiOut {
    static constexpr bool PERM = false, MID = true, AFTER = false;
    const float* x; bf16_t* x1h; unsigned char* x1f8; const PG8_LAS float* stat;
    __device__ __forceinline__ void mid(f32x4 (&acc)[2][2][4][2], const Unit& u, int wr, int wc, int fr, int fq) const {
        const PG8_LAS float* st = stat + (((u.pm >> 3) & 1) * 256 + wr * 64 + fr) * 2;
#pragma unroll
        for (int ai = 0; ai < 2; ++ai)
#pragma unroll
            for (int m = 0; m < 4; ++m) { const float f = st[(ai * HALF + m * 16) * 2];
#pragma unroll
                for (int bj = 0; bj < 2; ++bj)
#pragma unroll
                    for (int n = 0; n < 2; ++n) acc[ai][bj][m][n] *= f; }
    }
    __device__ __forceinline__ void operator()(const f32x4 (&acc)[2][2][4][2], const Unit& u, int wr, int wc, int fr, int fq) const {
        int row0 = u.pm * BM + wr * 64 + fr; asm volatile("" : "+v"(row0)); const int col0 = u.pn * BM + wc * 32 + 4 * fq;
        const PG8_LAS float* st = stat + (((u.pm >> 3) & 1) * 256 + wr * 64 + fr) * 2 + 1;
#pragma unroll
        for (int ai = 0; ai < 2; ++ai)
#pragma unroll
            for (int m = 0; m < 4; ++m) { const int row = row0 + ai * HALF + m * 16; const float rs = st[(ai * HALF + m * 16) * 2]; const size_t off = (size_t)row * D + col0;
#pragma unroll
                for (int bj = 0; bj < 2; ++bj)
#pragma unroll
                    for (int n = 0; n < 2; ++n) { const size_t o2 = off + bj * HALF + n * 16; const f32x4 v = *(const f32x4*)(x + o2) + acc[ai][bj][m][n] * rs;
                        uint2 w; w.x = cvt_pk_bf16(v[0], v[1]); w.y = cvt_pk_bf16(v[2], v[3]); *(uint2*)(x1h + o2) = w; *(unsigned*)(x1f8 + o2) = pk4_fp8(v[0], v[1], v[2], v[3]); }
                if (m & 1) asm volatile("" ::: "memory"); }
    }
};
struct EpiGate {
    static constexpr bool PERM = false, MID = false, AFTER = false;
    bf16_t* gs; const float* r2;
    __device__ __forceinline__ void operator()(const f32x4 (&acc)[2][2][4][2], const Unit& u, int wr, int wc, int fr, int fq) const {
        const int row0 = u.pm * BM + wr * 64 + fr, col0 = u.pn * BM + wc * 32 + 4 * fq;
#pragma unroll
        for (int ai = 0; ai < 2; ++ai)
#pragma unroll
            for (int m = 0; m < 4; ++m) { const size_t off = (size_t)(row0 + ai * HALF + m * 16) * D + col0; const float rs = r2[row0 + ai * HALF + m * 16];
#pragma unroll
                for (int bj = 0; bj < 2; ++bj)
#pragma unroll
                    for (int n = 0; n < 2; ++n) { const f32x4 a = acc[ai][bj][m][n] * rs; uint2 w; w.x = cvt_pk_bf16(sigm(a[0]), sigm(a[1])); w.y = cvt_pk_bf16(sigm(a[2]), sigm(a[3])); *(uint2*)(gs + off + bj * HALF + n * 16) = w; } }
    }
};
struct EpiPle {
    static constexpr bool PERM = false, MID = false, AFTER = false;
    const bf16_t* gs; const bf16_t* x2h; float* x3;
    __device__ __forceinline__ void operator()(const f32x4 (&acc)[2][2][4][2], const Unit& u, int wr, int wc, int fr, int fq) const {
        const int row0 = u.pm * BM + wr * 64 + fr, col0 = u.pn * BM + wc * 32 + 4 * fq;
#pragma unroll
        for (int ai = 0; ai < 2; ++ai)
#pragma unroll
            for (int m = 0; m < 4; ++m) { const size_t off = (size_t)(row0 + ai * HALF + m * 16) * D + col0;
#pragma unroll
                for (int bj = 0; bj < 2; ++bj)
#pragma unroll
                    for (int n = 0; n < 2; ++n) { const size_t o2 = off + bj * HALF + n * 16;
                        const unsigned long long gw_ = __hip_atomic_load((const unsigned long long*)(gs + o2), __ATOMIC_RELAXED, __HIP_MEMORY_SCOPE_AGENT);
                        const unsigned lo = (unsigned)gw_, hi = (unsigned)(gw_ >> 32);
                        f32x4 g; g[0] = __builtin_bit_cast(float, lo << 16); g[1] = __builtin_bit_cast(float, lo & 0xffff0000u); g[2] = __builtin_bit_cast(float, hi << 16); g[3] = __builtin_bit_cast(float, hi & 0xffff0000u);
                        const uint2 xw = *(const uint2*)(x2h + o2); f32x4 xv; xv[0] = __builtin_bit_cast(float, xw.x << 16); xv[1] = __builtin_bit_cast(float, xw.x & 0xffff0000u); xv[2] = __builtin_bit_cast(float, xw.y << 16); xv[3] = __builtin_bit_cast(float, xw.y & 0xffff0000u);
                        *(f32x4*)(x3 + o2) = xv + g * acc[ai][bj][m][n]; } }
    }
};
}

struct TrItem { const float* W; const float* kscale; bf16_t* WT; int ldw, k0, c0, K, r0; bool f8; };
__device__ __forceinline__ void tr_load(const TrItem& d, float (&v)[32], int lane) {
    const float* p = d.W + (size_t)(d.k0 + (lane >> 5)) * d.ldw + d.c0 + (lane & 31);
#pragma unroll
    for (int i = 0; i < 32; ++i) v[i] = p[(size_t)(2 * i) * d.ldw];
}
__device__ __forceinline__ void tr_store(const TrItem& d, const float (&v)[32], __attribute__((address_space(3))) float* scr, int lane) {
    const int c = lane & 7;
    float ks[8];
#pragma unroll
    for (int j = 0; j < 8; ++j) ks[j] = d.kscale ? d.kscale[d.k0 + 8 * c + j] : 1.f;
#pragma unroll
    for (int i = 0; i < 32; ++i) scr[(2 * i + (lane >> 5)) * 33 + (lane & 31)] = v[i];
    __builtin_amdgcn_s_waitcnt(0xC07F); asm volatile("" ::: "memory");
#pragma unroll
    for (int j = 0; j < 4; ++j) { const int n = (lane >> 3) + 8 * j; const __attribute__((address_space(3))) float* s = scr + (8 * c) * 33 + n;
        uint4 o; o.x = pk2(s[0 * 33] * ks[0], s[1 * 33] * ks[1]); o.y = pk2(s[2 * 33] * ks[2], s[3 * 33] * ks[3]); o.z = pk2(s[4 * 33] * ks[4], s[5 * 33] * ks[5]); o.w = pk2(s[6 * 33] * ks[6], s[7 * 33] * ks[7]);
        if (!d.f8) *(uint4*)(d.WT + (size_t)(d.r0 + n) * d.K + d.k0 + 8 * c) = o;
        else *(uint2*)((unsigned char*)d.WT + (size_t)(d.r0 + n) * d.K + d.k0 + 8 * c) = make_uint2(pk4_fp8(s[0 * 33] * ks[0] * pg8::W8_MUL, s[1 * 33] * ks[1] * pg8::W8_MUL, s[2 * 33] * ks[2] * pg8::W8_MUL, s[3 * 33] * ks[3] * pg8::W8_MUL),
                                                                                                           pk4_fp8(s[4 * 33] * ks[4] * pg8::W8_MUL, s[5 * 33] * ks[5] * pg8::W8_MUL, s[6 * 33] * ks[6] * pg8::W8_MUL, s[7 * 33] * ks[7] * pg8::W8_MUL)); }
    __builtin_amdgcn_s_waitcnt(0xC07F); asm volatile("" ::: "memory");
}

namespace attn_body {
using bf16x8=__attribute__((ext_vector_type(8)))short;
using s16x4=__attribute__((ext_vector_type(4)))short;
using f32x16=__attribute__((ext_vector_type(16)))float;
using f32x4=__attribute__((ext_vector_type(4)))float;
using u32x4=__attribute__((ext_vector_type(4)))unsigned;
constexpr int SEQ=S,DH=64,DM=NH*DH,OPITCH=D;
constexpr int NW=8,QBLK=32,QB=QBLK*NW,KVBLK=64,NQB=SEQ/QB;
__device__ __forceinline__ int crow(int r,int hi){return (r&3)+8*(r>>2)+4*hi;}
#define SBAR() __builtin_amdgcn_sched_barrier(0)
__device__ __forceinline__ void cmask(f32x16&p0,f32x16&p1,int jb,int qrel,int hi){
  const float NEG=-INFINITY; int kb=64*jb+4*hi;
  #pragma unroll
  for(int r=0;r<16;++r){int kv=kb+(r&3)+8*(r>>2); if(kv>qrel)p0[r]=NEG; if(kv+32>qrel)p1[r]=NEG;}
}
constexpr int NSLOT=3, SLOTB=8192;
constexpr int LDS_K=0, LDS_V=NSLOT*SLOTB, LDS_WS=2*NSLOT*SLOTB, LDS_OST=LDS_WS+NW*64*4, LDS_C=LDS_OST+NW*4096, ATT_LDS_BYTES=LDS_C+(SEQ+64)*4;
__device__ __forceinline__ void glds16(const void*gsrc,unsigned lds_dst){unsigned keep;
  asm volatile("s_mov_b32 %0, m0\n\ts_mov_b32 m0, %2\n\ts_nop 0\n\tglobal_load_lds_dwordx4 %1, off\n\ts_mov_b32 m0, %0":"=&s"(keep):"v"(gsrc),"s"(lds_dst):"memory");}
__device__ __forceinline__ float max3f(float a,float b,float c){float r;asm("v_max3_f32 %0, %1, %2, %3":"=v"(r):"v"(a),"v"(b),"v"(c));return r;}
__device__ __forceinline__ float max2f(float a,float b){float r;asm("v_max_f32_e32 %0, %1, %2":"=v"(r):"v"(a),"v"(b));return r;}
__device__ __forceinline__ float fadd_s(float a,float b){float r;asm("v_add_f32_e32 %0, %1, %2":"=v"(r):"v"(a),"v"(b));return r;}
__device__ __forceinline__ float fsub_s(float a,float b){float r;asm("v_sub_f32_e32 %0, %1, %2":"=v"(r):"v"(a),"v"(b));return r;}
typedef float f32x2_t __attribute__((ext_vector_type(2))); typedef __bf16 bf16x2_t __attribute__((ext_vector_type(2)));
__device__ __forceinline__ unsigned cvtpk_s(float lo,float hi){f32x2_t v={lo,hi};bf16x2_t b=__builtin_convertvector(v,bf16x2_t);return __builtin_bit_cast(unsigned,b);}
#define WAIT_BAR(N) asm volatile("s_waitcnt vmcnt(" #N ") lgkmcnt(0)\n\ts_barrier":::"memory")
typedef __attribute__((address_space(3))) const char* lds_cptr;
typedef __attribute__((address_space(3))) const float* lds_fptr;
typedef short v4i16_t __attribute__((ext_vector_type(4)));
__device__ __forceinline__ void qkt(f32x16&p0,f32x16&p1,const char*Kslot,const bf16x8*qr,int r32,int hi){
  const char*kb=Kslot+hi*1024+r32*16;
  #pragma unroll
  for(int d0=0;d0<4;++d0){
    const bf16x8 b0=*reinterpret_cast<const bf16x8*>(kb+d0*2048);
    const bf16x8 b1=*reinterpret_cast<const bf16x8*>(kb+d0*2048+512);
    p0=__builtin_amdgcn_mfma_f32_32x32x16_bf16(b0,qr[d0],p0,0,0,0);p1=__builtin_amdgcn_mfma_f32_32x32x16_bf16(b1,qr[d0],p1,0,0,0);}
}
__device__ __forceinline__ void kload8(bf16x8*kf,lds_cptr kp){
  kf[0]=*(const __attribute__((address_space(3))) bf16x8*)(kp);      kf[1]=*(const __attribute__((address_space(3))) bf16x8*)(kp+512);
  kf[2]=*(const __attribute__((address_space(3))) bf16x8*)(kp+2048); kf[3]=*(const __attribute__((address_space(3))) bf16x8*)(kp+2560);
  kf[4]=*(const __attribute__((address_space(3))) bf16x8*)(kp+4096); kf[5]=*(const __attribute__((address_space(3))) bf16x8*)(kp+4608);
  kf[6]=*(const __attribute__((address_space(3))) bf16x8*)(kp+6144); kf[7]=*(const __attribute__((address_space(3))) bf16x8*)(kp+6656);
}
__device__ __forceinline__ void kload2(bf16x8*kf,lds_cptr kp,int j){ kf[2*j]=*(const __attribute__((address_space(3))) bf16x8*)(kp+j*2048); kf[2*j+1]=*(const __attribute__((address_space(3))) bf16x8*)(kp+j*2048+512); }
__device__ __forceinline__ s16x4 vtr(lds_cptr p){ return __builtin_bit_cast(s16x4,__builtin_amdgcn_ds_read_tr16_b64_v4i16((__attribute__((address_space(3))) v4i16_t*)p)); }
__device__ __forceinline__ float rowmax(const f32x16&p0,const f32x16&p1){
  float a=max3f(p0[0],p0[1],p1[0]),b=max3f(p0[2],p0[3],p1[1]);a=max3f(a,p1[2],p1[3]);
  #pragma unroll
  for(int r=4;r<16;r+=4){a=max3f(a,p0[r],p0[r+1]);b=max3f(b,p0[r+2],p0[r+3]);a=max3f(a,p1[r],p1[r+1]);b=max3f(b,p1[r+2],p1[r+3]);}
  const float m=max2f(a,b);
  auto rr=__builtin_amdgcn_permlane32_swap(__float_as_uint(m),__float_as_uint(m),false,false);
  return max2f(__uint_as_float(rr[0]),__uint_as_float(rr[1]));
}
__device__ __forceinline__ void pv(f32x16*o,int vb,bf16x8 pa0,bf16x8 pa1,bf16x8 pa2,bf16x8 pa3){
  #pragma unroll
  for(int d0=0;d0<2;++d0){s16x4 lo[4],hi[4];
    #pragma unroll
    for(int ks=0;ks<4;++ks){
      asm volatile("ds_read_b64_tr_b16 %0,%1 offset:%c2":"=&v"(lo[ks]):"v"(vb),"i"(d0*4096+ks*1024):"memory");
      asm volatile("ds_read_b64_tr_b16 %0,%1 offset:%c2":"=&v"(hi[ks]):"v"(vb),"i"(d0*4096+ks*1024+512):"memory");}
    asm volatile("s_waitcnt lgkmcnt(0)":::"memory");SBAR();
    #define PK(k) (bf16x8){lo[k][0],lo[k][1],lo[k][2],lo[k][3],hi[k][0],hi[k][1],hi[k][2],hi[k][3]}
    o[d0]=__builtin_amdgcn_mfma_f32_32x32x16_bf16(pa0,PK(0),o[d0],0,0,0);
    o[d0]=__builtin_amdgcn_mfma_f32_32x32x16_bf16(pa1,PK(1),o[d0],0,0,0);
    o[d0]=__builtin_amdgcn_mfma_f32_32x32x16_bf16(pa2,PK(2),o[d0],0,0,0);
    o[d0]=__builtin_amdgcn_mfma_f32_32x32x16_bf16(pa3,PK(3),o[d0],0,0,0);
    #undef PK
  }
}
__device__ __forceinline__ void prep_c(int tid0,int b,int h,const float*logf,char*shm){
  int tid=tid0; asm volatile("":"+v"(tid)); const int lane=tid&63,wid=tid>>6;
  float*cl=(float*)(shm+LDS_C); float*wtot=(float*)(shm+LDS_WS);
  float v[8]; float tot=0.f;
  #pragma unroll
  for(int i=0;i<8;++i){ v[i]=logf[((size_t)b*SEQ+tid*8+i)*8+h]; tot+=v[i]; }
  float incl=tot;
  #pragma unroll
  for(int o=1;o<64;o<<=1){ const float n=bperm(incl,(lane-o)&63); if(lane>=o)incl+=n; }
  if(lane==63)wtot[wid]=incl;
  __syncthreads();
  float pre=incl-tot;
  #pragma unroll
  for(int w=0;w<8;++w) if(w<wid)pre+=wtot[w];
  #pragma unroll
  for(int i=0;i<8;++i){ pre+=v[i]; cl[tid*8+i]=pre*LOG2E; }
  if(tid<64)cl[SEQ+tid]=0.f;
  __syncthreads();
}
template<int THRL> __device__ __forceinline__ void attn_unit(int tid0,int b,int h,int qb,const bf16_t*Q,const bf16_t*__restrict__ K,const bf16_t*__restrict__ V,bf16_t*O,float*psa,char*shm){
  int tid=tid0; asm volatile("":"+v"(tid)); const int lane=tid&63,r32=lane&31,hi=lane>>5; const int wid=__builtin_amdgcn_readfirstlane(tid>>6);
  const long rowbase=(long)b*SEQ; const int q0=qb*QB;
  const bf16_t*Qw=Q+(rowbase+q0+wid*QBLK)*DM+h*DH;
  const bf16_t*Kh=K+rowbase*DM+h*DH,*Vh=V+rowbase*DM+h*DH;
  const unsigned lds0=(unsigned)(uintptr_t)shm;
  float*wsf=(float*)(shm+LDS_WS)+wid*64;
  const bf16_t*ksrc=Kh+(long)lane*DM+wid*8;
  const bf16_t*vsrc=Vh+(long)(16*(wid&3)+(lane>>2))*DM+(wid>>2)*32+(lane&3)*8;
  const unsigned kdst=lds0+LDS_K+wid*1024, vdst=lds0+LDS_V+wid*1024;
  #define DMA_K(t,slot) glds16(ksrc+(long)(t)*KVBLK*DM,(unsigned)__builtin_amdgcn_readfirstlane(kdst+(slot)))
  #define DMA_V(t,slot) glds16(vsrc+(long)(t)*KVBLK*DM,(unsigned)__builtin_amdgcn_readfirstlane(vdst+(slot)))
  const int vb0=(int)(lds0+LDS_V)+((lane>>4)&1)*32+(lane&3)*8+(4*hi+((lane&15)>>2))*64;
  const char*Kbase=shm+LDS_K; bf16x8 kf[8];
  const lds_cptr shm3=(lds_cptr)shm; const lds_cptr kp0=shm3+LDS_K+hi*1024+r32*16; const lds_cptr vp0=shm3+LDS_V+((lane>>4)&1)*32+(lane&3)*8+(4*hi+((lane&15)>>2))*64;
  const lds_fptr clh=(lds_fptr)(shm3+LDS_C)+4*hi;
  const int NT=(q0+QB)/KVBLK;
  DMA_K(0,0);DMA_V(0,0);DMA_K(1,SLOTB);
  bf16x8 qr[4];
  #pragma unroll
  for(int d0=0;d0<4;++d0)qr[d0]=*reinterpret_cast<const bf16x8*>(&Qw[(long)r32*DM+d0*16+hi*8]);
  float mhat=0.f,l_reg=0.f;f32x16 o[2];o[0]=f32x16{};o[1]=f32x16{};
  const int qrel=wid*QBLK+r32;
  const float cq2=((lds_fptr)(shm3+LDS_C))[q0+qrel];
  #define CMASK(P0,P1,t) do{int jb_=(t)-(NT-4); if(jb_>=0)cmask(P0,P1,jb_,qrel,hi);}while(0)
  #define CINIT(P0,P1,tt,basev_) do{ _Pragma("unroll") for(int g_=0;g_<4;++g_){ const f32x4 a_=*(const __attribute__((address_space(3))) f32x4*)(clh+64*(tt)+8*g_); const f32x4 b_=*(const __attribute__((address_space(3))) f32x4*)(clh+64*(tt)+32+8*g_); \
      _Pragma("unroll") for(int j_=0;j_<4;++j_){ P0[4*g_+j_]=(basev_)-a_[j_]; P1[4*g_+j_]=(basev_)-b_[j_]; } } }while(0)
  bool resc=false;
  #define START(P0,P1) do{ const float rm=rowmax(P0,P1); resc=false; \
    { const float dl=rm; mhat=fadd_s(mhat,dl); \
      _Pragma("unroll") for(int r=0;r<16;++r){P0[r]=fsub_s(P0[r],dl);P1[r]=fsub_s(P1[r],dl);} } \
    _Pragma("unroll") for(int r=0;r<16;++r)P0[r]=__builtin_amdgcn_exp2f(P0[r]); }while(0)
  #define RESC() do{ if(resc){ asm volatile("s_waitcnt lgkmcnt(0)":::"memory"); \
      _Pragma("unroll") for(int d_=0;d_<2;++d_) _Pragma("unroll") for(int r=0;r<16;++r)o[d_][r]*=wsf[crow(r,hi)]; } }while(0)
  f32x16 pA0,pA1,pB0,pB1;
  int sl_prev=0,sl_cur=0,sl_next=SLOTB;
  #define ROT() do{sl_prev=sl_cur;sl_cur=sl_next;sl_next=(sl_next==(NSLOT-1)*SLOTB)?0:sl_next+SLOTB;}while(0)
  DMA_K(2,2*SLOTB);
  CINIT(pA0,pA1,0,cq2);
  WAIT_BAR(3);
  qkt(pA0,pA1,Kbase,qr,r32,hi);asm volatile("s_nop 15\n\ts_nop 7":"+v"(pA0),"+v"(pA1));CMASK(pA0,pA1,0);
  START(pA0,pA1);
  _Pragma("unroll") for(int r=0;r<16;++r)pA1[r]=__builtin_amdgcn_exp2f(pA1[r]);
  { const float bv0=cq2-mhat; CINIT(pB0,pB1,1,bv0); }
  WAIT_BAR(0);
  DMA_K(3,0);DMA_V(1,SLOTB);
  ROT();
  kload8(kf,kp0+sl_cur);
  WAIT_BAR(2);
  s16x4 vlo[8],vhi[8]; u32x4 pw0,pw1,pw2,pw3;
  #define PKW(P,B) cvtpk_s(P[B],P[B+1])
  #define PAF(k) __builtin_bit_cast(bf16x8,pw##k)
  #define VFR(i) (bf16x8){vlo[i][0],vlo[i][1],vlo[i][2],vlo[i][3],vhi[i][0],vhi[i][1],vhi[i][2],vhi[i][3]}
  #define PIN(x) asm volatile("":"+v"(x))
  #define MX3(a,b,c) __builtin_fmaxf(__builtin_fmaxf((a),(b)),(c))
  #define GAPA(MF,A0,A1,A2,A3,W0,W1,PW) do{ MF; sacc+=A0; sacc+=A1; sacc+=A2; sacc+=A3; PIN(sacc); W0; W1; PIN(PW); SBAR(); }while(0)
  #define EX(v) __builtin_amdgcn_exp2f(v)
  #define CKRD(i) (*(const __attribute__((address_space(3))) f32x4*)(clt_+(((i)>>2)*32+((i)&3)*8)))
  #define GAPB(MF,X,B,PN,G,IROW) do{ const f32x4 ck_=CKRD(IROW); MF; X[B]=EX(X[B]); X[B+1]=EX(X[B+1]); X[B+2]=EX(X[B+2]); X[B+3]=EX(X[B+3]); PIN(X); \
      PN[4*(G)]=basev-ck_[0]; PN[4*(G)+1]=basev-ck_[1]; PN[4*(G)+2]=basev-ck_[2]; PN[4*(G)+3]=basev-ck_[3]; PIN(PN); SBAR(); }while(0)
  #define VRD(i) do{ vlo[i]=vtr(vp_+(((i)>>2)*4096+((i)&3)*1024)); vhi[i]=vtr(vp_+(((i)>>2)*4096+((i)&3)*1024+512)); }while(0)
  #define KRD(G,j) do{ if(G){ kload2(kf,kp0+sl_next,j); SBAR(); } }while(0)
  #define STEP(C0,C1,P0,P1,t,GK,GV,GL) do{ SBAR(); \
    const lds_cptr vp_=vp0+sl_prev; const lds_fptr clt_=clh+64*((t)+1); \
    VRD(0); SBAR(); float sacc=(P0[0]+P0[1]); \
    GAPA(C0=__builtin_amdgcn_mfma_f32_32x32x16_bf16(kf[0],qr[0],C0,0,0,0), P0[2],P0[3],P0[4],P0[5],     pw0[0]=PKW(P0,0), pw0[1]=PKW(P0,2), pw0); \
    VRD(4); SBAR(); GAPA(C1=__builtin_amdgcn_mfma_f32_32x32x16_bf16(kf[1],qr[0],C1,0,0,0), P0[6],P0[7],P0[8],P0[9],     pw0[2]=PKW(P0,4), pw0[3]=PKW(P0,6), pw0); \
    VRD(1); SBAR(); GAPA(C0=__builtin_amdgcn_mfma_f32_32x32x16_bf16(kf[2],qr[1],C0,0,0,0),   P0[10],P0[11],P0[12],P0[13], pw1[0]=PKW(P0,8), pw1[1]=PKW(P0,10), pw1); \
    VRD(5); SBAR(); GAPA(C1=__builtin_amdgcn_mfma_f32_32x32x16_bf16(kf[3],qr[1],C1,0,0,0),   P0[14],P0[15],P1[0],P1[1],   pw1[2]=PKW(P0,12),pw1[3]=PKW(P0,14), pw1); \
    VRD(2); SBAR(); GAPA(C0=__builtin_amdgcn_mfma_f32_32x32x16_bf16(kf[4],qr[2],C0,0,0,0),   P1[2],P1[3],P1[4],P1[5],     pw2[0]=PKW(P1,0), pw2[1]=PKW(P1,2), pw2); \
    VRD(6); SBAR(); GAPA(C1=__builtin_amdgcn_mfma_f32_32x32x16_bf16(kf[5],qr[2],C1,0,0,0),   P1[6],P1[7],P1[8],P1[9],     pw2[2]=PKW(P1,4), pw2[3]=PKW(P1,6), pw2); \
    VRD(3); SBAR(); GAPA(C0=__builtin_amdgcn_mfma_f32_32x32x16_bf16(kf[6],qr[3],C0,0,0,0),   P1[10],P1[11],P1[12],P1[13], pw3[0]=PKW(P1,8), pw3[1]=PKW(P1,10), pw3); \
    VRD(7); SBAR(); GAPA(C1=__builtin_amdgcn_mfma_f32_32x32x16_bf16(kf[7],qr[3],C1,0,0,0),   P1[14],P1[15],0.f,0.f,       pw3[2]=PKW(P1,12),pw3[3]=PKW(P1,14), pw3); \
    l_reg+=sacc; \
    if(GK){DMA_K((t)+3,sl_cur);} if(GV){DMA_V((t)+1,sl_next);} \
    CMASK(C0,C1,t); \
    { float a=MX3(C0[0],C0[1],C1[0]),b=MX3(C0[2],C0[3],C1[1]); a=MX3(a,C1[2],C1[3]); \
      _Pragma("unroll") for(int r=4;r<16;r+=4){a=MX3(a,C0[r],C0[r+1]);b=MX3(b,C0[r+2],C0[r+3]);a=MX3(a,C1[r],C1[r+1]);b=MX3(b,C1[r+2],C1[r+3]);} \
      float rm=__builtin_fmaxf(a,b); { auto rr=__builtin_amdgcn_permlane32_swap(__float_as_uint(rm),__float_as_uint(rm),false,false); rm=__builtin_fmaxf(__uint_as_float(rr[0]),__uint_as_float(rr[1])); } \
      resc=false; \
      if(__builtin_expect(__any(rm>(float)THRL),0)){ const float dl=__builtin_fmaxf(rm,0.f); mhat+=dl; \
        _Pragma("unroll") for(int r=0;r<16;++r){C0[r]-=dl;C1[r]-=dl;} \
        const float f=__builtin_amdgcn_exp2f(-dl); l_reg*=f; if(hi==0)wsf[r32]=f; resc=true; } } \
    const float basev=cq2-mhat; \
    SBAR(); \
    GAPB(o[0]=__builtin_amdgcn_mfma_f32_32x32x16_bf16(PAF(0),VFR(0),o[0],0,0,0), C0,0,  P0,0,0); \
    GAPB(o[1]=__builtin_amdgcn_mfma_f32_32x32x16_bf16(PAF(0),VFR(4),o[1],0,0,0), C0,4,  P0,1,1); \
    KRD(GL,0); GAPB(o[0]=__builtin_amdgcn_mfma_f32_32x32x16_bf16(PAF(1),VFR(1),o[0],0,0,0), C0,8,  P0,2,2); \
    KRD(GL,1); GAPB(o[1]=__builtin_amdgcn_mfma_f32_32x32x16_bf16(PAF(1),VFR(5),o[1],0,0,0), C0,12, P0,3,3); \
    KRD(GL,2); GAPB(o[0]=__builtin_amdgcn_mfma_f32_32x32x16_bf16(PAF(2),VFR(2),o[0],0,0,0), C1,0,  P1,0,4); \
    KRD(GL,3); GAPB(o[1]=__builtin_amdgcn_mfma_f32_32x32x16_bf16(PAF(2),VFR(6),o[1],0,0,0), C1,4,  P1,1,5); \
    GAPB(o[0]=__builtin_amdgcn_mfma_f32_32x32x16_bf16(PAF(3),VFR(3),o[0],0,0,0), C1,8,  P1,2,6); \
    GAPB(o[1]=__builtin_amdgcn_mfma_f32_32x32x16_bf16(PAF(3),VFR(7),o[1],0,0,0), C1,12, P1,3,7); \
    }while(0)
  int t=1;
  #undef CMASK
  #define CMASK(P0,P1,t) do{}while(0)
  for(;t+5<NT;t+=2){
    STEP(pB0,pB1,pA0,pA1,t,true,true,true);     WAIT_BAR(2); RESC(); ROT();
    STEP(pA0,pA1,pB0,pB1,t+1,true,true,true);   WAIT_BAR(2); RESC(); ROT();
  }
  #undef CMASK
  #define CMASK(P0,P1,t) do{int jb_=(t)-(NT-4); if(jb_>=0)cmask(P0,P1,jb_,qrel,hi);}while(0)
  #define ENDW(tt) do{ if((tt)+3<NT){WAIT_BAR(2);} else if((tt)+2<NT){WAIT_BAR(1);} else {WAIT_BAR(0);} }while(0)
  for(;t+1<NT;t+=2){
    STEP(pB0,pB1,pA0,pA1,t,(t+3<NT),(t+1<NT),(t+1<NT));       ENDW(t);   RESC(); ROT();
    STEP(pA0,pA1,pB0,pB1,t+1,(t+4<NT),(t+2<NT),(t+2<NT));     ENDW(t+1); RESC(); ROT();
  }
  STEP(pB0,pB1,pA0,pA1,NT-1,false,false,false); RESC();
  { float sacc=pB0[0]+pB0[1]; _Pragma("unroll") for(int r=2;r<16;++r)sacc+=pB0[r]; _Pragma("unroll") for(int r=0;r<16;++r)sacc+=pB1[r]; l_reg+=sacc;
    pw0=(u32x4){PKW(pB0,0),PKW(pB0,2),PKW(pB0,4),PKW(pB0,6)};pw1=(u32x4){PKW(pB0,8),PKW(pB0,10),PKW(pB0,12),PKW(pB0,14)};pw2=(u32x4){PKW(pB1,0),PKW(pB1,2),PKW(pB1,4),PKW(pB1,6)};pw3=(u32x4){PKW(pB1,8),PKW(pB1,10),PKW(pB1,12),PKW(pB1,14)};
    SBAR(); pv(o,vb0+sl_cur,PAF(0),PAF(1),PAF(2),PAF(3)); }
  #undef PKW
  #undef PAF
  #undef VFR
  #undef PIN
  #undef MX3
  #undef GAPA
  #undef GAPB
  #undef CKRD
  #undef EX
  #undef VRD
  #undef KRD
  #undef STEP
  #undef ENDW
  {auto rr=__builtin_amdgcn_permlane32_swap(__float_as_uint(l_reg),__float_as_uint(l_reg),false,false);l_reg=__uint_as_float(rr[0])+__uint_as_float(rr[1]);}
  if(hi==0)wsf[32+r32]=l_reg;asm volatile("s_waitcnt lgkmcnt(0)":::"memory");
  float rli[16];
  #pragma unroll
  for(int r=0;r<16;++r)rli[r]=__builtin_amdgcn_rcpf(wsf[32+crow(r,hi)]);
  bf16_t*Ow=O+(rowbase+q0+wid*QBLK)*OPITCH+h*DH;
  { bf16_t*stg=(bf16_t*)(shm+LDS_OST)+wid*2048;
    #pragma unroll
    for(int r=0;r<16;++r){const int orow=crow(r,hi);
      #pragma unroll
      for(int d0=0;d0<2;++d0)stg[orow*64+d0*32+r32]=f2bf(o[d0][r]*rli[r]);}
    asm volatile("s_waitcnt lgkmcnt(0)":::"memory");
    #pragma unroll
    for(int i=0;i<4;++i){const int row=i*8+(lane>>3),ch=lane&7; const u32x4 v=*(const u32x4*)(stg+row*64+ch*8); *(u32x4*)(Ow+(long)row*OPITCH+ch*8)=v;
      float ss=0.f;
      #pragma unroll
      for(int j=0;j<4;++j){ const float lo_=__builtin_bit_cast(float,v[j]<<16), hi_=__builtin_bit_cast(float,v[j]&0xffff0000u); ss+=lo_*lo_+hi_*hi_; }
      ss+=swz_xor<1>(ss); ss+=swz_xor<2>(ss); ss+=swz_xor<4>(ss);
      if(ch==0)psa[(rowbase+q0+wid*QBLK+row)*8+h]=ss; } }
  asm volatile("s_waitcnt lgkmcnt(0)\n\ts_barrier":::"memory");
  #undef DMA_K
  #undef DMA_V
  #undef CMASK
  #undef CINIT
  #undef START
  #undef RESC
  #undef ROT
}
#undef SBAR
#undef WAIT_BAR
}

__device__ void s5_precompute(int g, const float* lam_re, const float* lam_im, const float* log_dt, const float* b_re, const float* b_im, const float* c_re, const float* c_im,
                              bf16_t* bth, bf16_t* bttg, float* a16, float* sm) {
    float* apr = sm; float* api = apr + 17 * 64; float* bbr = api + 17 * 64; float* bbi = bbr + 1024; float* cr = bbi + 1024; float* ci = cr + 1024; float* Kt = ci + 1024;
    const int tid = threadIdx.x;
    if (tid < 64) { const int p = tid; const float dt = __expf(log_dt[g]); const float lr = lam_re[g * NP + p], li = lam_im[g * NP + p];
        for (int tau = 0; tau <= 16; ++tau) { const float mag = __expf(lr * dt * (float)tau), ang = li * dt * (float)tau; apr[tau * 64 + p] = mag * cosf(ang); api[tau * 64 + p] = mag * sinf(ang); }
        const float abr = apr[64 + p], abi = api[64 + p], den = lr * lr + li * li, nr = abr - 1.f; const float zr = (nr * lr + abi * li) / den, zi = (abi * lr - nr * li) / den;
        for (int c = 0; c < NC; ++c) { const float br = b_re[(size_t)(g * NP + p) * NC + c], bi = b_im[(size_t)(g * NP + p) * NC + c]; bbr[p * 16 + c] = zr * br - zi * bi; bbi[p * 16 + c] = zr * bi + zi * br; }
        a16[(g * 64 + p) * 2] = apr[16 * 64 + p]; a16[(g * 64 + p) * 2 + 1] = api[16 * 64 + p]; }
    for (int i = tid; i < 1024; i += NTHR) { cr[i] = c_re[(size_t)g * 1024 + i]; ci[i] = c_im[(size_t)g * 1024 + i]; }
    __syncthreads();
    for (int idx = tid; idx < 4096; idx += NTHR) { const int tau = idx >> 8, co = (idx >> 4) & 15, cin = idx & 15; float sacc = 0.f;
        for (int p = 0; p < 64; ++p) { const float c_r = cr[co * 64 + p], c_i = ci[co * 64 + p], a_r = apr[tau * 64 + p], a_i = api[tau * 64 + p]; const float wr_ = c_r * a_r - c_i * a_i, wi_ = c_r * a_i + c_i * a_r;
            sacc += wr_ * bbr[p * 16 + cin] - wi_ * bbi[p * 16 + cin]; }
        Kt[idx] = sacc; }
    __syncthreads();
    bf16_t* tg = bttg + (size_t)g * 256 * UXP; bf16_t* hh = bth + (size_t)g * 256 * 256;
    for (int idx = tid; idx < 256 * UXP; idx += NTHR) { const int n = idx / UXP, k = idx - n * UXP, i = n >> 4, co = n & 15; float v;
        if (k < 256) { const int j = k >> 4, cin = k & 15; v = (j <= i) ? Kt[((i - j) << 8) + (co << 4) + cin] : 0.f; }
        else if (k < 320) { const int p = k - 256; v = cr[co * 64 + p] * apr[(i + 1) * 64 + p] - ci[co * 64 + p] * api[(i + 1) * 64 + p]; }
        else { const int p = k - 320; v = -(cr[co * 64 + p] * api[(i + 1) * 64 + p] + ci[co * 64 + p] * apr[(i + 1) * 64 + p]); }
        tg[idx] = f2bf(v); }
    for (int idx = tid; idx < 256 * 256; idx += NTHR) { const int n = idx >> 8, k = idx & 255, j = k >> 4, cin = k & 15; float v = 0.f;
        if (n < 64) v = apr[(15 - j) * 64 + n] * bbr[n * 16 + cin] - api[(15 - j) * 64 + n] * bbi[n * 16 + cin];
        else if (n < 128) { const int p = n - 64; v = apr[(15 - j) * 64 + p] * bbi[p * 16 + cin] + api[(15 - j) * 64 + p] * bbr[p * 16 + cin]; }
        hh[idx] = f2bf(v); }
    __syncthreads();
}


#define XB_TMO      128
#define XB_XCNT(j)  (256  + 64 * (j))
#define XB_XSUB(j)  (1280 + 64 * (j))
#define XB_XGEN(j)  (2304 + 64 * (j))
#define XB_TOP      3328
#define XB_TOPGEN   3392
#define XCD_BAR_WORDS 3456
#define XB_SPIN_CAP (1u << 22)
__device__ __forceinline__ unsigned xb_ld(unsigned* p)              { return __hip_atomic_load(p, __ATOMIC_RELAXED, __HIP_MEMORY_SCOPE_AGENT); }
__device__ __forceinline__ unsigned xb_add(unsigned* p, unsigned v) { return __hip_atomic_fetch_add(p, v, __ATOMIC_RELAXED, __HIP_MEMORY_SCOPE_AGENT); }
__device__ __forceinline__ unsigned xb_xcc_id() { return (unsigned)__builtin_amdgcn_s_getreg((3 << 11) | 20) & 0xFu; }
#define XB_SPIN(cond, bar) do { unsigned _sp = 0; while (cond) { __builtin_amdgcn_s_sleep(1); \
    if ((++_sp & 255u) == 0u) { if (xb_ld(&(bar)[XB_TMO])) break; if (_sp > XB_SPIN_CAP) { atomicAdd(&(bar)[XB_TMO], 1u); break; } } } } while (0)
struct XcdBarrier { unsigned* bar; unsigned x; volatile __attribute__((address_space(3))) unsigned* st; };
__device__ __forceinline__ XcdBarrier xcd_barrier_post(unsigned* bar, volatile __attribute__((address_space(3))) unsigned* st, bool leader) {
    XcdBarrier b; b.bar = bar; b.x = xb_xcc_id(); b.st = st;
    if (leader) (void)xb_add(&bar[XB_XCNT(b.x)], 1u);
    return b;
}
__device__ __forceinline__ void xcd_barrier_complete(unsigned* bar, unsigned x, unsigned G, unsigned& nloc, unsigned& nx) {
    unsigned sum, cnt, mine, sp = 0u;
    for (;;) {
        sum = 0u; cnt = 0u; mine = 0u;
#pragma unroll
        for (unsigned j = 0; j < 16; ++j) { const unsigned c = xb_ld(&bar[XB_XCNT(j)]); sum += c; cnt += (c > 0u) ? 1u : 0u; mine = (j == x) ? c : mine; }
        if (sum == G) break;
        __builtin_amdgcn_s_sleep(1);
        if ((++sp & 255u) == 0u) { if (xb_ld(&bar[XB_TMO])) break; if (sp > XB_SPIN_CAP) { atomicAdd(&bar[XB_TMO], 1u); break; } }
    }
    nloc = mine > 0u ? mine : 1u; nx = cnt > 0u ? cnt : 1u;
}
__device__ __forceinline__ void xcd_barrier(const XcdBarrier& b, bool leader, unsigned G) {
    asm volatile("s_waitcnt vmcnt(0)" ::: "memory");
    __syncthreads();
    if (leader) {
        unsigned* bar = b.bar;
        __builtin_amdgcn_s_waitcnt(0);
        unsigned nloc = b.st[0], nx = b.st[1];
        if (nloc == 0u) { xcd_barrier_complete(bar, b.x, G, nloc, nx); b.st[0] = nloc; b.st[1] = nx; }
        const unsigned old = xb_add(&bar[XB_XSUB(b.x)], 1u);
        const unsigned gen = old / nloc;
        if (old + 1u == (gen + 1u) * nloc) {
            __builtin_amdgcn_fence(__ATOMIC_RELEASE, "agent");
            asm volatile("s_waitcnt vmcnt(0)" ::: "memory");
            const unsigned og = xb_add(&bar[XB_TOP], 1u);
            const unsigned tg = og / nx;
            if (og + 1u == (tg + 1u) * nx) xb_add(&bar[XB_TOPGEN], 1u);
            else XB_SPIN(xb_ld(&bar[XB_TOPGEN]) == tg, bar);
            __builtin_amdgcn_fence(__ATOMIC_ACQUIRE, "agent");
            xb_add(&bar[XB_XGEN(b.x)], 1u);
            asm volatile("s_waitcnt vmcnt(0)" ::: "memory");
        } else {
            XB_SPIN(xb_ld(&bar[XB_XGEN(b.x)]) == gen, bar);
            __builtin_amdgcn_fence(__ATOMIC_ACQUIRE, "agent");
            asm volatile("s_waitcnt vmcnt(0)" ::: "memory");
        }
    }
    __syncthreads();
}

__device__ __forceinline__ int lane_now() { int l; asm volatile("v_mbcnt_lo_u32_b32 %0, -1, 0\n\tv_mbcnt_hi_u32_b32 %0, -1, %0" : "=v"(l)); return l; }

struct Params {
    const float* in[29];
    float* out;
    unsigned char* ws;
};

__device__ __forceinline__ float wave_sum(float v) {
    v += swz_xor<1>(v); v += swz_xor<2>(v); v += swz_xor<4>(v); v += swz_xor<8>(v); v += swz_xor<16>(v);
    return xhalf_sum(v);
}

template <class AT> __device__ void rms_rows(const AT* in, int ldi, const float* g, float* out, int ldo, int ncols, int nrows, int gw, int ngw, int lane) {
    for (int r = gw; r < nrows; r += ngw) {
        const AT* row = in + (size_t)r * ldi; float ss = 0.f;
        for (int c = lane; c < ncols; c += 64) { const float v = ldf(row, c); ss += v * v; }
        ss = wave_sum(ss);
        const float rs = rsqrtf(ss / (float)ncols + EPS);
        float* orow = out + (size_t)r * ldo;
        for (int c = lane; c < ncols; c += 64) orow[c] = ldf(row, c) * rs * g[c];
    }
}

template <class AT, bool DUAL, class RowFn, class Epi>
__device__ void gemm_tile(const AT* A, int lda, RowFn arow, const float* B, int ldb, int K, int m0, int n0, int n1, int Nmax, float* sm, Epi epi) {
    float* As = sm;
    float* Bs = sm + 16 * 132;
    float* Bs2 = Bs + 16 * 128;
    const int tid = threadIdx.x, ty = tid >> 4, tx = tid & 15;
    float acc[4][8], acc2[4][8];
#pragma unroll
    for (int i = 0; i < 4; ++i)
#pragma unroll
        for (int j = 0; j < 8; ++j) { acc[i][j] = 0.f; acc2[i][j] = 0.f; }
    const int ar = tid >> 2, ak = (tid & 3) * 4;
    const int srow = arow(m0 + ar);
    const int bk = tid >> 5, bn = (tid & 31) * 4;
    for (int k0 = 0; k0 < K; k0 += 16) {
        float a4[4];
#pragma unroll
        for (int j = 0; j < 4; ++j) a4[j] = (srow >= 0) ? ldf(A, (size_t)srow * lda + k0 + ak + j) : 0.f;
        float b4[4], c4[4];
#pragma unroll
        for (int j = 0; j < 4; ++j) { const int col = n0 + bn + j; b4[j] = (col < Nmax) ? B[(size_t)(k0 + bk) * ldb + col] : 0.f; }
        if (DUAL) {
#pragma unroll
            for (int j = 0; j < 4; ++j) c4[j] = B[(size_t)(k0 + bk) * ldb + n1 + bn + j];
        }
        __syncthreads();
#pragma unroll
        for (int j = 0; j < 4; ++j) As[(ak + j) * 132 + ar] = a4[j];
#pragma unroll
        for (int j = 0; j < 4; ++j) Bs[bk * 128 + bn + j] = b4[j];
        if (DUAL) {
#pragma unroll
            for (int j = 0; j < 4; ++j) Bs2[bk * 128 + bn + j] = c4[j];
        }
        __syncthreads();
#pragma unroll 2
        for (int kk = 0; kk < 16; ++kk) {
            float a[4], b[8];
#pragma unroll
            for (int i = 0; i < 4; ++i) a[i] = As[kk * 132 + ty * 4 + i];
#pragma unroll
            for (int j = 0; j < 8; ++j) b[j] = Bs[kk * 128 + tx * 8 + j];
#pragma unroll
            for (int i = 0; i < 4; ++i)
#pragma unroll
                for (int j = 0; j < 8; ++j) acc[i][j] += a[i] * b[j];
            if (DUAL) {
#pragma unroll
                for (int j = 0; j < 8; ++j) b[j] = Bs2[kk * 128 + tx * 8 + j];
#pragma unroll
                for (int i = 0; i < 4; ++i)
#pragma unroll
                    for (int j = 0; j < 8; ++j) acc2[i][j] += a[i] * b[j];
            }
        }
    }
    __syncthreads();
#pragma unroll
    for (int i = 0; i < 4; ++i)
#pragma unroll
        for (int j = 0; j < 8; ++j) epi(m0 + ty * 4 + i, tx * 8 + j, acc[i][j], acc2[i][j]);
}

struct RowId { __device__ int operator()(int r) const { return r; } };
struct RowTok { const int* rowtok; __device__ int operator()(int r) const { const int id = rowtok[r]; return id < 0 ? -1 : (id >> 2); } };
struct RowSlot { const int* rowtok; __device__ int operator()(int r) const { return rowtok[r] < 0 ? -1 : r; } };

__device__ __forceinline__ float sigmoidf_(float x) { return 1.f / (1.f + __expf(-x)); }

__global__ void __launch_bounds__(NTHR) fwd_naive(Params P) {
    cg::grid_group grid = cg::this_grid();
    extern __shared__ __attribute__((aligned(16))) unsigned char lds[];
    float* sm = (float*)lds;
    int* ism = (int*)(lds + 57600);
    PG8_LAS unsigned char* ldsl = (PG8_LAS unsigned char*)lds;
    const int wave_s = __builtin_amdgcn_readfirstlane((int)threadIdx.x >> 6);
#define TID_NOW() (wave_s * 64 + lane_now())
    int tid = TID_NOW(), lane = tid & 63, wave = tid >> 6;
    const int nblk = gridDim.x, blk = blockIdx.x;
    int gw = blk * NWAVE + wave; const int ngw = nblk * NWAVE;
#define REFRESH_IDS() do { tid = TID_NOW(); asm volatile("" : "+v"(tid)); lane = tid & 63; wave = tid >> 6; gw = blk * NWAVE + wave; } while (0)
    PG8_LAS unsigned long long* ptab = (PG8_LAS unsigned long long*)(ldsl + PTAB_OFF);
    if (tid == 0) {
#pragma unroll
        for (int k = 0; k < 29; ++k) ptab[k] = (unsigned long long)P.in[k];
        ptab[29] = (unsigned long long)P.out; ptab[30] = (unsigned long long)P.ws; }
    volatile __attribute__((address_space(3))) unsigned* MISC = (volatile __attribute__((address_space(3))) unsigned*)(ldsl + MISC_OFF);
    if (tid < 2) MISC[tid] = 0u;
    __syncthreads();
#define LPTRI(k) ((unsigned long long)(unsigned)__builtin_amdgcn_readfirstlane((int)(unsigned)ptab[k]) | ((unsigned long long)(unsigned)__builtin_amdgcn_readfirstlane((int)(unsigned)(ptab[k] >> 32)) << 32))
    const XcdBarrier xbar = xcd_barrier_post((unsigned*)((unsigned char*)(__attribute__((address_space(1))) unsigned char*)LPTRI(30) + WS_CTL) + CT_BAR, MISC, tid == 0);
#define GSYNC() do { xcd_barrier(xbar, TID_NOW() == 0, (unsigned)nblk); REFRESH_IDS(); } while (0)
#define ALLPTRS() \
    unsigned char* ws = (unsigned char*)(__attribute__((address_space(1))) unsigned char*)LPTRI(30); int* ctl = (int*)(ws + WS_CTL); float* outp = (float*)(__attribute__((address_space(1))) float*)LPTRI(29); \
    float* logf_ = (float*)(ws + WS_LOGF); float* x1 = (float*)(ws + WS_X1); \
    int* topi = (int*)(ws + WS_TOPI); float* topg = (float*)(ws + WS_TOPG); int* rowtok = (int*)(ws + WS_ROWTOK); float* rowgate = (float*)(ws + WS_ROWGATE); \
    bf16_t* act = (bf16_t*)(ws + WS_ACT); bf16_t* Y = (bf16_t*)(ws + WS_Y); \
    bf16_t* Win_t = (bf16_t*)(ws + WS_WIN); bf16_t* XN = (bf16_t*)(ws + WS_XN); bf16_t* QB = (bf16_t*)(ws + WS_Q); \
    bf16_t* KB = QB + (size_t)T * 512; bf16_t* VB = KB + (size_t)T * 512; bf16_t* UX = (bf16_t*)(ws + WS_UX); \
    bf16_t* S5H = (bf16_t*)(ws + WS_S5H); bf16_t* S5TG = (bf16_t*)(ws + WS_S5TG); float* A16 = (float*)(ws + WS_A16); \
    bf16_t* Wgu_t = (bf16_t*)(ws + WS_WGU); bf16_t* Wdn_t = (bf16_t*)(ws + WS_WDN); bf16_t* X1B = (bf16_t*)(ws + WS_X1B); \
    bf16_t* MIXB = (bf16_t*)(ws + WS_MIXB); float* psa = (float*)(ws + WS_PSA); float* pss = (float*)(ws + WS_PSS); \
    bf16_t* GB = (bf16_t*)(ws + WS_GB); bf16_t* Wglu_t = (bf16_t*)(ws + WS_WGLU); bf16_t* Wout_t = (bf16_t*)(ws + WS_WOUT); bf16_t* Wpg_t = (bf16_t*)(ws + WS_WPG); bf16_t* Wpp_t = (bf16_t*)(ws + WS_WPP); \
    bf16_t* PB = (bf16_t*)(ws + WS_PB); bf16_t* XN2 = (bf16_t*)(ws + WS_XN2); bf16_t* GSB = (bf16_t*)(ws + WS_GS); \
    int* rowsrc = (int*)(ws + WS_ROWSRC); float* rowscl = (float*)(ws + WS_ROWSCL); float* r1 = (float*)(ws + WS_R1); bf16_t* X1H = (bf16_t*)(ws + WS_X1H); float* r2 = (float*)(ws + WS_R2); int* slotof = (int*)(ws + WS_SLOTOF); (void)X1H; (void)r2; (void)slotof; \
    const float* x = (const float*)(__attribute__((address_space(1))) const float*)LPTRI(0); const float* pin = (const float*)(__attribute__((address_space(1))) const float*)LPTRI(1); const float* norm_mix_g = (const float*)(__attribute__((address_space(1))) const float*)LPTRI(2); const float* w_in = (const float*)(__attribute__((address_space(1))) const float*)LPTRI(3); const float* b_f = (const float*)(__attribute__((address_space(1))) const float*)LPTRI(4); \
    const float* lam_re = (const float*)(__attribute__((address_space(1))) const float*)LPTRI(5); const float* lam_im = (const float*)(__attribute__((address_space(1))) const float*)LPTRI(6); const float* log_dt = (const float*)(__attribute__((address_space(1))) const float*)LPTRI(7); const float* b_re = (const float*)(__attribute__((address_space(1))) const float*)LPTRI(8); const float* b_im = (const float*)(__attribute__((address_space(1))) const float*)LPTRI(9); \
    const float* c_re = (const float*)(__attribute__((address_space(1))) const float*)LPTRI(10); const float* c_im = (const float*)(__attribute__((address_space(1))) const float*)LPTRI(11); const float* d_skip = (const float*)(__attribute__((address_space(1))) const float*)LPTRI(12); const float* w_glu = (const float*)(__attribute__((address_space(1))) const float*)LPTRI(13); const float* b_glu = (const float*)(__attribute__((address_space(1))) const float*)LPTRI(14); \
    const float* attn_out_g = (const float*)(__attribute__((address_space(1))) const float*)LPTRI(15); const float* ssm_out_g = (const float*)(__attribute__((address_space(1))) const float*)LPTRI(16); const float* w_out = (const float*)(__attribute__((address_space(1))) const float*)LPTRI(17); const float* norm_ffn_g = (const float*)(__attribute__((address_space(1))) const float*)LPTRI(18); \
    const float* w_router = (const float*)(__attribute__((address_space(1))) const float*)LPTRI(19); const float* b_router = (const float*)(__attribute__((address_space(1))) const float*)LPTRI(20); const float* w_gu = (const float*)(__attribute__((address_space(1))) const float*)LPTRI(21); const float* b_gu = (const float*)(__attribute__((address_space(1))) const float*)LPTRI(22); \
    const float* w_dn = (const float*)(__attribute__((address_space(1))) const float*)LPTRI(23); const float* b_dn = (const float*)(__attribute__((address_space(1))) const float*)LPTRI(24); const float* norm_ple_g = (const float*)(__attribute__((address_space(1))) const float*)LPTRI(25); const float* w_ple_gate = (const float*)(__attribute__((address_space(1))) const float*)LPTRI(26); \
    const float* w_ple_proj = (const float*)(__attribute__((address_space(1))) const float*)LPTRI(27); const float* norm_final_g = (const float*)(__attribute__((address_space(1))) const float*)LPTRI(28); \
    (void)ctl; (void)outp; (void)logf_; (void)x1; (void)topi; (void)topg; (void)rowtok; (void)rowgate; (void)act; (void)Y; (void)Win_t; (void)XN; (void)QB; (void)KB; (void)VB; (void)UX; (void)S5H; (void)S5TG; (void)A16; (void)Wgu_t; (void)Wdn_t; (void)X1B; \
    (void)MIXB; (void)psa; (void)pss; (void)GB; (void)Wglu_t; (void)Wout_t; (void)Wpg_t; (void)Wpp_t; (void)PB; (void)XN2; (void)GSB; (void)rowsrc; (void)rowscl; (void)r1; (void)x; (void)pin; (void)norm_mix_g; (void)w_in; (void)b_f; \
    (void)lam_re; (void)lam_im; (void)log_dt; (void)b_re; (void)b_im; (void)c_re; (void)c_im; (void)d_skip; (void)w_glu; (void)b_glu; (void)attn_out_g; (void)ssm_out_g; (void)w_out; (void)norm_ffn_g; (void)w_router; (void)b_router; (void)w_gu; (void)b_gu; \
    (void)w_dn; (void)b_dn; (void)norm_ple_g; (void)w_ple_gate; (void)w_ple_proj; (void)norm_final_g

    { ALLPTRS();
    if (blk == 0 && tid < 128) ctl[tid] = 0;
    if (blk < NG) s5_precompute(blk, lam_re, lam_im, log_dt, b_re, b_im, c_re, c_im, S5H, S5TG, A16, sm);
    REP(1) {
        PG8_LAS float* scr = (PG8_LAS float*)(ldsl + wave * 16384);
        constexpr int I_IN = 16 * 64, I_GU = NE * 16 * 64, I_DN = NE * 16 * 32, I_GLU = 8 * 16, I_OUT = 16 * 32, I_PG = 16 * 32, I_PP = 4 * 32;
        constexpr int NI = I_IN + I_GLU + I_OUT + I_PG + I_PP + I_GU + I_DN;
        auto decode = [&](int it, TrItem& d) {
            int r = it;
            if (r < I_GLU) { const int kb = r >> 4, nb = r & 15; d = TrItem{w_glu, nullptr, Wglu_t, SW, kb * 64, nb * 32, SW, nb * 32, false}; return; }
            r -= I_GLU;
            if (r < I_OUT) { const int kb = r >> 5, nb = r & 31; d = TrItem{w_out, kb < 8 ? attn_out_g : ssm_out_g - AW, Wout_t, D, kb * 64, nb * 32, D, nb * 32, false}; return; }
            r -= I_OUT;
            if (r < I_PG) { const int kb = r >> 5, nb = r & 31; d = TrItem{w_ple_gate, norm_ple_g, Wpg_t, D, kb * 64, nb * 32, D, nb * 32, false}; return; }
            r -= I_PG;
            if (r < I_PP) { const int kb = r >> 5, nb = r & 31; d = TrItem{w_ple_proj, nullptr, Wpp_t, D, kb * 64, nb * 32, PLE, nb * 32, false}; return; }
            r -= I_PP;
            if (r < I_IN) { const int kb = r >> 6, nb = r & 63, n0 = nb * 32; d = TrItem{w_in, norm_mix_g, Win_t, INW, kb * 64, (n0 < 1536) ? n0 : n0 + 8, D, n0, false}; return; }
            r -= I_IN;
            if (r < I_GU) {
                const int e = r >> 10, kb = (r >> 6) & 15, nb = r & 63; const int n0 = nb * 32, pn = n0 >> 8, j0 = n0 & 255;
                d = TrItem{w_gu + (size_t)e * D * 2 * DFF, norm_ffn_g, (bf16_t*)((unsigned char*)Wgu_t + (size_t)e * 2 * DFF * D), 2 * DFF, kb * 64, (j0 < 128) ? pn * 128 + j0 : DFF + pn * 128 + (j0 - 128), D, n0, true}; return; }
            r -= I_GU;
            { const int e = r >> 9, kb = (r >> 5) & 15, nb = r & 31; d = TrItem{w_dn + (size_t)e * DFF * D, nullptr, (bf16_t*)((unsigned char*)Wdn_t + (size_t)e * D * DFF), D, kb * 64, nb * 32, DFF, nb * 32, true}; }
        };
        TrItem dc, dn; float vc[32], vn[32];
        int it = gw;
        if (it < NI) { decode(it, dc); tr_load(dc, vc, lane); }
        while (it < NI) {
            const int itn = it + ngw; const bool more = itn < NI;
            if (more) { decode(itn, dn); tr_load(dn, vn, lane); }
            tr_store(dc, vc, scr, lane);
            if (more) { dc = dn;
#pragma unroll
                for (int i = 0; i < 32; ++i) vc[i] = vn[i]; }
            it = itn;
        }
    }
    for (size_t i = (size_t)(blk * NTHR + tid) * 8; i < (size_t)T * PLE; i += (size_t)nblk * NTHR * 8) {
        const float4 a = *(const float4*)(pin + i), b4 = *(const float4*)(pin + i + 4);
        *(uint4*)(PB + i) = make_uint4(pk2(a.x, a.y), pk2(a.z, a.w), pk2(b4.x, b4.y), pk2(b4.z, b4.w)); }
    REP(10) {
        float wf[4][4][8];
#pragma unroll
        for (int j = 0; j < 4; ++j)
#pragma unroll
            for (int i = 0; i < 4; ++i) { const int k = 256 * j + 4 * lane + i; const float gk = norm_mix_g[k]; const float4 a = *(const float4*)(w_in + (size_t)k * INW + COL_F), b4 = *(const float4*)(w_in + (size_t)k * INW + COL_F + 4);
                wf[j][i][0] = a.x * gk; wf[j][i][1] = a.y * gk; wf[j][i][2] = a.z * gk; wf[j][i][3] = a.w * gk; wf[j][i][4] = b4.x * gk; wf[j][i][5] = b4.y * gk; wf[j][i][6] = b4.z * gk; wf[j][i][7] = b4.w * gk; }
        float4 vnx[4];
        if (gw < T) {
#pragma unroll
            for (int j = 0; j < 4; ++j) vnx[j] = ((const float4*)(x + (size_t)gw * D) + lane)[64 * j]; }
        for (int r = gw; r < T; r += ngw) {
            float4 v[4]; float ss = 0.f;
#pragma unroll
            for (int j = 0; j < 4; ++j) v[j] = vnx[j];
            if (r + ngw < T) {
#pragma unroll
                for (int j = 0; j < 4; ++j) vnx[j] = ((const float4*)(x + (size_t)(r + ngw) * D) + lane)[64 * j]; }
#pragma unroll
            for (int j = 0; j < 4; ++j) ss += (v[j].x * v[j].x + v[j].y * v[j].y) + (v[j].z * v[j].z + v[j].w * v[j].w);
            ss = wave_sum(ss); const float rs = rsqrtf(ss * (1.f / D) + EPS);
            float fl[8];
#pragma unroll
            for (int h = 0; h < 8; ++h) fl[h] = 0.f;
            uint2* o8 = (uint2*)(XN + (size_t)r * D) + lane;
#pragma unroll
            for (int j = 0; j < 4; ++j) { const float a0 = v[j].x * rs, a1 = v[j].y * rs, a2 = v[j].z * rs, a3 = v[j].w * rs;
                o8[64 * j] = make_uint2(pk2(a0, a1), pk2(a2, a3));
#pragma unroll
                for (int h = 0; h < 8; ++h) fl[h] += a0 * wf[j][0][h] + a1 * wf[j][1][h] + a2 * wf[j][2][h] + a3 * wf[j][3][h]; }
            float mine = 0.f;
#pragma unroll
            for (int h = 0; h < 8; ++h) { const float sfl = wave_sum(fl[h]); if (lane == h) mine = sfl; }
            if (lane < 8) { const float z = mine + b_f[lane]; logf_[(size_t)r * 8 + lane] = fminf(z, 0.f) - log1pf(__expf(-fabsf(z))); }
        }
    }
    __syncthreads();
    }
    grid.sync(); REFRESH_IDS();
    { ALLPTRS();

    REP(2) {
        pg8::Order So; So.init(T / 256, 2048 / 256, nblk, blk, nullptr);
        pg8::EpiQKVU E{QB, (size_t)T * 512, UX};
        pg8::gemm_phase(TID_NOW(), ldsl, (const char*)XN, (const char*)Win_t, 0, D, So, pg8::DenseRows{D}, E);
    }
    }
    GSYNC();
    { ALLPTRS();

    REP(3) {
        const int pm = (blk % 8) * (nblk / 8) + blk / 8, g = pm >> 3;
        pg8::OneUnit So{pm, g};
        pg8::EpiS5H E1{UX, A16 + g * 128};
        pg8::gemm_phase(TID_NOW(), ldsl, (const char*)UX, (const char*)S5H, (size_t)256 * 256 * 2, 256, So, pg8::DenseRows{UXP}, E1);
        pg8::EpiS5Y E2{UX, d_skip, GB};
        pg8::gemm_phase(TID_NOW(), ldsl, (const char*)UX, (const char*)S5TG, (size_t)256 * UXP * 2, UXP, So, pg8::DenseRows{UXP}, E2);
    }
    REP(4) {
        const int vcu = (blk % 8) * (nblk / 8) + blk / 8, bh = vcu >> 2, sg = vcu & 3, b = bh >> 3, h = bh & 7;
        attn_body::prep_c(TID_NOW(), b, h, logf_, (char*)lds);
        for (int i = 0; i < 4; ++i) { const int qb = (i == 0) ? sg : (i == 1) ? 7 - sg : (i == 2) ? 8 + sg : 15 - sg;
            attn_body::attn_unit<8>(TID_NOW(), b, h, qb, QB, KB, VB, MIXB, psa, (char*)lds); }
    }
    }
    GSYNC();
    { ALLPTRS();

    REP(9) {
        pg8::Order So; So.init(T / 256, SW / 256, nblk, blk, nullptr);
        pg8::EpiGlu E{GB, MIXB, b_glu, pss};
        pg8::gemm_phase(TID_NOW(), ldsl, (const char*)GB, (const char*)Wglu_t, 0, SW, So, pg8::DenseRows{SW}, E);
    }
    }
    GSYNC();
    { ALLPTRS();

    REP(5) {
        pg8::Order So; So.init(T / 256, D / 256, nblk, blk, nullptr);
        PG8_LAS float* stat = (PG8_LAS float*)(ldsl + 131072);
        {   pg8::Unit uu; if (So.next(tid >> 8, uu)) { const int row = uu.pm * 256 + (tid & 255); const float4* pa = (const float4*)(psa + (size_t)row * 8); const float4* ps = (const float4*)(pss + (size_t)row * 8);
                const float4 a0 = pa[0], a1 = pa[1], s0 = ps[0], s1 = ps[1];
                const float ra = rsqrtf((((a0.x + a0.y) + (a0.z + a0.w)) + ((a1.x + a1.y) + (a1.z + a1.w))) * (1.f / AW) + EPS), rs = rsqrtf((((s0.x + s0.y) + (s0.z + s0.w)) + ((s1.x + s1.y) + (s1.z + s1.w))) * (1.f / SW) + EPS);
                PG8_LAS float* d2 = stat + (((uu.pm >> 3) & 1) * 256 + (tid & 255)) * 2; d2[0] = ra / rs; d2[1] = rs; } }
        __syncthreads();
        pg8::EpiOut E{x, X1H, (unsigned char*)X1B, stat};
        pg8::gemm_phase(TID_NOW(), ldsl, (const char*)MIXB, (const char*)Wout_t, 0, D, So, pg8::DenseRows{D}, E);
    }
    }
    GSYNC();
    { ALLPTRS();

    {
        typedef float f32x16 __attribute__((ext_vector_type(16)));
        float* Wr = sm;
        int* hist = (int*)(lds + 131072);
        for (int i = tid; i < D * NE; i += NTHR) Wr[i] = w_router[i] * norm_ffn_g[i >> 5];
        if (tid < NE) hist[tid] = 0;
        __syncthreads();
        if (wave >= 4) { for (int i = blk * 256 + (tid - 256); i < CAP; i += nblk * 256) { rowtok[i] = -1; rowgate[i] = 0.f; rowsrc[i] = 0; rowscl[i] = 0.f; } }
        else {
            const int r0 = (blk * 4 + wave) * 32, e = lane & 31, h = lane >> 5; const bf16_t* xp = X1H + (size_t)(r0 + e) * D + 4 * h;
            f32x16 acc;
#pragma unroll
            for (int r = 0; r < 16; ++r) acc[r] = 0.f;
            float ss = 0.f;
#pragma unroll 4
            for (int j = 0; j < 128; ++j) { const uint2 xw = *(const uint2*)(xp + 8 * j); float4 xv; xv.x = __builtin_bit_cast(float, xw.x << 16); xv.y = __builtin_bit_cast(float, xw.x & 0xffff0000u); xv.z = __builtin_bit_cast(float, xw.y << 16); xv.w = __builtin_bit_cast(float, xw.y & 0xffff0000u);
                const float* wp = Wr + (8 * j + 4 * h) * 32 + e;
                ss += (xv.x * xv.x + xv.y * xv.y) + (xv.z * xv.z + xv.w * xv.w);
                acc = __builtin_amdgcn_mfma_f32_32x32x2f32(xv.x, wp[0], acc, 0, 0, 0); acc = __builtin_amdgcn_mfma_f32_32x32x2f32(xv.y, wp[32], acc, 0, 0, 0);
                acc = __builtin_amdgcn_mfma_f32_32x32x2f32(xv.z, wp[64], acc, 0, 0, 0); acc = __builtin_amdgcn_mfma_f32_32x32x2f32(xv.w, wp[96], acc, 0, 0, 0); }
            ss = xhalf_sum(ss); const float rs = rsqrtf(ss * (1.f / D) + EPS);
            if (h == 0) r1[r0 + e] = rs;
            const float bias = b_router[e];
#pragma unroll
            for (int r = 0; r < 16; ++r) { const int ri = (r & 3) + 8 * (r >> 2) + 4 * h;
                float v = acc[r] * bperm(rs, ri) + bias; float tv[TOPK]; int ti[TOPK];
#pragma unroll
                for (int k = 0; k < TOPK; ++k) { float m = v;
                    m = fmaxf(m, swz_xor<1>(m)); m = fmaxf(m, swz_xor<2>(m)); m = fmaxf(m, swz_xor<4>(m)); m = fmaxf(m, swz_xor<8>(m)); m = fmaxf(m, swz_xor<16>(m));
                    const unsigned long long bm = __ballot(v == m); const unsigned half = h ? (unsigned)(bm >> 32) : (unsigned)bm; const int idx = __ffs((int)half) - 1;
                    tv[k] = m; ti[k] = idx; if (e == idx) v = -INFINITY; }
                float es[TOPK], den = 0.f;
#pragma unroll
                for (int k = 0; k < TOPK; ++k) { es[k] = __expf(tv[k] - tv[0]); den += es[k]; }
                if (e < TOPK) { float gsel = es[0]; int isel = ti[0];
#pragma unroll
                    for (int k = 1; k < TOPK; ++k) if (e == k) { gsel = es[k]; isel = ti[k]; }
                    topi[(size_t)(r0 + ri) * TOPK + e] = isel; topg[(size_t)(r0 + ri) * TOPK + e] = gsel / den; atomicAdd(&hist[isel], 1); } }
        }
        __syncthreads();
        if (tid < NE) atomicAdd(&ctl[CT_COUNT + tid], hist[tid]);
    }
    }
    GSYNC();
    { ALLPTRS();

    {
        int* lcnt = ism + 64; int* lbase = ism + 128;
        if (tid < NE) lcnt[tid] = 0;
        if (tid == 0) {
            int run = 0;
            for (int e = 0; e < NE; ++e) { ism[e] = run; const int cnt = ctl[CT_COUNT + e]; run += (cnt + MB - 1) / MB * MB; }
            ism[NE] = run;
            if (blk == 0) {
                for (int e = 0; e <= NE; ++e) ctl[CT_PADSTART + e] = ism[e];
                ctl[CT_NTILES] = run / MB;
                for (int e = 0; e < NE; ++e) for (int tt = ism[e] / MB; tt < ism[e + 1] / MB; ++tt) ctl[CT_TILEEXP + tt] = e;
            }
        }
        __syncthreads();
        const int i = blk * NTHR + tid; const int e = topi[i]; const int rank = atomicAdd(&lcnt[e], 1);
        __syncthreads();
        if (tid < NE) lbase[tid] = atomicAdd(&ctl[CT_CURSOR + tid], lcnt[tid]);
        __syncthreads();
        const int slot = ism[e] + lbase[e] + rank;
        rowtok[slot] = i; rowgate[slot] = topg[i]; rowsrc[slot] = i >> 2; rowscl[slot] = r1[i >> 2]; slotof[i] = slot;
    }
    }
    GSYNC();
    { ALLPTRS();

    REP(6) {
        pg8::Order So; So.init(__builtin_amdgcn_readfirstlane(ctl[CT_NTILES]), 2 * DFF / 256, nblk, blk, ctl + CT_TILEEXP);
        pg8::EpiSwiglu E{(unsigned char*)act, b_gu, rowscl};
        pg8::gemm_phase<1>(TID_NOW(), ldsl, (const char*)X1B, (const char*)Wgu_t, (size_t)2 * DFF * D, D, So, pg8::GatherRows{rowsrc, D}, E);
    }
    }
    GSYNC();
    { ALLPTRS();

    REP(7) {
        pg8::Order So; So.init(__builtin_amdgcn_readfirstlane(ctl[CT_NTILES]), D / 256, nblk, blk, ctl + CT_TILEEXP);
        pg8::EpiScatter E{Y, b_dn, rowgate};
        pg8::gemm_phase<1>(TID_NOW(), ldsl, (const char*)act, (const char*)Wdn_t, (size_t)D * DFF, DFF, So, pg8::DenseRows{DFF}, E);
    }
    }
    GSYNC();
    { ALLPTRS();

    for (int r = gw; r < T; r += ngw) {
        const uint2* xr = (const uint2*)(X1H + (size_t)r * D) + lane; float4 v[4]; float ss = 0.f;
        const int4 sl = *(const int4*)(slotof + (size_t)r * TOPK);
        const uint2* y0 = (const uint2*)(Y + (size_t)sl.x * D) + lane; const uint2* y1 = (const uint2*)(Y + (size_t)sl.y * D) + lane; const uint2* y2 = (const uint2*)(Y + (size_t)sl.z * D) + lane; const uint2* y3 = (const uint2*)(Y + (size_t)sl.w * D) + lane;
#define BF4ADD(dst, src2) do { dst.x += __builtin_bit_cast(float, (src2).x << 16); dst.y += __builtin_bit_cast(float, (src2).x & 0xffff0000u); dst.z += __builtin_bit_cast(float, (src2).y << 16); dst.w += __builtin_bit_cast(float, (src2).y & 0xffff0000u); } while (0)
#pragma unroll
        for (int j = 0; j < 4; ++j) { const uint2 a = xr[64 * j], b0 = y0[64 * j], b1 = y1[64 * j], b2 = y2[64 * j], b3 = y3[64 * j];
            v[j] = make_float4(0.f, 0.f, 0.f, 0.f); BF4ADD(v[j], a); BF4ADD(v[j], b0); BF4ADD(v[j], b1); BF4ADD(v[j], b2); BF4ADD(v[j], b3);
            ss += (v[j].x * v[j].x + v[j].y * v[j].y) + (v[j].z * v[j].z + v[j].w * v[j].w); }
#undef BF4ADD
        ss = wave_sum(ss); if (lane == 0) r2[r] = rsqrtf(ss * (1.f / D) + EPS);
        uint2* o8 = (uint2*)(XN2 + (size_t)r * D) + lane;
#pragma unroll
        for (int j = 0; j < 4; ++j) o8[64 * j] = make_uint2(pk2(v[j].x, v[j].y), pk2(v[j].z, v[j].w));
    }
    }
    GSYNC();
    { ALLPTRS();

    {
        pg8::Order So; So.init(T / 256, D / 256, nblk, blk, nullptr);
        pg8::EpiGate E1{GSB, r2};
        pg8::gemm_phase(TID_NOW(), ldsl, (const char*)XN2, (const char*)Wpg_t, 0, D, So, pg8::DenseRows{D}, E1);
        pg8::EpiPle E2{GSB, XN2, x1};
        pg8::gemm_phase(TID_NOW(), ldsl, (const char*)PB, (const char*)Wpp_t, 0, PLE, So, pg8::DenseRows{PLE}, E2);
    }
    }
    GSYNC();
    { ALLPTRS();

    REP(8)
    for (int r = gw; r < T; r += 2 * ngw) {
        const int r2 = r + ngw; const bool has2 = r2 < T;
        const float4* xr = (const float4*)(x1 + (size_t)r * D) + lane; const float4* xr2 = (const float4*)(x1 + (size_t)(has2 ? r2 : r) * D) + lane; float4 v[4], w[4]; float ss = 0.f, ss2 = 0.f;
#pragma unroll
        for (int j = 0; j < 4; ++j) { v[j] = xr[64 * j]; w[j] = xr2[64 * j]; }
#pragma unroll
        for (int j = 0; j < 4; ++j) { ss += (v[j].x * v[j].x + v[j].y * v[j].y) + (v[j].z * v[j].z + v[j].w * v[j].w); ss2 += (w[j].x * w[j].x + w[j].y * w[j].y) + (w[j].z * w[j].z + w[j].w * w[j].w); }
        ss = wave_sum(ss); ss2 = wave_sum(ss2); const float rs = rsqrtf(ss * (1.f / D) + EPS), rs2 = rsqrtf(ss2 * (1.f / D) + EPS);
        if (has2) { float4* orow2 = (float4*)(outp + (size_t)r2 * D) + lane;
#pragma unroll
            for (int j = 0; j < 4; ++j) { const float4 g4 = ((const float4*)norm_final_g)[lane + 64 * j]; orow2[64 * j] = make_float4(w[j].x * rs2 * g4.x, w[j].y * rs2 * g4.y, w[j].z * rs2 * g4.z, w[j].w * rs2 * g4.w); } }
        float4* orow = (float4*)(outp + (size_t)r * D) + lane;
#pragma unroll
        for (int j = 0; j < 4; ++j) { const float4 g4 = ((const float4*)norm_final_g)[lane + 64 * j]; orow[64 * j] = make_float4(v[j].x * rs * g4.x, v[j].y * rs * g4.y, v[j].z * rs * g4.z, v[j].w * rs * g4.w); }
    }
    }
}

extern "C" void kernel_launch(void* const* d_in, const int* in_sizes, int n_in, void* d_out, int out_size, void* d_ws, size_t ws_size, hipStream_t stream) {
    static int grid = 0;
    if (grid == 0) {
        int dev = 0, cus = 0, per_cu = 0;
        (void)hipGetDevice(&dev);
        (void)hipDeviceGetAttribute(&cus, hipDeviceAttributeMultiprocessorCount, dev);
        if (hipFuncSetAttribute((const void*)fwd_naive, hipFuncAttributeMaxDynamicSharedMemorySize, LDS_BYTES) != hipSuccess) fprintf(stderr, "kernel_launch: hipFuncSetAttribute failed\n");
        (void)hipOccupancyMaxActiveBlocksPerMultiprocessor(&per_cu, (const void*)fwd_naive, NTHR, LDS_BYTES);
        if (per_cu < 1) { fprintf(stderr, "kernel_launch: occupancy query says %d blocks per CU\n", per_cu); per_cu = 1; }
        grid = cus;
        if (n_in != 29 || ws_size < WS_END) { fprintf(stderr, "kernel_launch: unexpected n_in %d or ws_size %zu\n", n_in, ws_size); }
    }
    (void)hipMemsetAsync((char*)d_ws + WS_CTL, 0, CTL_ZERO_BYTES, stream);
    Params p{};
    for (int i = 0; i < 29; ++i) p.in[i] = (const float*)d_in[i];
    p.out = (float*)d_out; p.ws = (unsigned char*)d_ws;
    void* args[] = {&p};
    hipError_t e = hipLaunchCooperativeKernel((const void*)fwd_naive, dim3(grid), dim3(NTHR), args, LDS_BYTES, stream);
    if (e != hipSuccess) fprintf(stderr, "cooperative launch failed: %s (grid %d)\n", hipGetErrorString(e), grid);
}
```
